# Optimizing an MI355X kernel written in HIP

```python
import math
import jax, jax.numpy as jnp
from jax import lax
import numpy as np

D_MODEL = 2048
BATCH = 2
SEQ = 16384
DEPTH = 1

CHUNK = 64
EPS = 1e-6
NEG_INF = -1e30

D_MIX = D_MODEL
DIFF_WIDTH = D_MIX // 2
GMLP_WIDTH = D_MIX - DIFF_WIDTH

DIFF_HEADS = 8
DIFF_QK_DIM = DIFF_WIDTH // DIFF_HEADS // 2
DIFF_V_DIM = 2 * DIFF_QK_DIM
ROPE_DIMS = DIFF_QK_DIM // 4
ROPE_THETA = 500000.0
Q_BLOCK = 128

GMLP_GROUPS = 8
GMLP_GROUP_CH = GMLP_WIDTH // GMLP_GROUPS
GMLP_LEN = 128

Q_COLS = DIFF_HEADS * 2 * DIFF_QK_DIM
K_COLS = DIFF_HEADS * 2 * DIFF_QK_DIM
V_COLS = DIFF_HEADS * DIFF_V_DIM
U_COLS = GMLP_WIDTH
Z_COLS = GMLP_WIDTH
IN_COLS = Q_COLS + K_COLS + V_COLS + U_COLS + Z_COLS

PEER_HEADS = 8
PEER_N_KEYS = 128
PEER_N_EXPERTS = PEER_N_KEYS * PEER_N_KEYS
PEER_QUERY_DIM = 256
PEER_HALF = PEER_QUERY_DIM // 2
PEER_TOPK = 16
PEER_TOKEN_BLOCK = 128

kernel_name = "hymba_diffattn_gmlp_peer_block"


def rmsnorm(x, g):
    xf = x.astype(jnp.float32)
    y = xf * lax.rsqrt(jnp.mean(xf * xf, axis=-1, keepdims=True) + EPS)
    return (y * g.astype(jnp.float32)).astype(x.dtype)


def rope_tables(seq_len, dtype):
    pos = jnp.arange(seq_len, dtype=jnp.float32)
    inv_freq = ROPE_THETA ** (-jnp.arange(0, ROPE_DIMS, 2, dtype=jnp.float32) / ROPE_DIMS)
    ang = pos[:, None] * inv_freq[None, :]
    return jnp.cos(ang).astype(dtype), jnp.sin(ang).astype(dtype)


def apply_partial_rope(t, cos, sin):
    half = ROPE_DIMS // 2
    c = cos[None, :, None, None, :]
    s = sin[None, :, None, None, :]
    x1 = t[..., :half]
    x2 = t[..., half:ROPE_DIMS]
    return jnp.concatenate([x1 * c - x2 * s, x2 * c + x1 * s, t[..., ROPE_DIMS:]], axis=-1)


def diff_attention(q, k, v, lam, subln_g, lambda_init):
    B, S = q.shape[0], q.shape[1]
    nqb = S // Q_BLOCK
    qb = q.reshape(B, nqb, Q_BLOCK, DIFF_HEADS, 2, DIFF_QK_DIM).transpose(1, 0, 3, 4, 2, 5)
    kt = k.transpose(0, 2, 3, 1, 4)
    vt = v.transpose(0, 2, 1, 3)
    chunk_id = jnp.arange(S, dtype=jnp.int32) // CHUNK
    q_chunk = chunk_id.reshape(nqb, Q_BLOCK)
    scale = DIFF_QK_DIM ** -0.5

    def one_block(args):
        q_blk, q_ch = args
        s = jnp.einsum('bhmqd,bhmkd->bhmqk', q_blk, kt).astype(jnp.float32) * scale
        mask = chunk_id[None, :] <= q_ch[:, None]
        s = jnp.where(mask, s, NEG_INF)
        p = jax.nn.softmax(s, axis=-1)
        a = p[:, :, 0] - lam * p[:, :, 1]
        return jnp.einsum('bhqk,bhkd->bhqd', a.astype(vt.dtype), vt)

    o = lax.map(one_block, (qb, q_chunk))
    o = o.transpose(1, 0, 3, 2, 4).reshape(B, S, DIFF_HEADS, DIFF_V_DIM)
    o = rmsnorm(o, subln_g) * (1.0 - lambda_init)
    return o.reshape(B, S, DIFF_WIDTH)


def gmlp_spatial_gating(u, z, z_norm_g, w_s, b_s):
    B, S = u.shape[0], u.shape[1]
    u = jax.nn.gelu(u)
    z = jax.nn.gelu(z).reshape(B, S, GMLP_GROUPS, GMLP_GROUP_CH)
    z = rmsnorm(z, z_norm_g.reshape(GMLP_GROUPS, GMLP_GROUP_CH))
    z = z.reshape(B, S // GMLP_LEN, GMLP_LEN, GMLP_GROUPS, GMLP_GROUP_CH)
    pos_chunk = jnp.arange(GMLP_LEN, dtype=jnp.int32) // CHUNK
    mask = pos_chunk[:, None] >= pos_chunk[None, :]
    w = jnp.where(mask[None], w_s, jnp.zeros_like(w_s))
    sz = jnp.einsum('gpq,bnqgc->bnpgc', w, z) + b_s.T[None, None, :, :, None]
    return u * sz.reshape(B, S, GMLP_WIDTH)


def peer_ffn(x, w_q, sub_keys, u_tab, v_tab):
    B, S, D = x.shape
    xt = x.reshape(-1, PEER_TOKEN_BLOCK, D)

    def one_block(xb):
        T = xb.shape[0]
        q = (xb @ w_q).reshape(T, PEER_HEADS, 2, PEER_HALF)
        sc = jnp.einsum('thcd,hckd->thck', q, sub_keys)
        s1, i1 = lax.top_k(sc[:, :, 0], PEER_TOPK)
        s2, i2 = lax.top_k(sc[:, :, 1], PEER_TOPK)
        cand = (s1[..., :, None] + s2[..., None, :]).reshape(T, PEER_HEADS, PEER_TOPK * PEER_TOPK)
        best, ci = lax.top_k(cand, PEER_TOPK)
        e1 = jnp.take_along_axis(i1, ci // PEER_TOPK, axis=-1)
        e2 = jnp.take_along_axis(i2, ci % PEER_TOPK, axis=-1)
        idx = e1 * PEER_N_KEYS + e2
        g = jax.nn.softmax(best.astype(jnp.float32), axis=-1)
        u_sel = jnp.take(u_tab, idx, axis=0)
        act = jax.nn.gelu(jnp.einsum('td,thkd->thk', xb, u_sel))
        v_sel = jnp.take(v_tab, idx, axis=0)
        return jnp.einsum('thk,thkd->td', g.astype(act.dtype) * act, v_sel)

    out = lax.map(one_block, xt)
    return out.reshape(B, S, D)


def setup_inputs(seed: int = 0) -> dict:
    key = jax.random.key(seed)
    ks = jax.random.split(key, 20)
    f32 = jnp.float32
    nrm = lambda k, shape, s: jax.random.normal(k, shape, f32) * s
    gain = lambda k, shape: 1.0 + 0.02 * jax.random.normal(k, shape, f32)
    return {
        "x": jax.random.normal(ks[0], (BATCH, SEQ, D_MODEL), f32),
        "mix_norm_g": gain(ks[1], (DEPTH, D_MODEL)),
        "w_in": nrm(ks[2], (DEPTH, D_MODEL, IN_COLS), D_MODEL ** -0.5),
        "lambda_q1": nrm(ks[3], (DEPTH, DIFF_QK_DIM), 0.1),
        "lambda_k1": nrm(ks[4], (DEPTH, DIFF_QK_DIM), 0.1),
        "lambda_q2": nrm(ks[5], (DEPTH, DIFF_QK_DIM), 0.1),
        "lambda_k2": nrm(ks[6], (DEPTH, DIFF_QK_DIM), 0.1),
        "subln_g": gain(ks[7], (DEPTH, DIFF_V_DIM)),
        "gmlp_z_norm_g": gain(ks[8], (DEPTH, GMLP_WIDTH)),
        "gmlp_w_s": nrm(ks[9], (DEPTH, GMLP_GROUPS, GMLP_LEN, GMLP_LEN), GMLP_LEN ** -0.5),
        "gmlp_b_s": gain(ks[10], (DEPTH, GMLP_GROUPS, GMLP_LEN)),
        "gmlp_out_g": gain(ks[11], (DEPTH, GMLP_WIDTH)),
        "w_out": nrm(ks[12], (DEPTH, D_MIX, D_MODEL), D_MIX ** -0.5),
        "ffn_norm_g": gain(ks[13], (DEPTH, D_MODEL)),
        "peer_w_q": nrm(ks[14], (DEPTH, D_MODEL, PEER_HEADS * PEER_QUERY_DIM), D_MODEL ** -0.5),
        "peer_sub_keys": nrm(ks[15], (DEPTH, PEER_HEADS, 2, PEER_N_KEYS, PEER_HALF), PEER_HALF ** -0.5),
        "peer_u": nrm(ks[16], (DEPTH, PEER_N_EXPERTS, D_MODEL), D_MODEL ** -0.5),
        "peer_v": nrm(ks[17], (DEPTH, PEER_N_EXPERTS, D_MODEL), 0.3),
        "final_norm_g": gain(ks[18], (D_MODEL,)),
    }


def reference(x, mix_norm_g, w_in, lambda_q1, lambda_k1, lambda_q2, lambda_k2, subln_g,
              gmlp_z_norm_g, gmlp_w_s, gmlp_b_s, gmlp_out_g, w_out, ffn_norm_g,
              peer_w_q, peer_sub_keys, peer_u, peer_v, final_norm_g):
    B, S = x.shape[0], x.shape[1]
    cos, sin = rope_tables(S, x.dtype)
    splits = [Q_COLS, Q_COLS + K_COLS, Q_COLS + K_COLS + V_COLS, Q_COLS + K_COLS + V_COLS + U_COLS]
    for l in range(DEPTH):
        lambda_init = 0.8 - 0.6 * math.exp(-0.3 * l)
        hn = rmsnorm(x, mix_norm_g[l])
        proj = hn @ w_in[l]
        q, k, v, u_g, z_g = jnp.split(proj, splits, axis=-1)
        q = apply_partial_rope(q.reshape(B, S, DIFF_HEADS, 2, DIFF_QK_DIM), cos, sin)
        k = apply_partial_rope(k.reshape(B, S, DIFF_HEADS, 2, DIFF_QK_DIM), cos, sin)
        v = v.reshape(B, S, DIFF_HEADS, DIFF_V_DIM)
        lam = (jnp.exp(jnp.sum(lambda_q1[l].astype(jnp.float32) * lambda_k1[l].astype(jnp.float32)))
               - jnp.exp(jnp.sum(lambda_q2[l].astype(jnp.float32) * lambda_k2[l].astype(jnp.float32)))
               + lambda_init)
        attn_out = diff_attention(q, k, v, lam, subln_g[l], lambda_init)
        gmlp_out = rmsnorm(gmlp_spatial_gating(u_g, z_g, gmlp_z_norm_g[l], gmlp_w_s[l], gmlp_b_s[l]),
                           gmlp_out_g[l])
        mixed = jnp.concatenate([attn_out, gmlp_out], axis=-1) @ w_out[l]
        x = x + mixed
        x = x + peer_ffn(rmsnorm(x, ffn_norm_g[l]), peer_w_q[l], peer_sub_keys[l], peer_u[l], peer_v[l])
    return rmsnorm(x, final_norm_g)
```

```cpp
#include <hip/hip_runtime.h>
#include <cstdio>
#include <cstdint>
namespace pg8 {
#define PG8_LAS __attribute__((address_space(3)))
typedef unsigned short bf16_t;
typedef short bf16x8 __attribute__((ext_vector_type(8)));
typedef float f32x4 __attribute__((ext_vector_type(4)));
typedef unsigned u32x4 __attribute__((ext_vector_type(4)));
constexpr int BM = 256, BK = 64, HALF = 128, HTB = HALF * BK * 2  , STAGE_BYTES = 8 * HTB, NXCD = 8, WGM = 8;

__host__ __device__ __forceinline__ int lds_byte(int r, int c) { const int st = (r >> 4) * 2 + (c >> 5), rr = r & 15, cc = c & 31, ob = rr * 64 + cc * 2; return st * 1024 + (ob ^ (((ob >> 9) & 1) << 5)); }
__host__ __device__ __forceinline__ void stage_rc(int b, int& R, int& C) { const int st = b / 1024, sb = b % 1024, swz = sb ^ (((sb >> 9) & 1) << 5); R = (st >> 1) * 16 + swz / 64; C = (st & 1) * 32 + (swz % 64) / 2; }
__host__ __device__ __forceinline__ int perm32(int rho) { const int n = rho >> 4, i = rho & 15; return 8 * (i >> 2) + 4 * n + (i & 3); }

struct Unit { int pm, pn; };
struct Gemm { const bf16_t* A; const bf16_t* Bt; int M, N, K; };

struct StaticOrder {
    int nM, nN, nwg, G, c;
    __host__ __device__ void init(int M, int N, int G_, int c_) { nM = M / BM; nN = N / BM; nwg = nM * nN; G = G_; c = c_; }
    __host__ __device__ bool next(int i, Unit& u) const {
        const long L = (long)i * G + c; if (L >= nwg) return false;
        int wgid = (int)L; { const int q = nwg / NXCD, r = nwg % NXCD, xcd = wgid % NXCD, off = wgid / NXCD; wgid = (xcd < r ? xcd * (q + 1) : r * (q + 1) + (xcd - r) * q) + off; }
        const int nig = WGM * nN, gid = wgid / nig, fm = gid * WGM, gsz = (nM - fm) < WGM ? (nM - fm) : WGM;
        u.pm = fm + ((wgid % nig) % gsz); u.pn = (wgid % nig) / gsz; return true;
    }
    __device__ __forceinline__ void a_ready(const Unit&) const {}
    __device__ __forceinline__ void done(const Unit&) const {}
};

__device__ __forceinline__ unsigned cvt_pk_bf16(float lo, float hi) { unsigned r; asm volatile("v_cvt_pk_bf16_f32 %0, %1, %2" : "=v"(r) : "v"(lo), "v"(hi)); return r; }
typedef float f32x2 __attribute__((ext_vector_type(2)));
__device__ __forceinline__ f32x2 gelu_pk(f32x2 v) {
    const f32x2 av = __builtin_elementwise_abs(v), d = av * 0.2316418882f + 1.0f;
    f32x2 t; t.x = __builtin_amdgcn_rcpf(d.x); t.y = __builtin_amdgcn_rcpf(d.y);
    f32x2 q = t * 0.5307027145f + (-0.7265760135f); q = q * t + 0.7107068705f; q = q * t + (-0.142248368f); q = q * t + 0.127414796f; q = q * t;
    const f32x2 s = (v * v) * (-0.72134752044f);
    f32x2 e; e.x = __builtin_amdgcn_exp2f(s.x); e.y = __builtin_amdgcn_exp2f(s.y);
    const f32x2 m = v * (q * e), r = v - m;
    f32x2 o; o.x = v.x < 0.f ? m.x : r.x; o.y = v.y < 0.f ? m.y : r.y; return o;
}

template <class Epi, class Sched, bool ALIGN_EPI = false, bool SP2 = false>
__device__ __forceinline__ void gemm_phase(PG8_LAS unsigned char* lds, const Gemm g, const Sched& S, const Epi& E) {
    const int tid = threadIdx.x, wid = __builtin_amdgcn_readfirstlane(tid >> 6), lane = tid & 63, wr = wid >> 2, wc = wid & 3, fr = lane & 15, fq = lane >> 4;
    const int K = g.K, nt = K / BK;
    unsigned voffA[2], voffB[2];
#pragma unroll
    for (int i = 0; i < 2; ++i) { int R, C; stage_rc(tid * 16 + i * 8192, R, C); const int Rb = Epi::PERM ? ((R & ~31) + perm32(R & 31)) : R;
        voffA[i] = (unsigned)(R * K + C) * 2u; voffB[i] = (unsigned)(Rb * K + C) * 2u; }
    const size_t kstep = (size_t)(BK * 2);
    const size_t hstep = (size_t)HALF * K * 2;
    const size_t tstep = 2 * hstep;
    const unsigned ldsw = (unsigned)wid * 1024u;
    const int aoff = lds_byte(wr * 64 + fr, fq * 8), boff = lds_byte(wc * 32 + fr, fq * 8);
#define PG8_SA(b, h) (((b) * 2 + (h)) * HTB)
#define PG8_SB(b, h) ((4 + (b) * 2 + (h)) * HTB)
#define PG8_STAGE(bufoff, gbase, voff) do { _Pragma("unroll") for (int _i = 0; _i < 2; ++_i) \
        __builtin_amdgcn_global_load_lds((const unsigned*)((const char*)(gbase) + (voff)[_i]), (PG8_LAS unsigned*)(lds + (bufoff) + ldsw + _i * 8192), 16, 0, 0); } while (0)
#define PG8_LDA(dst, b, h) do { _Pragma("unroll") for (int m = 0; m < 4; ++m) _Pragma("unroll") for (int k = 0; k < 2; ++k) dst[m][k] = *(const PG8_LAS bf16x8*)(lds + PG8_SA(b, h) + aoff + m * 2048 + k * 1024); } while (0)
#define PG8_LDB(dst, b, h) do { _Pragma("unroll") for (int n = 0; n < 2; ++n) _Pragma("unroll") for (int k = 0; k < 2; ++k) dst[n][k] = *(const PG8_LAS bf16x8*)(lds + PG8_SB(b, h) + boff + n * 2048 + k * 1024); } while (0)
#define PG8_MMA(ai, bj, At, Bt) do { __builtin_amdgcn_s_setprio(1); _Pragma("unroll") for (int m = 0; m < 4; ++m) _Pragma("unroll") for (int n = 0; n < 2; ++n) _Pragma("unroll") for (int k = 0; k < 2; ++k) \
        acc[ai][bj][m][n] = __builtin_amdgcn_mfma_f32_16x16x32_bf16(Bt[n][k], At[m][k], acc[ai][bj][m][n], 0, 0, 0); __builtin_amdgcn_s_setprio(0); } while (0)
#define PG8_WAIT_V(n) asm volatile("s_waitcnt vmcnt(" #n ")" ::: "memory")
#define PG8_WAIT_L(n) asm volatile("s_waitcnt lgkmcnt(" #n ")" ::: "memory")
#define PG8_BAR __builtin_amdgcn_s_barrier()
#define PG8_SCHED __builtin_amdgcn_sched_barrier(0)
    Unit cur, nxt; int ui = 0;
    if (!S.next(0, cur)) return;
    f32x4 acc[2][2][4][2];
#pragma unroll
    for (int a = 0; a < 2; ++a)
#pragma unroll
        for (int b = 0; b < 2; ++b)
#pragma unroll
            for (int m = 0; m < 4; ++m)
#pragma unroll
                for (int n = 0; n < 2; ++n) acc[a][b][m][n] = (f32x4){0.f, 0.f, 0.f, 0.f};
    bf16x8 At[4][2], B0[2][2], B1[2][2];
    const char* cA = (const char*)g.A + (size_t)cur.pm * tstep; const char* cB = (const char*)g.Bt + (size_t)cur.pn * tstep;
    S.a_ready(cur);
    if constexpr (SP2) {
        PG8_STAGE(PG8_SB(0, 0), cB, voffB); PG8_STAGE(PG8_SB(0, 1), cB + hstep, voffB); PG8_STAGE(PG8_SA(0, 0), cA, voffA); PG8_STAGE(PG8_SA(0, 1), cA + hstep, voffA);
        if (wr == 1) PG8_BAR;
        PG8_WAIT_V(2); PG8_BAR;
        PG8_STAGE(PG8_SB(1, 0), cB + kstep, voffB); PG8_STAGE(PG8_SA(1, 0), cA + kstep, voffA); PG8_STAGE(PG8_SB(1, 1), cB + hstep + kstep, voffB);
        PG8_WAIT_V(6); PG8_BAR;
    } else {
        PG8_STAGE(PG8_SB(0, 0), cB, voffB); PG8_STAGE(PG8_SA(0, 0), cA, voffA); PG8_STAGE(PG8_SB(0, 1), cB + hstep, voffB); PG8_STAGE(PG8_SA(0, 1), cA + hstep, voffA);
        if (wr == 1) PG8_BAR;
        PG8_WAIT_V(4); PG8_BAR;
        PG8_STAGE(PG8_SB(1, 0), cB + kstep, voffB); PG8_STAGE(PG8_SA(1, 0), cA + kstep, voffA); PG8_STAGE(PG8_SB(1, 1), cB + hstep + kstep, voffB);
        PG8_WAIT_V(6); PG8_BAR;
    }
    for (;;) {
        const bool has_next = S.next(ui + 1, nxt);
        const char* nA = has_next ? (const char*)g.A + (size_t)nxt.pm * tstep : cA; const char* nB = has_next ? (const char*)g.Bt + (size_t)nxt.pn * tstep : cB;
        for (int t = 0; t < nt; t += 2) {
            const bool last = (t == nt - 2);
            const char* a1 = cA + (size_t)(t + 1) * kstep;
            const char* a2 = last ? nA : cA + (size_t)(t + 2) * kstep; const char* b2 = last ? nB : cB + (size_t)(t + 2) * kstep;
            const char* a3 = a2 + kstep; const char* b3 = b2 + kstep;
            if (last && has_next) S.a_ready(nxt);
            if constexpr (SP2) {
            PG8_LDB(B0, 0, 0); PG8_LDB(B1, 0, 1); PG8_SCHED; PG8_LDA(At, 0, 0); PG8_STAGE(PG8_SA(1, 1), a1 + hstep, voffA);
            PG8_WAIT_V(8); PG8_WAIT_L(0); PG8_BAR; PG8_MMA(0, 0, At, B0); PG8_MMA(0, 1, At, B1); PG8_BAR; PG8_SCHED;
            PG8_LDA(At, 0, 1); PG8_STAGE(PG8_SB(0, 0), b2, voffB); PG8_STAGE(PG8_SB(0, 1), b2 + hstep, voffB); PG8_STAGE(PG8_SA(0, 0), a2, voffA);
            PG8_WAIT_V(8); PG8_WAIT_L(0); PG8_BAR; PG8_MMA(1, 0, At, B0); PG8_MMA(1, 1, At, B1); PG8_BAR; PG8_SCHED;
            PG8_LDB(B0, 1, 0); PG8_LDB(B1, 1, 1); PG8_SCHED; PG8_LDA(At, 1, 0); PG8_STAGE(PG8_SA(0, 1), a2 + hstep, voffA);
            PG8_WAIT_V(8); PG8_WAIT_L(0); PG8_BAR; PG8_MMA(0, 0, At, B0); PG8_MMA(0, 1, At, B1); PG8_BAR; PG8_SCHED;
            PG8_LDA(At, 1, 1); PG8_STAGE(PG8_SB(1, 0), b3, voffB); PG8_STAGE(PG8_SB(1, 1), b3 + hstep, voffB); PG8_STAGE(PG8_SA(1, 0), a3, voffA);
            PG8_WAIT_V(8); PG8_WAIT_L(0); PG8_BAR; PG8_MMA(1, 0, At, B0); PG8_MMA(1, 1, At, B1); PG8_BAR; PG8_SCHED;
            } else {
            PG8_LDB(B0, 0, 0); PG8_SCHED; PG8_LDA(At, 0, 0); PG8_STAGE(PG8_SA(1, 1), a1 + hstep, voffA);
            PG8_WAIT_L(8); PG8_BAR; PG8_WAIT_L(0); PG8_MMA(0, 0, At, B0); PG8_BAR; PG8_SCHED;
            PG8_LDB(B1, 0, 1); PG8_STAGE(PG8_SB(0, 0), b2, voffB);
            PG8_BAR; PG8_WAIT_L(0); PG8_MMA(0, 1, At, B1); PG8_BAR;
            PG8_LDA(At, 0, 1); PG8_STAGE(PG8_SA(0, 0), a2, voffA);
            PG8_BAR; PG8_WAIT_L(0); PG8_MMA(1, 0, At, B0); PG8_BAR; PG8_SCHED;
            PG8_STAGE(PG8_SB(0, 1), b2 + hstep, voffB);
            PG8_WAIT_V(6); PG8_BAR; PG8_MMA(1, 1, At, B1); PG8_BAR;
            PG8_LDB(B0, 1, 0); PG8_SCHED; PG8_LDA(At, 1, 0); PG8_STAGE(PG8_SA(0, 1), a2 + hstep, voffA);
            PG8_WAIT_L(8); PG8_BAR; PG8_WAIT_L(0); PG8_MMA(0, 0, At, B0); PG8_BAR; PG8_SCHED;
            PG8_LDB(B1, 1, 1); PG8_STAGE(PG8_SB(1, 0), b3, voffB);
            PG8_BAR; PG8_WAIT_L(0); PG8_MMA(0, 1, At, B1); PG8_BAR;
            PG8_LDA(At, 1, 1); PG8_STAGE(PG8_SA(1, 0), a3, voffA);
            PG8_BAR; PG8_WAIT_L(0); PG8_MMA(1, 0, At, B0); PG8_BAR; PG8_SCHED;
            PG8_STAGE(PG8_SB(1, 1), b3 + hstep, voffB);
            PG8_WAIT_V(6); PG8_BAR; PG8_MMA(1, 1, At, B1); PG8_BAR;
            }
        }
        if constexpr (ALIGN_EPI) { if (wr == 0) PG8_BAR; }
        if constexpr (!Epi::AFTER_DRAIN) { E(acc, cur, wr, wc, fr, fq); S.done(cur); }
        if (!has_next) break;
#pragma unroll
        for (int a = 0; a < 2; ++a)
#pragma unroll
            for (int b = 0; b < 2; ++b)
#pragma unroll
                for (int m = 0; m < 4; ++m)
#pragma unroll
                    for (int n = 0; n < 2; ++n) acc[a][b][m][n] = (f32x4){0.f, 0.f, 0.f, 0.f};
        cur = nxt; cA = nA; cB = nB; ++ui;
        if constexpr (ALIGN_EPI) { if (wr == 1) PG8_BAR; }
    }
    PG8_WAIT_V(0);
    if constexpr (!ALIGN_EPI) { if (wr == 0) PG8_BAR; }
    PG8_BAR;
    if constexpr (Epi::AFTER_DRAIN) { E.fused(acc, cur, wr, wc, fr, fq, lds, wid, lane); S.done(cur); }
#undef PG8_SA
#undef PG8_SB
#undef PG8_STAGE
#undef PG8_LDA
#undef PG8_LDB
#undef PG8_MMA
#undef PG8_WAIT_V
#undef PG8_WAIT_L
#undef PG8_BAR
#undef PG8_SCHED
}
}
namespace pg8 {
__device__ __forceinline__ float gelu_tanh(float x) {
    const float y2 = x * (1.5957691216057308f + 0.07135481627613502f * x * x);
    const float e = __builtin_amdgcn_exp2f(-1.4426950408889634f * y2);
    return x * __builtin_amdgcn_rcpf(1.0f + e);
}
struct EpiInProj {
    static constexpr bool PERM = true, AFTER_DRAIN = false;
    bf16_t* Oq; size_t region_stride; const float* rope; float qscale;
    __device__ __forceinline__ void operator()(const f32x4 (&acc)[2][2][4][2], const Unit& u, int wr, int wc, int fr, int fq) const {
        const int region = u.pn >> 2;
        bf16_t* base = Oq + (size_t)region * region_stride;
        const int row0 = u.pm * BM + wr * 64 + fr, col0 = (u.pn & 3) * 256 + wc * 32 + 8 * fq;
        const bool do_rope = (region < 2) && ((wc & 1) == 0) && (fq < 2);
        const bool do_gelu = (region >= 3);
        const float sc = (region == 0) ? qscale : 1.f;
#pragma unroll
        for (int ai = 0; ai < 2; ++ai)
#pragma unroll
            for (int m = 0; m < 4; ++m) { const int row = row0 + ai * HALF + m * 16; bf16_t* rowp = base + (size_t)row * 1024 + col0;
                f32x4 cs0 = (f32x4){1.f, 0.f, 1.f, 0.f}, cs1 = (f32x4){1.f, 0.f, 1.f, 0.f};
                if (do_rope) { const float* rp = rope + ((size_t)(row & 16383) * 8 + 4 * fq) * 2; cs0 = *(const f32x4*)rp; cs1 = *(const f32x4*)(rp + 4); }
#pragma unroll
                for (int bj = 0; bj < 2; ++bj) { f32x4 v0 = acc[ai][bj][m][0], v1 = acc[ai][bj][m][1];
                    if (do_rope) {
                        f32x4 r0, r1;
                        r0[0] = v0[0] * cs0[0] - v0[1] * cs0[1]; r0[1] = v0[1] * cs0[0] + v0[0] * cs0[1];
                        r0[2] = v0[2] * cs0[2] - v0[3] * cs0[3]; r0[3] = v0[3] * cs0[2] + v0[2] * cs0[3];
                        r1[0] = v1[0] * cs1[0] - v1[1] * cs1[1]; r1[1] = v1[1] * cs1[0] + v1[0] * cs1[1];
                        r1[2] = v1[2] * cs1[2] - v1[3] * cs1[3]; r1[3] = v1[3] * cs1[2] + v1[2] * cs1[3];
                        v0 = r0; v1 = r1; }
                    if (do_gelu) {
#pragma unroll
                        for (int e = 0; e < 4; ++e) { v0[e] = gelu_tanh(v0[e]); v1[e] = gelu_tanh(v1[e]); } }
                    v0 = v0 * sc; v1 = v1 * sc; u32x4 w; w.x = cvt_pk_bf16(v0[0], v0[1]); w.y = cvt_pk_bf16(v0[2], v0[3]); w.z = cvt_pk_bf16(v1[0], v1[1]); w.w = cvt_pk_bf16(v1[2], v1[3]);
                    *(u32x4*)(rowp + bj * HALF) = w; } }
    }
};
struct EpiF32Res {
    static constexpr bool PERM = false, AFTER_DRAIN = false;
    float* C; int ldc; const float* R;
    __device__ __forceinline__ void operator()(const f32x4 (&acc)[2][2][4][2], const Unit& u, int wr, int wc, int fr, int fq) const {
        const int row0 = u.pm * BM + wr * 64 + fr, col0 = u.pn * BM + wc * 32 + 4 * fq;
#pragma unroll
        for (int ai = 0; ai < 2; ++ai)
#pragma unroll
            for (int m = 0; m < 4; ++m) { const size_t off = (size_t)(row0 + ai * HALF + m * 16) * ldc + col0;
#pragma unroll
                for (int bj = 0; bj < 2; ++bj)
#pragma unroll
                    for (int n = 0; n < 2; ++n) { f32x4 v = acc[ai][bj][m][n]; if (R) v = v + *(const f32x4*)(R + off + bj * HALF + n * 16); *(f32x4*)(C + off + bj * HALF + n * 16) = v; } }
    }
};
}
#include <hip/hip_bf16.h>
#include <cmath>
namespace attn_body {
using bf16=__hip_bfloat16;
using bf16x8=__attribute__((ext_vector_type(8)))short;
using s16x4=__attribute__((ext_vector_type(4)))short;
using f32x16=__attribute__((ext_vector_type(16)))float;
using u32x4=__attribute__((ext_vector_type(4)))unsigned;
constexpr int BATCH=2,NHEAD=16,SEQ=16384,D=64,DM=NHEAD*D;
constexpr int NW=8,QBLK=32,QB=QBLK*NW,KVBLK=64,NQB=SEQ/QB;
constexpr int ATTN_PITCH=DM, ATTN_UNIT_ROWS=QB;
__device__ __forceinline__ int crow(int r,int hi){return (r&3)+8*(r>>2)+4*hi;}
#define SBAR() __builtin_amdgcn_sched_barrier(0)
__device__ __forceinline__ void cmask(f32x16&p0,f32x16&p1,int jb,int qrel,int hi){
  const float NEG=-INFINITY; (void)hi;
  if(jb>(qrel>>6)){
  #pragma unroll
  for(int r=0;r<16;++r){p0[r]=NEG;p1[r]=NEG;} }
}

constexpr int NSLOT=3, SLOTB=8192;
constexpr int LDS_K=0, LDS_V=NSLOT*SLOTB, LDS_WS=2*NSLOT*SLOTB, LDS_OST=LDS_WS+NW*64*4, LDS_BYTES=LDS_OST+NW*4096;
constexpr float C2=0.125f*1.4426950408889634f;
__device__ __forceinline__ void glds16(const void*gsrc,unsigned lds_dst){unsigned keep;
  asm volatile("s_mov_b32 %0, m0\n\ts_mov_b32 m0, %2\n\ts_nop 0\n\tglobal_load_lds_dwordx4 %1, off\n\ts_mov_b32 m0, %0":"=&s"(keep):"v"(gsrc),"s"(lds_dst):"memory");}
__device__ __forceinline__ float max3f(float a,float b,float c){float r;asm("v_max3_f32 %0, %1, %2, %3":"=v"(r):"v"(a),"v"(b),"v"(c));return r;}
__device__ __forceinline__ float max2f(float a,float b){float r;asm("v_max_f32_e32 %0, %1, %2":"=v"(r):"v"(a),"v"(b));return r;}
__device__ __forceinline__ float fadd_s(float a,float b){float r;asm("v_add_f32_e32 %0, %1, %2":"=v"(r):"v"(a),"v"(b));return r;}
__device__ __forceinline__ float fsub_s(float a,float b){float r;asm("v_sub_f32_e32 %0, %1, %2":"=v"(r):"v"(a),"v"(b));return r;}
typedef float f32x2_t __attribute__((ext_vector_type(2))); typedef __bf16 bf16x2_t __attribute__((ext_vector_type(2)));
__device__ __forceinline__ unsigned cvtpk_s(float lo,float hi){f32x2_t v={lo,hi};bf16x2_t b=__builtin_convertvector(v,bf16x2_t);return __builtin_bit_cast(unsigned,b);}
#define WAIT_BAR(N) asm volatile("s_waitcnt vmcnt(" #N ") lgkmcnt(0)\n\ts_barrier":::"memory")

__device__ __forceinline__ void qkt(f32x16&p0,f32x16&p1,const char*Kslot,const bf16x8*qr,const f32x16&negm,int r32,int hi){
  const char*kb=Kslot+hi*1024+r32*16;
  #pragma unroll
  for(int d0=0;d0<4;++d0){
    const bf16x8 b0=*reinterpret_cast<const bf16x8*>(kb+d0*2048);
    const bf16x8 b1=*reinterpret_cast<const bf16x8*>(kb+d0*2048+512);
    if(d0==0){p0=__builtin_amdgcn_mfma_f32_32x32x16_bf16(b0,qr[0],negm,0,0,0);p1=__builtin_amdgcn_mfma_f32_32x32x16_bf16(b1,qr[0],negm,0,0,0);}
    else{p0=__builtin_amdgcn_mfma_f32_32x32x16_bf16(b0,qr[d0],p0,0,0,0);p1=__builtin_amdgcn_mfma_f32_32x32x16_bf16(b1,qr[d0],p1,0,0,0);}}
}
typedef __attribute__((address_space(3))) const char* lds_cptr;
typedef short v4i16_t __attribute__((ext_vector_type(4)));
__device__ __forceinline__ void kload8(bf16x8*kf,lds_cptr kp){
  kf[0]=*(const __attribute__((address_space(3))) bf16x8*)(kp);      kf[1]=*(const __attribute__((address_space(3))) bf16x8*)(kp+512);
  kf[2]=*(const __attribute__((address_space(3))) bf16x8*)(kp+2048); kf[3]=*(const __attribute__((address_space(3))) bf16x8*)(kp+2560);
  kf[4]=*(const __attribute__((address_space(3))) bf16x8*)(kp+4096); kf[5]=*(const __attribute__((address_space(3))) bf16x8*)(kp+4608);
  kf[6]=*(const __attribute__((address_space(3))) bf16x8*)(kp+6144); kf[7]=*(const __attribute__((address_space(3))) bf16x8*)(kp+6656);
}
__device__ __forceinline__ void kload2(bf16x8*kf,lds_cptr kp,int j){ kf[2*j]=*(const __attribute__((address_space(3))) bf16x8*)(kp+j*2048); kf[2*j+1]=*(const __attribute__((address_space(3))) bf16x8*)(kp+j*2048+512); }
__device__ __forceinline__ s16x4 vtr(lds_cptr p){ return __builtin_bit_cast(s16x4,__builtin_amdgcn_ds_read_tr16_b64_v4i16((__attribute__((address_space(3))) v4i16_t*)p)); }
__device__ __forceinline__ float rowmax(const f32x16&p0,const f32x16&p1){
  float a=max3f(p0[0],p0[1],p1[0]),b=max3f(p0[2],p0[3],p1[1]);a=max3f(a,p1[2],p1[3]);
  #pragma unroll
  for(int r=4;r<16;r+=4){a=max3f(a,p0[r],p0[r+1]);b=max3f(b,p0[r+2],p0[r+3]);a=max3f(a,p1[r],p1[r+1]);b=max3f(b,p1[r+2],p1[r+3]);}
  const float m=max2f(a,b);
  auto rr=__builtin_amdgcn_permlane32_swap(__float_as_uint(m),__float_as_uint(m),false,false);
  return max2f(__uint_as_float(rr[0]),__uint_as_float(rr[1]));
}
__device__ __forceinline__ void pv(f32x16*o,int vb,bf16x8 pa0,bf16x8 pa1,bf16x8 pa2,bf16x8 pa3){
  #pragma unroll
  for(int d0=0;d0<2;++d0){s16x4 lo[4],hi[4];
    #pragma unroll
    for(int ks=0;ks<4;++ks){
      asm volatile("ds_read_b64_tr_b16 %0,%1 offset:%c2":"=&v"(lo[ks]):"v"(vb),"i"(d0*4096+ks*1024):"memory");
      asm volatile("ds_read_b64_tr_b16 %0,%1 offset:%c2":"=&v"(hi[ks]):"v"(vb),"i"(d0*4096+ks*1024+512):"memory");}
    asm volatile("s_waitcnt lgkmcnt(0)":::"memory");SBAR();
    #define PK(k) (bf16x8){lo[k][0],lo[k][1],lo[k][2],lo[k][3],hi[k][0],hi[k][1],hi[k][2],hi[k][3]}
    o[d0]=__builtin_amdgcn_mfma_f32_32x32x16_bf16(pa0,PK(0),o[d0],0,0,0);
    o[d0]=__builtin_amdgcn_mfma_f32_32x32x16_bf16(pa1,PK(1),o[d0],0,0,0);
    o[d0]=__builtin_amdgcn_mfma_f32_32x32x16_bf16(pa2,PK(2),o[d0],0,0,0);
    o[d0]=__builtin_amdgcn_mfma_f32_32x32x16_bf16(pa3,PK(3),o[d0],0,0,0);
    #undef PK
  }
}

#ifndef ATTN_STORE16
#define ATTN_STORE16(p,v) (*(u32x4*)(p)=(v))
#endif
template<int THRL> __device__ __forceinline__ void attn_unit(int b,int hq,int hv,int qb,const bf16*Q,const bf16*__restrict__ K,const bf16*__restrict__ V,bf16*O,char*shm){
  int tid_=threadIdx.x; asm volatile("":"+v"(tid_));
  const int tid=tid_,lane=tid&63,r32=lane&31,hi=lane>>5; const int wid=__builtin_amdgcn_readfirstlane(tid>>6);
  const long rowbase=(long)b*SEQ; const int q0=qb*QB;
  const bf16*Qw=Q+(rowbase+q0+wid*QBLK)*DM+hq*D;
  const bf16*Kh=K+rowbase*DM+hq*D,*Vh=V+rowbase*DM+hv*D;
  const unsigned lds0=(unsigned)(uintptr_t)shm;
  float*wsf=(float*)(shm+LDS_WS)+wid*64;
  const bf16*ksrc=Kh+(long)lane*DM+wid*8;
  const bf16*vsrc=Vh+(long)(16*(wid&3)+(lane>>2))*DM+(wid>>2)*32+(lane&3)*8;
  const unsigned kdst=lds0+LDS_K+wid*1024, vdst=lds0+LDS_V+wid*1024;
  #define DMA_K(t,slot) glds16(ksrc+(long)(t)*KVBLK*DM,(unsigned)__builtin_amdgcn_readfirstlane(kdst+(slot)))
  #define DMA_V(t,slot) glds16(vsrc+(long)(t)*KVBLK*DM,(unsigned)__builtin_amdgcn_readfirstlane(vdst+(slot)))
  const int vb0=(int)(lds0+LDS_V)+((lane>>4)&1)*32+(lane&3)*8+(4*hi+((lane&15)>>2))*64;
  const char*Kbase=shm+LDS_K; bf16x8 kf[8];
  const lds_cptr shm3=(lds_cptr)shm; const lds_cptr kp0=shm3+LDS_K+hi*1024+r32*16; const lds_cptr vp0=shm3+LDS_V+((lane>>4)&1)*32+(lane&3)*8+(4*hi+((lane&15)>>2))*64;
  const int NT=(q0+QB)/KVBLK;
  DMA_K(0,0);DMA_V(0,0);DMA_K(1,SLOTB);
  bf16x8 qr[4];
  #pragma unroll
  for(int d0=0;d0<4;++d0)qr[d0]=*reinterpret_cast<const bf16x8*>(&Qw[(long)r32*DM+d0*16+hi*8]);
  float mhat=0.f,l_reg=0.f;f32x16 o[2];o[0]=f32x16{};o[1]=f32x16{};f32x16 negm=f32x16{};asm volatile("":"+v"(negm));
  const int qrel=wid*QBLK+r32;
  #define CMASK(P0,P1,t) do{int jb_=(t)-(NT-4); if(jb_>=0)cmask(P0,P1,jb_,qrel,hi);}while(0)
  bool resc=false;
  #define START(P0,P1) do{ const float rm=rowmax(P0,P1); resc=false; \
    { const float dl=rm; mhat=fadd_s(mhat,dl); \
      _Pragma("unroll") for(int r=0;r<16;++r){P0[r]=fsub_s(P0[r],dl);P1[r]=fsub_s(P1[r],dl);} \
      _Pragma("unroll") for(int r=0;r<16;++r)negm[r]=-mhat; asm volatile("":"+v"(negm)); } \
    _Pragma("unroll") for(int r=0;r<16;++r)P0[r]=__builtin_amdgcn_exp2f(P0[r]); }while(0)
  #define RESC() do{ if(resc){ asm volatile("s_waitcnt lgkmcnt(0)":::"memory"); \
      _Pragma("unroll") for(int d_=0;d_<2;++d_) _Pragma("unroll") for(int r=0;r<16;++r)o[d_][r]*=wsf[crow(r,hi)]; } }while(0)
  f32x16 pA0,pA1,pB0,pB1;
  int sl_prev=0,sl_cur=0,sl_next=SLOTB;
  #define ROT() do{sl_prev=sl_cur;sl_cur=sl_next;sl_next=(sl_next==(NSLOT-1)*SLOTB)?0:sl_next+SLOTB;}while(0)
  DMA_K(2,2*SLOTB);
  WAIT_BAR(3);
  qkt(pA0,pA1,Kbase,qr,negm,r32,hi);asm volatile("s_nop 15\n\ts_nop 7":"+v"(pA0),"+v"(pA1));CMASK(pA0,pA1,0);
  START(pA0,pA1);
  _Pragma("unroll") for(int r=0;r<16;++r)pA1[r]=__builtin_amdgcn_exp2f(pA1[r]);
  WAIT_BAR(0);
  DMA_K(3,0);DMA_V(1,SLOTB);
  ROT();
  kload8(kf,kp0+sl_cur);
  WAIT_BAR(2);
  s16x4 vlo[8],vhi[8]; u32x4 pw0,pw1,pw2,pw3;
  #define PKW(P,B) cvtpk_s(P[B],P[B+1])
  #define PAF(k) __builtin_bit_cast(bf16x8,pw##k)
  #define VFR(i) (bf16x8){vlo[i][0],vlo[i][1],vlo[i][2],vlo[i][3],vhi[i][0],vhi[i][1],vhi[i][2],vhi[i][3]}
  #define PIN(x) asm volatile("":"+v"(x))
  #define MX3(a,b,c) __builtin_fmaxf(__builtin_fmaxf((a),(b)),(c))
  #define GAPA(MF,A0,A1,A2,A3,W0,W1,PW) do{ MF; sacc+=A0; sacc+=A1; sacc+=A2; sacc+=A3; PIN(sacc); W0; W1; PIN(PW); SBAR(); }while(0)
  #define EX(v) __builtin_amdgcn_exp2f(v)
  #define GAPB(MF,X,B) do{ MF; X[B]=EX(X[B]); X[B+1]=EX(X[B+1]); X[B+2]=EX(X[B+2]); X[B+3]=EX(X[B+3]); PIN(X); SBAR(); }while(0)
  #define VRD(i) do{ vlo[i]=vtr(vp_+(((i)>>2)*4096+((i)&3)*1024)); vhi[i]=vtr(vp_+(((i)>>2)*4096+((i)&3)*1024+512)); }while(0)
  #define KRD(G,j) do{ if(G){ kload2(kf,kp0+sl_next,j); SBAR(); } }while(0)
  #define STEP(C0,C1,P0,P1,t,GK,GV,GL) do{ SBAR(); \
    const lds_cptr vp_=vp0+sl_prev; \
    VRD(0); SBAR(); float sacc=(P0[0]+P0[1]); \
    GAPA(C0=__builtin_amdgcn_mfma_f32_32x32x16_bf16(kf[0],qr[0],negm,0,0,0), P0[2],P0[3],P0[4],P0[5],     pw0[0]=PKW(P0,0), pw0[1]=PKW(P0,2), pw0); \
    VRD(4); SBAR(); GAPA(C1=__builtin_amdgcn_mfma_f32_32x32x16_bf16(kf[1],qr[0],negm,0,0,0), P0[6],P0[7],P0[8],P0[9],     pw0[2]=PKW(P0,4), pw0[3]=PKW(P0,6), pw0); \
    VRD(1); SBAR(); GAPA(C0=__builtin_amdgcn_mfma_f32_32x32x16_bf16(kf[2],qr[1],C0,0,0,0),   P0[10],P0[11],P0[12],P0[13], pw1[0]=PKW(P0,8), pw1[1]=PKW(P0,10), pw1); \
    VRD(5); SBAR(); GAPA(C1=__builtin_amdgcn_mfma_f32_32x32x16_bf16(kf[3],qr[1],C1,0,0,0),   P0[14],P0[15],P1[0],P1[1],   pw1[2]=PKW(P0,12),pw1[3]=PKW(P0,14), pw1); \
    VRD(2); SBAR(); GAPA(C0=__builtin_amdgcn_mfma_f32_32x32x16_bf16(kf[4],qr[2],C0,0,0,0),   P1[2],P1[3],P1[4],P1[5],     pw2[0]=PKW(P1,0), pw2[1]=PKW(P1,2), pw2); \
    VRD(6); SBAR(); GAPA(C1=__builtin_amdgcn_mfma_f32_32x32x16_bf16(kf[5],qr[2],C1,0,0,0),   P1[6],P1[7],P1[8],P1[9],     pw2[2]=PKW(P1,4), pw2[3]=PKW(P1,6), pw2); \
    VRD(3); SBAR(); GAPA(C0=__builtin_amdgcn_mfma_f32_32x32x16_bf16(kf[6],qr[3],C0,0,0,0),   P1[10],P1[11],P1[12],P1[13], pw3[0]=PKW(P1,8), pw3[1]=PKW(P1,10), pw3); \
    VRD(7); SBAR(); GAPA(C1=__builtin_amdgcn_mfma_f32_32x32x16_bf16(kf[7],qr[3],C1,0,0,0),   P1[14],P1[15],0.f,0.f,       pw3[2]=PKW(P1,12),pw3[3]=PKW(P1,14), pw3); \
    l_reg+=sacc; \
    if(GK){DMA_K((t)+3,sl_cur);} if(GV){DMA_V((t)+1,sl_next);} \
    CMASK(C0,C1,t); \
    { float a=MX3(C0[0],C0[1],C1[0]),b=MX3(C0[2],C0[3],C1[1]); a=MX3(a,C1[2],C1[3]); \
      _Pragma("unroll") for(int r=4;r<16;r+=4){a=MX3(a,C0[r],C0[r+1]);b=MX3(b,C0[r+2],C0[r+3]);a=MX3(a,C1[r],C1[r+1]);b=MX3(b,C1[r+2],C1[r+3]);} \
      float rm=__builtin_fmaxf(a,b); { auto rr=__builtin_amdgcn_permlane32_swap(__float_as_uint(rm),__float_as_uint(rm),false,false); rm=__builtin_fmaxf(__uint_as_float(rr[0]),__uint_as_float(rr[1])); } \
      resc=false; \
      if(__builtin_expect(__any(rm>(float)THRL),0)){ const float dl=__builtin_fmaxf(rm,0.f); mhat+=dl; \
        _Pragma("unroll") for(int r=0;r<16;++r){C0[r]-=dl;C1[r]-=dl;} \
        _Pragma("unroll") for(int r=0;r<16;++r)negm[r]=-mhat; asm volatile("":"+v"(negm)); \
        const float f=__builtin_amdgcn_exp2f(-dl); l_reg*=f; if(hi==0)wsf[r32]=f; resc=true; } } \
    SBAR(); \
    GAPB(o[0]=__builtin_amdgcn_mfma_f32_32x32x16_bf16(PAF(0),VFR(0),o[0],0,0,0), C0,0); \
    GAPB(o[1]=__builtin_amdgcn_mfma_f32_32x32x16_bf16(PAF(0),VFR(4),o[1],0,0,0), C0,4); \
    KRD(GL,0); GAPB(o[0]=__builtin_amdgcn_mfma_f32_32x32x16_bf16(PAF(1),VFR(1),o[0],0,0,0), C0,8); \
    KRD(GL,1); GAPB(o[1]=__builtin_amdgcn_mfma_f32_32x32x16_bf16(PAF(1),VFR(5),o[1],0,0,0), C0,12); \
    KRD(GL,2); GAPB(o[0]=__builtin_amdgcn_mfma_f32_32x32x16_bf16(PAF(2),VFR(2),o[0],0,0,0), C1,0); \
    KRD(GL,3); GAPB(o[1]=__builtin_amdgcn_mfma_f32_32x32x16_bf16(PAF(2),VFR(6),o[1],0,0,0), C1,4); \
    GAPB(o[0]=__builtin_amdgcn_mfma_f32_32x32x16_bf16(PAF(3),VFR(3),o[0],0,0,0), C1,8); \
    GAPB(o[1]=__builtin_amdgcn_mfma_f32_32x32x16_bf16(PAF(3),VFR(7),o[1],0,0,0), C1,12); \
    }while(0)
  int t=1;
  #undef CMASK
  #define CMASK(P0,P1,t) do{}while(0)
  for(;t+5<NT;t+=2){
    STEP(pB0,pB1,pA0,pA1,t,true,true,true);     WAIT_BAR(2); RESC(); ROT();
    STEP(pA0,pA1,pB0,pB1,t+1,true,true,true);   WAIT_BAR(2); RESC(); ROT();
  }
  #undef CMASK
  #define CMASK(P0,P1,t) do{int jb_=(t)-(NT-4); if(jb_>=0)cmask(P0,P1,jb_,qrel,hi);}while(0)
  #define ENDW(tt) do{ if((tt)+3<NT){WAIT_BAR(2);} else if((tt)+2<NT){WAIT_BAR(1);} else {WAIT_BAR(0);} }while(0)
  for(;t+1<NT;t+=2){
    STEP(pB0,pB1,pA0,pA1,t,(t+3<NT),(t+1<NT),(t+1<NT));       ENDW(t);   RESC(); ROT();
    STEP(pA0,pA1,pB0,pB1,t+1,(t+4<NT),(t+2<NT),(t+2<NT));     ENDW(t+1); RESC(); ROT();
  }
  STEP(pB0,pB1,pA0,pA1,NT-1,false,false,false); RESC();
  { float sacc=pB0[0]+pB0[1]; _Pragma("unroll") for(int r=2;r<16;++r)sacc+=pB0[r]; _Pragma("unroll") for(int r=0;r<16;++r)sacc+=pB1[r]; l_reg+=sacc;
    pw0=(u32x4){PKW(pB0,0),PKW(pB0,2),PKW(pB0,4),PKW(pB0,6)};pw1=(u32x4){PKW(pB0,8),PKW(pB0,10),PKW(pB0,12),PKW(pB0,14)};pw2=(u32x4){PKW(pB1,0),PKW(pB1,2),PKW(pB1,4),PKW(pB1,6)};pw3=(u32x4){PKW(pB1,8),PKW(pB1,10),PKW(pB1,12),PKW(pB1,14)};
    SBAR(); pv(o,vb0+sl_cur,PAF(0),PAF(1),PAF(2),PAF(3)); }
  #undef PKW
  #undef PAF
  #undef VFR
  #undef PIN
  #undef MX3
  #undef GAPA
  #undef GAPB
  #undef EX
  #undef VRD
  #undef KRD
  #undef STEP
  #undef ENDW
  {auto rr=__builtin_amdgcn_permlane32_swap(__float_as_uint(l_reg),__float_as_uint(l_reg),false,false);l_reg=__uint_as_float(rr[0])+__uint_as_float(rr[1]);}
  if(hi==0)wsf[32+r32]=l_reg;asm volatile("s_waitcnt lgkmcnt(0)":::"memory");
  float rli[16];
  #pragma unroll
  for(int r=0;r<16;++r)rli[r]=__builtin_amdgcn_rcpf(wsf[32+crow(r,hi)]);
  bf16*Ow=O+(rowbase+q0+wid*QBLK)*DM+hv*D;
  { bf16*stg=(bf16*)(shm+LDS_OST)+wid*2048;
    #pragma unroll
    for(int r=0;r<16;++r){const int orow=crow(r,hi);
      #pragma unroll
      for(int d0=0;d0<2;++d0)stg[orow*64+d0*32+r32]=__float2bfloat16(o[d0][r]*rli[r]);}
    asm volatile("s_waitcnt lgkmcnt(0)":::"memory");
    #pragma unroll
    for(int i=0;i<4;++i){const int row=i*8+(lane>>3),ch=lane&7; const u32x4 v=*(const u32x4*)(stg+row*64+ch*8); ATTN_STORE16(Ow+(long)row*DM+ch*8,v);} }
  asm volatile("s_waitcnt lgkmcnt(0)\n\ts_barrier":::"memory");
  #undef DMA_K
  #undef DMA_V
  #undef CMASK
  #undef START
  #undef RESC
  #undef ROT
}
constexpr int ATTN_LDS_BYTES=LDS_BYTES;
struct AttnTensors { const bf16* Q; const bf16* K; const bf16* V; bf16* O0; bf16* O1; };
template<int THRL=8> __device__ __forceinline__ void attn_phase(char*lds,const AttnTensors&T,int vcu){
  const int combo=vcu>>2, s=vcu&3, half=combo&1, m=(combo>>1)&1, h=(combo>>2)&7, b=combo>>5;
  bf16* O = m ? T.O1 : T.O0;
  for(int i=0;i<16;++i){ const int j=i>>1, q=4*j+s, qb=(i&1)?(63-q):q; attn_unit<THRL>(b,2*h+m,2*h+half,qb,T.Q,T.K,T.V,O,lds); }
}
#undef SBAR
#undef WAIT_BAR
}
constexpr int NWAVES = 8;
#ifndef MK_N_LAUNCHES
#define MK_N_LAUNCHES 9
#endif
constexpr int N_PHASES = 9;
constexpr int N_LAUNCHES = MK_N_LAUNCHES;
static_assert(N_LAUNCHES == 1 || N_LAUNCHES == N_PHASES, "MK_N_LAUNCHES is 1 or 9");

constexpr int T = 32768, SEQL = 16384, D = 2048, NIN = 5120;
constexpr float EPS = 1e-6f;
constexpr float LAMBDA_INIT = 0.2f;

constexpr size_t MiB = 1u << 20;
constexpr size_t WS_CTL = 0, CTL_ZERO_BYTES = 1 * MiB;
constexpr size_t WS_WIN = 2 * MiB;
constexpr size_t WS_WOUT = 22 * MiB;
constexpr size_t WS_WSC = 30 * MiB;
constexpr size_t WS_ROPE = 38 * MiB;
constexpr size_t WS_XN = 40 * MiB;
constexpr size_t WS_Q = 168 * MiB, WS_K = 232 * MiB, WS_V = 296 * MiB, WS_U = 360 * MiB, WS_Z = 424 * MiB;
constexpr size_t WS_O0 = 488 * MiB, WS_O1 = 552 * MiB;
constexpr size_t WS_MIX = 616 * MiB;
constexpr size_t WS_UT = 744 * MiB, WS_VT = 808 * MiB;
constexpr size_t WS_SC = 168 * MiB;
constexpr size_t WS_IDX = 872 * MiB, WS_GATE = 888 * MiB;
constexpr size_t WS_END = 904 * MiB;
static_assert(WS_SC + (size_t)2048 * T * 4 <= WS_Z, "SC overlay stays inside Q|K|V|U");
constexpr int CW_TMO = 0;
constexpr int CW_BAR = 4096;

constexpr int RING_OFF = 0, RING_BYTES = 131072;
constexpr int LDSCTL_OFF = RING_BYTES, MISC_OFF = LDSCTL_OFF + 320;
constexpr int SMALL_OFF = RING_BYTES + 1024;
constexpr int LDS_BYTES = 147456;
static_assert(MISC_OFF + 128 <= SMALL_OFF && SMALL_OFF + 4096 <= LDS_BYTES, "LDS map");

#define GAS __attribute__((address_space(1)))
#define LAS __attribute__((address_space(3)))
typedef unsigned short bf16;
typedef unsigned v4u __attribute__((ext_vector_type(4)));
typedef float f32x4 __attribute__((ext_vector_type(4)));
typedef short bf16x8 __attribute__((ext_vector_type(8)));
typedef GAS unsigned gu32;
typedef GAS unsigned long long gu64;
#define RLX_AGENT __ATOMIC_RELAXED, __HIP_MEMORY_SCOPE_AGENT
#define LDS_WAIT() asm volatile("s_waitcnt lgkmcnt(0)" ::: "memory")
#define VM_WAIT() asm volatile("s_waitcnt vmcnt(0)" ::: "memory")
__device__ __forceinline__ unsigned long long rt() { return __builtin_amdgcn_s_memrealtime(); }
__device__ __forceinline__ unsigned f2bf(float f) { unsigned u = __builtin_bit_cast(unsigned, f); return (u + 0x7fffu + ((u >> 16) & 1u)) >> 16; }
__device__ __forceinline__ unsigned pk2(float lo, float hi) { return f2bf(lo) | (f2bf(hi) << 16); }

#define XB_TMO      128
#define XB_XCNT(j)  (256  + 64 * (j))
#define XB_XSUB(j)  (1280 + 64 * (j))
#define XB_XGEN(j)  (2304 + 64 * (j))
#define XB_TOP      3328
#define XB_TOPGEN   3392
#define XCD_BAR_WORDS 3456
#define XB_SPIN_CAP (1u << 18)

__device__ __forceinline__ unsigned xb_ld(unsigned* p)              { return __hip_atomic_load(p, __ATOMIC_RELAXED, __HIP_MEMORY_SCOPE_AGENT); }
__device__ __forceinline__ unsigned xb_add(unsigned* p, unsigned v) { return __hip_atomic_fetch_add(p, v, __ATOMIC_RELAXED, __HIP_MEMORY_SCOPE_AGENT); }
__device__ __forceinline__ unsigned xb_xcc_id() { return (unsigned)__builtin_amdgcn_s_getreg((3 << 11) | 20) & 0xFu; }
#define XB_SPIN(cond, bar) do { unsigned _sp = 0; while (cond) { __builtin_amdgcn_s_sleep(1); \
    if ((++_sp & 255u) == 0u) { if (xb_ld(&(bar)[XB_TMO])) break; if (_sp > XB_SPIN_CAP) { atomicAdd(&(bar)[XB_TMO], 1u); break; } } } } while (0)

struct XcdBarrier {
    unsigned* bar; unsigned x;
    volatile LAS unsigned* st;
};

__device__ __forceinline__ XcdBarrier xcd_barrier_post(unsigned* bar, volatile LAS unsigned* st) {
    XcdBarrier b; b.bar = bar; b.x = xb_xcc_id(); b.st = st;
    if (threadIdx.x == 0) (void)xb_add(&bar[XB_XCNT(b.x)], 1u);
    return b;
}
__device__ __forceinline__ void xcd_barrier_complete(unsigned* bar, unsigned x, unsigned& nloc, unsigned& nx) {
    const unsigned G = gridDim.x * gridDim.y * gridDim.z;
    unsigned sum, cnt, mine, sp = 0u;
    for (;;) {
        sum = 0u; cnt = 0u; mine = 0u;
#pragma unroll
        for (unsigned j = 0; j < 16; ++j) { const unsigned c = xb_ld(&bar[XB_XCNT(j)]); sum += c; cnt += (c > 0u) ? 1u : 0u; mine = (j == x) ? c : mine; }
        if (sum == G) break;
        __builtin_amdgcn_s_sleep(1);
        if ((++sp & 255u) == 0u) { if (xb_ld(&bar[XB_TMO])) break; if (sp > XB_SPIN_CAP) { atomicAdd(&bar[XB_TMO], 1u); break; } }
    }
    nloc = mine > 0u ? mine : 1u; nx = cnt > 0u ? cnt : 1u;
}

__device__ __forceinline__ void xcd_barrier(const XcdBarrier& b) {
    asm volatile("s_waitcnt vmcnt(0)" ::: "memory");
    __syncthreads();
    if (threadIdx.x == 0) {
        unsigned* bar = b.bar;
        __builtin_amdgcn_s_waitcnt(0);
        unsigned nloc = b.st[0], nx = b.st[1];
        if (nloc == 0u) { xcd_barrier_complete(bar, b.x, nloc, nx); b.st[0] = nloc; b.st[1] = nx; }
        const unsigned old = xb_add(&bar[XB_XSUB(b.x)], 1u);
        const unsigned gen = old / nloc;
        if (old + 1u == (gen + 1u) * nloc) {
            __builtin_amdgcn_fence(__ATOMIC_RELEASE, "agent");
            asm volatile("s_waitcnt vmcnt(0)" ::: "memory");
            const unsigned og = xb_add(&bar[XB_TOP], 1u);
            const unsigned tg = og / nx;
            if (og + 1u == (tg + 1u) * nx) xb_add(&bar[XB_TOPGEN], 1u);
            else XB_SPIN(xb_ld(&bar[XB_TOPGEN]) == tg, bar);
            __builtin_amdgcn_fence(__ATOMIC_ACQUIRE, "agent");
            xb_add(&bar[XB_XGEN(b.x)], 1u);
            asm volatile("s_waitcnt vmcnt(0)" ::: "memory");
        } else {
            XB_SPIN(xb_ld(&bar[XB_XGEN(b.x)]) == gen, bar);
            __builtin_amdgcn_fence(__ATOMIC_ACQUIRE, "agent");
            asm volatile("s_waitcnt vmcnt(0)" ::: "memory");
        }
    }
    __syncthreads();
}


typedef unsigned long long u64;
typedef float f32x2v __attribute__((ext_vector_type(2)));
typedef __bf16 bf16x2_t __attribute__((ext_vector_type(2)));
__device__ __forceinline__ float bflo(unsigned u) { return __builtin_bit_cast(float, u << 16); }
__device__ __forceinline__ float bfhi(unsigned u) { return __builtin_bit_cast(float, u & 0xffff0000u); }
__device__ __forceinline__ float wave_sum(float v) {
#pragma unroll
    for (int o = 1; o < 64; o <<= 1) v += __shfl_xor(v, o);
    return v;
}
__device__ __forceinline__ float gelu_tanh(float x) { return pg8::gelu_tanh(x); }

__device__ const float c_invf[8] = {1.0f, 0.1939227432012558f, 0.03760603070259094f, 0.007292664609849453f, 0.0014142135623842478f, 0.00027424818836152554f, 5.318296098266728e-05f, 1.0313386155758053e-05f};

struct Args { const float* in[19]; float* out; unsigned char* ws; int ph_lo, ph_hi, li, pad; };
#define F_IN(k) (args.in[k])
#define F_WS(ty, off) ((ty*)(F.ws + (off)))
struct Frame {
    LAS unsigned char* lds;
    volatile LAS unsigned* MISC;
    gu32* ctl;
    int tid, lane, wave;
    int vcu, G;
    float* out; unsigned char* ws;
};

__device__ __forceinline__ void p0_transpose_item(const float* W, int K, int N, bf16* WT, LAS float* scr, int item, int lane, int rope_rows) {
    const int nblk = N / 32, kb = item / nblk, nb = item % nblk, k0 = 64 * kb, n0 = 32 * nb;
#pragma unroll 8
    for (int i = 0; i < 32; ++i) { const int kk = 2 * i + (lane >> 5); scr[kk * 33 + (lane & 31)] = W[(size_t)(k0 + kk) * N + n0 + (lane & 31)]; }
    LDS_WAIT(); asm volatile("" ::: "memory");
    const int c = lane & 7;
    const bool perm = (n0 < rope_rows) && ((n0 & 63) == 0);
#pragma unroll
    for (int j = 0; j < 4; ++j) { const int n = (lane >> 3) + 8 * j; const int src = (perm && n < 16) ? ((n >> 1) + 8 * (n & 1)) : n; const LAS float* s = scr + (8 * c) * 33 + src;
        v4u o; o.x = pk2(s[0 * 33], s[1 * 33]); o.y = pk2(s[2 * 33], s[3 * 33]); o.z = pk2(s[4 * 33], s[5 * 33]); o.w = pk2(s[6 * 33], s[7 * 33]);
        *(GAS v4u*)(WT + (size_t)(n0 + n) * K + k0 + 8 * c) = o; }
    LDS_WAIT(); asm volatile("" ::: "memory");
}
__device__ __forceinline__ void rms_row_to_bf16(const float* xrow, const float* g, bf16* orow, int lane) {
    const GAS f32x4* xr = (const GAS f32x4*)xrow + lane;
    f32x4 v[8]; float s = 0.f;
#pragma unroll
    for (int j = 0; j < 8; ++j) { v[j] = xr[64 * j]; s += (v[j].x * v[j].x + v[j].y * v[j].y) + (v[j].z * v[j].z + v[j].w * v[j].w); }
    const float r = 1.f / sqrtf(wave_sum(s) * (1.f / D) + EPS);
    const GAS f32x4* gr = (const GAS f32x4*)g + lane;
    GAS u64* o8 = (GAS u64*)orow + lane;
#pragma unroll
    for (int j = 0; j < 8; ++j) { const f32x4 gg = gr[64 * j]; o8[64 * j] = (u64)pk2(v[j].x * r * gg.x, v[j].y * r * gg.y) | ((u64)pk2(v[j].z * r * gg.z, v[j].w * r * gg.w) << 32); }
}
__device__ __forceinline__ void p0_wsc_item(Frame& F, const Args& args, int it) {
    const int g = it >> 5, kk0 = (it & 31) * 64;
    LAS float* sk = (LAS float*)(F.lds + RING_OFF);
    LAS float* wq = sk + 128 * 129;
    const float* skg = F_IN(15) + (size_t)g * 128 * 128;
    for (int i = F.tid; i < 128 * 32; i += NWAVES * 64) { const int k = i >> 5, d4 = (i & 31) * 4; const f32x4 v = *(const GAS f32x4*)(skg + k * 128 + d4);
        sk[k * 129 + d4] = v.x; sk[k * 129 + d4 + 1] = v.y; sk[k * 129 + d4 + 2] = v.z; sk[k * 129 + d4 + 3] = v.w; }
    for (int i = F.tid; i < 64 * 32; i += NWAVES * 64) { const int r = i >> 5, d4 = (i & 31) * 4; const f32x4 v = *(const GAS f32x4*)(F_IN(14) + (size_t)(kk0 + r) * 2048 + g * 128 + d4);
        wq[r * 129 + d4] = v.x; wq[r * 129 + d4 + 1] = v.y; wq[r * 129 + d4 + 2] = v.z; wq[r * 129 + d4 + 3] = v.w; }
    __syncthreads();
    const int kkl = F.tid & 63, kb = (F.tid >> 6) * 16;
    float acc[16];
#pragma unroll
    for (int j = 0; j < 16; ++j) acc[j] = 0.f;
    for (int d = 0; d < 128; ++d) { const float a = wq[kkl * 129 + d];
#pragma unroll
        for (int j = 0; j < 16; ++j) acc[j] += a * sk[(kb + j) * 129 + d]; }
#pragma unroll
    for (int j = 0; j < 16; ++j) F_WS(bf16, WS_WSC)[(size_t)(g * 128 + kb + j) * 2048 + kk0 + kkl] = (bf16)f2bf(acc[j]);
    __syncthreads();
}
__device__ __forceinline__ void p0_prologue(Frame& F, const Args& args) {
    LAS float* scr = (LAS float*)(F.lds + RING_OFF + F.wave * 16384);
    const int gw = F.vcu * NWAVES + F.wave, NGW = F.G * NWAVES;
    constexpr int I_IN = (D / 64) * (NIN / 32), I_OUT = (D / 64) * (D / 32);
    for (int it = gw; it < I_IN + I_OUT; it += NGW) {
        if (it < I_IN) p0_transpose_item(F_IN(2), D, NIN, F_WS(bf16, WS_WIN), scr, it, F.lane, 2048);
        else p0_transpose_item(F_IN(12), D, D, F_WS(bf16, WS_WOUT), scr, it - I_IN, F.lane, 0);
    }
    __syncthreads();
    for (int it = F.vcu; it < 512; it += F.G) p0_wsc_item(F, args, it);
    { const int gt = F.vcu * (NWAVES * 64) + F.tid, NGT = F.G * NWAVES * 64;
      for (int i = gt; i < SEQL * 8; i += NGT) { const int pos = i >> 3, f = i & 7;
          const float angf = (float)pos * c_invf[f];
          const double a = (double)angf, n = __builtin_rint(a * 0.15915494309189535);
          double r = __builtin_fma(-n, 6.283185307179586, a); r = __builtin_fma(-n, 2.4492935982947064e-16, r);
          const double r2 = r * r; double sn = 1.0, cs = 1.0;
#pragma unroll
          for (int k = 12; k >= 1; --k) { sn = 1.0 - r2 * (1.0 / (double)((2 * k) * (2 * k + 1))) * sn; cs = 1.0 - r2 * (1.0 / (double)((2 * k - 1) * (2 * k))) * cs; }
          sn *= r;
          *(GAS f32x2v*)(F_WS(float, WS_ROPE) + (size_t)i * 2) = (f32x2v){(float)cs, (float)sn}; } }
    { const size_t gt = (size_t)F.vcu * (NWAVES * 64) + F.tid, NGT = (size_t)F.G * NWAVES * 64, n8 = (size_t)16384 * 2048 / 8;
      for (size_t i = gt; i < 2 * n8; i += NGT) { const bool second = i >= n8; const size_t j = second ? i - n8 : i;
          const GAS f32x4* src = (const GAS f32x4*)(second ? F_IN(17) : F_IN(16)) + 2 * j; const f32x4 a = src[0], b = src[1];
          v4u o; o.x = pk2(a.x, a.y); o.y = pk2(a.z, a.w); o.z = pk2(b.x, b.y); o.w = pk2(b.z, b.w);
          *((GAS v4u*)(second ? F_WS(bf16, WS_VT) : F_WS(bf16, WS_UT)) + j) = o; } }
    for (int m = gw; m < T; m += NGW) rms_row_to_bf16(F_IN(0) + (size_t)m * D, F_IN(1), F_WS(bf16, WS_XN) + (size_t)m * D, F.lane);
}

__device__ __forceinline__ void combine_row(Frame& F, const Args& args, int t, float lam) {
#pragma unroll
    for (int j = 0; j < 2; ++j) { const size_t off = (size_t)t * 1024 + 8 * F.lane + 512 * j;
        const v4u a = *(const GAS v4u*)(F_WS(bf16, WS_O0) + off), b = *(const GAS v4u*)(F_WS(bf16, WS_O1) + off);
        float o[8]; float ss = 0.f;
#pragma unroll
        for (int i = 0; i < 4; ++i) { o[2 * i] = bflo(a[i]) - lam * bflo(b[i]); o[2 * i + 1] = bfhi(a[i]) - lam * bfhi(b[i]); ss += o[2 * i] * o[2 * i] + o[2 * i + 1] * o[2 * i + 1]; }
        ss += __shfl_xor(ss, 1); ss += __shfl_xor(ss, 2); ss += __shfl_xor(ss, 4); ss += __shfl_xor(ss, 8);
        const float r = (1.f - LAMBDA_INIT) / sqrtf(ss * (1.f / 128.f) + EPS);
        const int d0 = (8 * F.lane) & 127;
        const f32x4 g0 = *(const GAS f32x4*)(F_IN(7) + d0), g1 = *(const GAS f32x4*)(F_IN(7) + d0 + 4);
        v4u w; w.x = pk2(o[0] * r * g0.x, o[1] * r * g0.y); w.y = pk2(o[2] * r * g0.z, o[3] * r * g0.w); w.z = pk2(o[4] * r * g1.x, o[5] * r * g1.y); w.w = pk2(o[6] * r * g1.z, o[7] * r * g1.w);
        *(GAS v4u*)(F_WS(bf16, WS_MIX) + (size_t)t * 2048 + 8 * F.lane + 512 * j) = w; }
}
__device__ __forceinline__ void gmlp_unit(Frame& F, const Args& args, int unit) {
    LAS float* zn = (LAS float*)(F.lds + RING_OFF);
    LAS float* wt = zn + 128 * 128;
    LAS float* rowss = (LAS float*)(F.lds + SMALL_OFF);
    const int t0 = unit * 128;
    if (F.tid < 128) rowss[F.tid] = 0.f;
    const int tp = F.tid >> 5, tc = F.tid & 31, p0 = 8 * tp, c0 = 4 * tc;
    for (int g = 0; g < 8; ++g) {
        __syncthreads();
        { const int q = F.tid >> 2, cq = F.tid & 3;
          float zv[32]; float ss = 0.f;
#pragma unroll
          for (int j = 0; j < 4; ++j) { const v4u raw = *(const GAS v4u*)(F_WS(bf16, WS_Z) + (size_t)(t0 + q) * 1024 + g * 128 + 8 * cq + 32 * j);
#pragma unroll
              for (int i = 0; i < 4; ++i) { const float a = bflo(raw[i]), b = bfhi(raw[i]); zv[8 * j + 2 * i] = a; zv[8 * j + 2 * i + 1] = b; ss += a * a + b * b; } }
          ss += __shfl_xor(ss, 1); ss += __shfl_xor(ss, 2);
          const float r = 1.f / sqrtf(ss * (1.f / 128.f) + EPS);
#pragma unroll
          for (int j = 0; j < 4; ++j) { const int c = 8 * cq + 32 * j; const f32x4 g0 = *(const GAS f32x4*)(F_IN(8) + g * 128 + c), g1 = *(const GAS f32x4*)(F_IN(8) + g * 128 + c + 4);
              *(LAS f32x4*)(zn + q * 128 + c) = (f32x4){zv[8 * j] * r * g0.x, zv[8 * j + 1] * r * g0.y, zv[8 * j + 2] * r * g0.z, zv[8 * j + 3] * r * g0.w};
              *(LAS f32x4*)(zn + q * 128 + c + 4) = (f32x4){zv[8 * j + 4] * r * g1.x, zv[8 * j + 5] * r * g1.y, zv[8 * j + 6] * r * g1.z, zv[8 * j + 7] * r * g1.w}; } }
        for (int i = F.tid; i < 128 * 32; i += NWAVES * 64) { const int p = i & 127, q4 = (i >> 7) * 4;
            f32x4 w = *(const GAS f32x4*)(F_IN(9) + ((size_t)g * 128 + p) * 128 + q4);
            if (p < 64 && q4 >= 64) w = (f32x4){0.f, 0.f, 0.f, 0.f};
            wt[(q4 + 0) * 128 + p] = w.x; wt[(q4 + 1) * 128 + p] = w.y; wt[(q4 + 2) * 128 + p] = w.z; wt[(q4 + 3) * 128 + p] = w.w; }
        __syncthreads();
        float acc[8][4];
#pragma unroll
        for (int i = 0; i < 8; ++i)
#pragma unroll
            for (int k = 0; k < 4; ++k) acc[i][k] = 0.f;
        const int qmax = (p0 < 64) ? 64 : 128;
#pragma unroll 4
        for (int q = 0; q < qmax; ++q) { const f32x4 a0 = *(const LAS f32x4*)(wt + q * 128 + p0), a1 = *(const LAS f32x4*)(wt + q * 128 + p0 + 4), b = *(const LAS f32x4*)(zn + q * 128 + c0);
#pragma unroll
            for (int k = 0; k < 4; ++k) { acc[0][k] += a0.x * b[k]; acc[1][k] += a0.y * b[k]; acc[2][k] += a0.z * b[k]; acc[3][k] += a0.w * b[k];
                                          acc[4][k] += a1.x * b[k]; acc[5][k] += a1.y * b[k]; acc[6][k] += a1.z * b[k]; acc[7][k] += a1.w * b[k]; } }
#pragma unroll
        for (int i = 0; i < 8; ++i) { const int p = p0 + i; const float bias = F_IN(10)[g * 128 + p];
            const u64 uraw = *(const GAS u64*)(F_WS(bf16, WS_U) + (size_t)(t0 + p) * 1024 + g * 128 + c0);
            const unsigned ulo = (unsigned)uraw, uhi = (unsigned)(uraw >> 32);
            const float o0 = (acc[i][0] + bias) * bflo(ulo), o1 = (acc[i][1] + bias) * bfhi(ulo), o2 = (acc[i][2] + bias) * bflo(uhi), o3 = (acc[i][3] + bias) * bfhi(uhi);
            float ss = (o0 * o0 + o1 * o1) + (o2 * o2 + o3 * o3);
            ss += __shfl_xor(ss, 1); ss += __shfl_xor(ss, 2); ss += __shfl_xor(ss, 4); ss += __shfl_xor(ss, 8); ss += __shfl_xor(ss, 16);
            if (tc == 0) rowss[p] += ss;
            *(GAS u64*)(F_WS(bf16, WS_MIX) + (size_t)(t0 + p) * 2048 + 1024 + g * 128 + c0) = (u64)pk2(o0, o1) | ((u64)pk2(o2, o3) << 32); }
    }
    __syncthreads();
    VM_WAIT();
    for (int g = 0; g < 8; ++g) { const f32x4 gg = *(const GAS f32x4*)(F_IN(11) + g * 128 + c0);
#pragma unroll
        for (int i = 0; i < 8; ++i) { const int p = p0 + i; const float r = 1.f / sqrtf(rowss[p] * (1.f / 1024.f) + EPS);
            GAS u64* ptr = (GAS u64*)(F_WS(bf16, WS_MIX) + (size_t)(t0 + p) * 2048 + 1024 + g * 128 + c0);
            const u64 raw = __hip_atomic_load(ptr, __ATOMIC_RELAXED, __HIP_MEMORY_SCOPE_AGENT); const unsigned lo = (unsigned)raw, hi = (unsigned)(raw >> 32);
            *ptr = (u64)pk2(bflo(lo) * r * gg.x, bfhi(lo) * r * gg.y) | ((u64)pk2(bflo(hi) * r * gg.z, bfhi(hi) * r * gg.w) << 32); } }
    __syncthreads();
}

__device__ __forceinline__ void topk_unit(Frame& F, const Args& args, int wu) {
    const int t = (wu >> 3) * 64 + F.lane, h = wu & 7;
    int LA[16], LB[16];
#pragma unroll
    for (int j = 0; j < 16; ++j) { LA[j] = (int)0x80000000; LB[j] = (int)0x80000000; }
    const GAS float* scA = (const GAS float*)F_WS(float, WS_SC) + (size_t)(2 * h) * 128 * T + t;
    const GAS float* scB = scA + (size_t)128 * T;
#pragma unroll 4
    for (int k = 0; k < 128; ++k) {
        int ka = __builtin_bit_cast(int, scA[(size_t)k * T]), kb = __builtin_bit_cast(int, scB[(size_t)k * T]);
        ka ^= (ka >> 31) & 0x7fffffff; kb ^= (kb >> 31) & 0x7fffffff;
        ka = (ka & ~127) | (127 - k); kb = (kb & ~127) | (127 - k);
#pragma unroll
        for (int j = 0; j < 16; ++j) { const int ha = LA[j] > ka ? LA[j] : ka; ka = LA[j] > ka ? ka : LA[j]; LA[j] = ha; const int hb = LB[j] > kb ? LB[j] : kb; kb = LB[j] > kb ? kb : LB[j]; LB[j] = hb; }
    }
    float va[16], vb[16]; int ia[16], ib[16];
#pragma unroll
    for (int j = 0; j < 16; ++j) { int a = LA[j] & ~127; ia[j] = 127 - (LA[j] & 127); a ^= (a >> 31) & 0x7fffffff; va[j] = __builtin_bit_cast(float, a);
                                   int b = LB[j] & ~127; ib[j] = 127 - (LB[j] & 127); b ^= (b >> 31) & 0x7fffffff; vb[j] = __builtin_bit_cast(float, b); }
    float S[16]; int P[16];
#pragma unroll
    for (int q = 0; q < 16; ++q) { S[q] = -INFINITY; P[q] = 0; }
#pragma unroll
    for (int i = 0; i < 16; ++i)
#pragma unroll
        for (int j = 0; j < 16; ++j) if ((i + 1) * (j + 1) <= 16) {
            float s = va[i] + vb[j]; int p = ia[i] * 128 + ib[j];
#pragma unroll
            for (int q = 0; q < 16; ++q) { const bool gt = s > S[q]; const float s2 = gt ? S[q] : s; const int p2 = gt ? P[q] : p; S[q] = gt ? s : S[q]; P[q] = gt ? p : P[q]; s = s2; p = p2; }
        }
    float e[16]; float sum = 0.f;
#pragma unroll
    for (int q = 0; q < 16; ++q) { e[q] = __expf(S[q] - S[0]); sum += e[q]; }
    const float inv = 1.f / sum;
    GAS v4u* ip = (GAS v4u*)(F_WS(int, WS_IDX) + (size_t)t * 128 + h * 16); GAS f32x4* gp = (GAS f32x4*)(F_WS(float, WS_GATE) + (size_t)t * 128 + h * 16);
#pragma unroll
    for (int q = 0; q < 4; ++q) { ip[q] = (v4u){(unsigned)P[4 * q], (unsigned)P[4 * q + 1], (unsigned)P[4 * q + 2], (unsigned)P[4 * q + 3]};
                                  gp[q] = (f32x4){e[4 * q] * inv, e[4 * q + 1] * inv, e[4 * q + 2] * inv, e[4 * q + 3] * inv}; }
}

__device__ __forceinline__ float dot2a(unsigned x, unsigned u, float acc) { asm("v_dot2c_f32_bf16 %0, %1, %2" : "+v"(acc) : "v"(x), "v"(u)); return acc; }
__device__ __forceinline__ float dot8(v4u x, v4u u, float acc) {
    acc = dot2a(x.x, u.x, acc); acc = dot2a(x.y, u.y, acc); acc = dot2a(x.z, u.z, acc); acc = dot2a(x.w, u.w, acc);
    return acc;
}
__device__ __forceinline__ void peer_token(Frame& F, const Args& args, int t) {
    const int lane = F.lane;
    v4u xr[4];
    { const GAS v4u* xp = (const GAS v4u*)(F_WS(bf16, WS_XN) + (size_t)t * D) + lane;
#pragma unroll
      for (int j = 0; j < 4; ++j) xr[j] = xp[64 * j]; }
    const int i0 = F_WS(int, WS_IDX)[(size_t)t * 128 + lane], i1 = F_WS(int, WS_IDX)[(size_t)t * 128 + 64 + lane];
    const float g0 = F_WS(float, WS_GATE)[(size_t)t * 128 + lane], g1 = F_WS(float, WS_GATE)[(size_t)t * 128 + 64 + lane];
    float out[32];
#pragma unroll
    for (int i = 0; i < 32; ++i) out[i] = 0.f;
#pragma unroll 1
    for (int gi = 0; gi < 32; ++gi) {
        const int ireg = (gi < 16) ? i0 : i1; const float greg = (gi < 16) ? g0 : g1; const int lb = (4 * gi) & 63;
        int e[4];
#pragma unroll
        for (int kk = 0; kk < 4; ++kk) e[kk] = __builtin_amdgcn_readlane(ireg, lb + kk);
        v4u ub[4][4];
#pragma unroll
        for (int kk = 0; kk < 4; ++kk) { const GAS v4u* up = (const GAS v4u*)(F_WS(bf16, WS_UT) + (size_t)e[kk] * D) + lane;
#pragma unroll
            for (int j = 0; j < 4; ++j) ub[kk][j] = up[64 * j]; }
        float part[4];
#pragma unroll
        for (int kk = 0; kk < 4; ++kk) { float a = 0.f;
#pragma unroll
            for (int j = 0; j < 4; ++j) a = dot8(xr[j], ub[kk][j], a);
            part[kk] = a; }
#pragma unroll
        for (int k = 0; k < 2; ++k) { const bool hi = (lane & 32) != 0; const float keep = hi ? part[k + 2] : part[k], send = hi ? part[k] : part[k + 2]; part[k] = keep + __shfl_xor(send, 32); }
        { const bool hi = (lane & 16) != 0; const float keep = hi ? part[1] : part[0], send = hi ? part[0] : part[1]; part[0] = keep + __shfl_xor(send, 16); }
        float s = part[0]; s += __shfl_xor(s, 8); s += __shfl_xor(s, 4); s += __shfl_xor(s, 2); s += __shfl_xor(s, 1);
        const float gk = __shfl(greg, lb + ((lane >> 4) & 3));
        const float w = gk * gelu_tanh(s);
#pragma unroll
        for (int kk = 0; kk < 4; ++kk) {
            const float wk = __builtin_bit_cast(float, __builtin_amdgcn_readlane(__builtin_bit_cast(int, w), 16 * kk));
            const GAS v4u* vp = (const GAS v4u*)(F_WS(bf16, WS_VT) + (size_t)e[kk] * D) + lane;
#pragma unroll
            for (int j = 0; j < 4; ++j) { const v4u v = vp[64 * j];
#pragma unroll
                for (int i = 0; i < 4; ++i) { out[8 * j + 2 * i] += wk * bflo(v[i]); out[8 * j + 2 * i + 1] += wk * bfhi(v[i]); } } }
    }
    float* orow = F.out + (size_t)t * D; float ss = 0.f;
#pragma unroll
    for (int j = 0; j < 4; ++j) { const f32x4 a = *(const GAS f32x4*)(orow + 8 * lane + 512 * j), b = *(const GAS f32x4*)(orow + 8 * lane + 512 * j + 4);
        out[8 * j] += a.x; out[8 * j + 1] += a.y; out[8 * j + 2] += a.z; out[8 * j + 3] += a.w; out[8 * j + 4] += b.x; out[8 * j + 5] += b.y; out[8 * j + 6] += b.z; out[8 * j + 7] += b.w;
#pragma unroll
        for (int i = 0; i < 8; ++i) ss += out[8 * j + i] * out[8 * j + i]; }
    const float r = 1.f / sqrtf(wave_sum(ss) * (1.f / D) + EPS);
#pragma unroll
    for (int j = 0; j < 4; ++j) { const f32x4 ga = *(const GAS f32x4*)(F_IN(18) + 8 * lane + 512 * j), gb = *(const GAS f32x4*)(F_IN(18) + 8 * lane + 512 * j + 4);
        *(GAS f32x4*)(orow + 8 * lane + 512 * j) = (f32x4){out[8 * j] * r * ga.x, out[8 * j + 1] * r * ga.y, out[8 * j + 2] * r * ga.z, out[8 * j + 3] * r * ga.w};
        *(GAS f32x4*)(orow + 8 * lane + 512 * j + 4) = (f32x4){out[8 * j + 4] * r * gb.x, out[8 * j + 5] * r * gb.y, out[8 * j + 6] * r * gb.z, out[8 * j + 7] * r * gb.w}; }
}

__global__ void __launch_bounds__(NWAVES * 64, 2) mk_fwd(Args args) {
    extern __shared__ __attribute__((aligned(16))) unsigned char lds[];
    Frame F;
    F.lds = (LAS unsigned char*)lds;
    F.MISC = (volatile LAS unsigned*)(F.lds + MISC_OFF);
    F.tid = threadIdx.x; F.lane = F.tid & 63; F.wave = __builtin_amdgcn_readfirstlane(F.tid >> 6);
    F.G = gridDim.x; { const int bx = blockIdx.x; F.vcu = (F.G % 8 == 0) ? (bx % 8) * (F.G / 8) + bx / 8 : bx; }
    unsigned char* ws = args.ws;
    F.ctl = (gu32*)(ws + WS_CTL);
    F.out = args.out; F.ws = ws;
    for (int u = F.tid; u < (LDS_BYTES - LDSCTL_OFF) / 4; u += NWAVES * 64) ((LAS unsigned*)(F.lds + LDSCTL_OFF))[u] = 0u;
    __syncthreads();
    XcdBarrier bar; bar.bar = (unsigned*)(F.ctl + CW_BAR); bar.x = 0; bar.st = nullptr;
    if (N_LAUNCHES == 1) bar = xcd_barrier_post((unsigned*)(F.ctl + CW_BAR), F.MISC + 8);
#define GRID_BAR() do { if (N_LAUNCHES == 1) xcd_barrier(bar); } while (0)
    const int lo = args.ph_lo, hi = args.ph_hi;
#define IN(k) (lo <= (k) && (k) < hi)
#define BOTH(k) (IN(k) && IN((k) + 1))
    const int gw = F.vcu * NWAVES + F.wave, NGW = F.G * NWAVES;

    if (IN(0)) { p0_prologue(F, args); if (BOTH(0)) GRID_BAR(); }

    if (IN(1)) {
        pg8::Gemm g{F_WS(bf16, WS_XN), F_WS(bf16, WS_WIN), T, NIN, D}; pg8::StaticOrder S; S.init(T, NIN, F.G, (int)blockIdx.x);
        static_assert(WS_K - WS_Q == 64 * MiB && WS_V - WS_K == 64 * MiB && WS_U - WS_V == 64 * MiB && WS_Z - WS_U == 64 * MiB, "q|k|v|u|z regions equally spaced");
        pg8::EpiInProj E{F_WS(bf16, WS_Q), (size_t)(32 * MiB), F_WS(float, WS_ROPE), attn_body::C2};
        pg8::gemm_phase<pg8::EpiInProj, pg8::StaticOrder, true, true>(F.lds + RING_OFF, g, S, E);
        if (BOTH(1)) GRID_BAR();
    }

    if (IN(2)) {
        static_assert(attn_body::ATTN_LDS_BYTES <= RING_BYTES, "attention scratch fits the ring region");
        const attn_body::AttnTensors AT{(const attn_body::bf16*)F_WS(bf16, WS_Q), (const attn_body::bf16*)F_WS(bf16, WS_K), (const attn_body::bf16*)F_WS(bf16, WS_V), (attn_body::bf16*)F_WS(bf16, WS_O0), (attn_body::bf16*)F_WS(bf16, WS_O1)};
        for (int v = F.vcu; v < 256; v += F.G) attn_body::attn_phase<8>((char*)lds + RING_OFF, AT, v);
        if (BOTH(2)) GRID_BAR();
    }

    if (IN(3)) {
        for (int unit = F.vcu; unit < 256; unit += F.G) gmlp_unit(F, args, unit);
        float d1 = F_IN(3)[F.lane] * F_IN(4)[F.lane], d2 = F_IN(5)[F.lane] * F_IN(6)[F.lane];
        d1 = wave_sum(d1); d2 = wave_sum(d2);
        const float lam = __expf(d1) - __expf(d2) + LAMBDA_INIT;
        for (int t = gw; t < T; t += NGW) combine_row(F, args, t, lam);
        if (BOTH(3)) GRID_BAR();
    }

    if (IN(4)) {
        pg8::Gemm g{F_WS(bf16, WS_MIX), F_WS(bf16, WS_WOUT), T, D, D}; pg8::StaticOrder S; S.init(T, D, F.G, (int)blockIdx.x);
        pg8::EpiF32Res E{F.out, D, F_IN(0)};
        pg8::gemm_phase<pg8::EpiF32Res, pg8::StaticOrder, true, true>(F.lds + RING_OFF, g, S, E);
        if (BOTH(4)) GRID_BAR();
    }

    if (IN(5)) {
        for (int m = gw; m < T; m += NGW) rms_row_to_bf16(F.out + (size_t)m * D, F_IN(13), F_WS(bf16, WS_XN) + (size_t)m * D, F.lane);
        if (BOTH(5)) GRID_BAR();
    }

    if (IN(6)) {
        pg8::Gemm g{F_WS(bf16, WS_WSC), F_WS(bf16, WS_XN), 2048, T, D}; pg8::StaticOrder S; S.init(2048, T, F.G, (int)blockIdx.x);
        pg8::EpiF32Res E{F_WS(float, WS_SC), T, nullptr};
        pg8::gemm_phase<pg8::EpiF32Res, pg8::StaticOrder, true, true>(F.lds + RING_OFF, g, S, E);
        if (BOTH(6)) GRID_BAR();
    }

    if (IN(7)) {
        for (int wu = gw; wu < (T / 64) * 8; wu += NGW) topk_unit(F, args, wu);
        if (BOTH(7)) GRID_BAR();
    }

    if (IN(8)) {
        for (int t = gw; t < T; t += NGW) peer_token(F, args, t);
    }
#undef IN
#undef BOTH
}

extern "C" void kernel_launch(void* const* d_in, const int* in_sizes, int n_in, void* d_out, int out_size, void* d_ws, size_t ws_size, hipStream_t stream) {
    static int grid = 0;
    if (grid == 0) {
        if (n_in != 19 || in_sizes[0] != T * D || out_size != T * D || ws_size < WS_END) { fprintf(stderr, "kernel_launch: unexpected shapes (n_in %d, in0 %d, out %d, ws %zu); nothing launched\n", n_in, n_in > 0 ? in_sizes[0] : -1, out_size, ws_size); grid = -1; return; }
        int dev = 0, cus = 0, per_cu = 0;
        if (hipGetDevice(&dev) != hipSuccess || hipDeviceGetAttribute(&cus, hipDeviceAttributeMultiprocessorCount, dev) != hipSuccess) { fprintf(stderr, "kernel_launch: device query failed\n"); grid = -1; return; }
        if (hipFuncSetAttribute((const void*)mk_fwd, hipFuncAttributeMaxDynamicSharedMemorySize, LDS_BYTES) != hipSuccess) { fprintf(stderr, "kernel_launch: hipFuncSetAttribute failed\n"); grid = -1; return; }
        if (hipOccupancyMaxActiveBlocksPerMultiprocessor(&per_cu, (const void*)mk_fwd, NWAVES * 64, LDS_BYTES) != hipSuccess || per_cu < 1)
            fprintf(stderr, "kernel_launch: note: occupancy query reports %d workgroups per CU\n", per_cu);
        (void)hipGetLastError();
        grid = cus;
    }
    if (grid < 0) return;
    if (hipMemsetAsync((char*)d_ws + WS_CTL, 0, CTL_ZERO_BYTES, stream) != hipSuccess) { fprintf(stderr, "kernel_launch: memset failed\n"); return; }
    Args a{};
    for (int i = 0; i < 19; ++i) a.in[i] = (const float*)d_in[i];
    a.out = (float*)d_out; a.ws = (unsigned char*)d_ws;
    for (int li = 0; li < N_LAUNCHES; ++li) {
        a.ph_lo = (N_LAUNCHES == 1) ? 0 : li; a.ph_hi = (N_LAUNCHES == 1) ? N_PHASES : li + 1; a.li = li; a.pad = 0;
        hipLaunchKernelGGL(mk_fwd, dim3(grid), dim3(NWAVES * 64), LDS_BYTES, stream, a);
        const hipError_t le = hipPeekAtLastError();
        if (le != hipSuccess) { fprintf(stderr, "kernel_launch: launch %d failed: %s\n", li, hipGetErrorName(le)); break; }
    }
}
```

```cpp
#include <hip/hip_runtime.h>
#include <cstdio>
#include <cstdint>
namespace pg8 {
#define PG8_LAS __attribute__((address_space(3)))
typedef unsigned short bf16_t;
typedef short bf16x8 __attribute__((ext_vector_type(8)));
typedef float f32x4 __attribute__((ext_vector_type(4)));
typedef unsigned u32x4 __attribute__((ext_vector_type(4)));
constexpr int BM = 256, BK = 64, HALF = 128, HTB = HALF * BK * 2  , STAGE_BYTES = 8 * HTB, NXCD = 8, WGM = 8;

__host__ __device__ __forceinline__ int lds_byte(int r, int c) { const int st = (r >> 4) * 2 + (c >> 5), rr = r & 15, cc = c & 31, ob = rr * 64 + cc * 2; return st * 1024 + (ob ^ (((ob >> 9) & 1) << 5)); }
__host__ __device__ __forceinline__ void stage_rc(int b, int& R, int& C) { const int st = b / 1024, sb = b % 1024, swz = sb ^ (((sb >> 9) & 1) << 5); R = (st >> 1) * 16 + swz / 64; C = (st & 1) * 32 + (swz % 64) / 2; }
__host__ __device__ __forceinline__ int perm32(int rho) { const int n = rho >> 4, i = rho & 15; return 8 * (i >> 2) + 4 * n + (i & 3); }

struct Unit { int pm, pn; };
struct Gemm { const bf16_t* A; const bf16_t* Bt; int M, N, K; };

struct StaticOrder {
    int nM, nN, nwg, G, c;
    __host__ __device__ void init(int M, int N, int G_, int c_) { nM = M / BM; nN = N / BM; nwg = nM * nN; G = G_; c = c_; }
    __host__ __device__ bool next(int i, Unit& u) const {
        const long L = (long)i * G + c; if (L >= nwg) return false;
        int wgid = (int)L; { const int q = nwg / NXCD, r = nwg % NXCD, xcd = wgid % NXCD, off = wgid / NXCD; wgid = (xcd < r ? xcd * (q + 1) : r * (q + 1) + (xcd - r) * q) + off; }
        const int nig = WGM * nN, gid = wgid / nig, fm = gid * WGM, gsz = (nM - fm) < WGM ? (nM - fm) : WGM;
        u.pm = fm + ((wgid % nig) % gsz); u.pn = (wgid % nig) / gsz; return true;
    }
    __device__ __forceinline__ void a_ready(const Unit&) const {}
    __device__ __forceinline__ void done(const Unit&) const {}
};

__device__ __forceinline__ unsigned cvt_pk_bf16(float lo, float hi) { unsigned r; asm volatile("v_cvt_pk_bf16_f32 %0, %1, %2" : "=v"(r) : "v"(lo), "v"(hi)); return r; }
typedef float f32x2 __attribute__((ext_vector_type(2)));
__device__ __forceinline__ f32x2 gelu_pk(f32x2 v) {
    const f32x2 av = __builtin_elementwise_abs(v), d = av * 0.2316418882f + 1.0f;
    f32x2 t; t.x = __builtin_amdgcn_rcpf(d.x); t.y = __builtin_amdgcn_rcpf(d.y);
    f32x2 q = t * 0.5307027145f + (-0.7265760135f); q = q * t + 0.7107068705f; q = q * t + (-0.142248368f); q = q * t + 0.127414796f; q = q * t;
    const f32x2 s = (v * v) * (-0.72134752044f);
    f32x2 e; e.x = __builtin_amdgcn_exp2f(s.x); e.y = __builtin_amdgcn_exp2f(s.y);
    const f32x2 m = v * (q * e), r = v - m;
    f32x2 o; o.x = v.x < 0.f ? m.x : r.x; o.y = v.y < 0.f ? m.y : r.y; return o;
}

template <class Epi, class Sched, bool ALIGN_EPI = false, bool SP2 = false>
__device__ __forceinline__ void gemm_phase(PG8_LAS unsigned char* lds, const Gemm g, const Sched& S, const Epi& E) {
    const int tid = threadIdx.x, wid = __builtin_amdgcn_readfirstlane(tid >> 6), lane = tid & 63, wr = wid >> 2, wc = wid & 3, fr = lane & 15, fq = lane >> 4;
    const int K = g.K, nt = K / BK;
    unsigned voffA[2], voffB[2];
#pragma unroll
    for (int i = 0; i < 2; ++i) { int R, C; stage_rc(tid * 16 + i * 8192, R, C); const int Rb = Epi::PERM ? ((R & ~31) + perm32(R & 31)) : R;
        voffA[i] = (unsigned)(R * K + C) * 2u; voffB[i] = (unsigned)(Rb * K + C) * 2u; }
    const size_t kstep = (size_t)(BK * 2);
    const size_t hstep = (size_t)HALF * K * 2;
    const size_t tstep = 2 * hstep;
    const unsigned ldsw = (unsigned)wid * 1024u;
    const int aoff = lds_byte(wr * 64 + fr, fq * 8), boff = lds_byte(wc * 32 + fr, fq * 8);
#define PG8_SA(b, h) (((b) * 2 + (h)) * HTB)
#define PG8_SB(b, h) ((4 + (b) * 2 + (h)) * HTB)
#define PG8_STAGE(bufoff, gbase, voff) do { _Pragma("unroll") for (int _i = 0; _i < 2; ++_i) \
        __builtin_amdgcn_global_load_lds((const unsigned*)((const char*)(gbase) + (voff)[_i]), (PG8_LAS unsigned*)(lds + (bufoff) + ldsw + _i * 8192), 16, 0, 0); } while (0)
#define PG8_LDA(dst, b, h) do { _Pragma("unroll") for (int m = 0; m < 4; ++m) _Pragma("unroll") for (int k = 0; k < 2; ++k) dst[m][k] = *(const PG8_LAS bf16x8*)(lds + PG8_SA(b, h) + aoff + m * 2048 + k * 1024); } while (0)
#define PG8_LDB(dst, b, h) do { _Pragma("unroll") for (int n = 0; n < 2; ++n) _Pragma("unroll") for (int k = 0; k < 2; ++k) dst[n][k] = *(const PG8_LAS bf16x8*)(lds + PG8_SB(b, h) + boff + n * 2048 + k * 1024); } while (0)
#define PG8_MMA(ai, bj, At, Bt) do { __builtin_amdgcn_s_setprio(1); _Pragma("unroll") for (int m = 0; m < 4; ++m) _Pragma("unroll") for (int n = 0; n < 2; ++n) _Pragma("unroll") for (int k = 0; k < 2; ++k) \
        acc[ai][bj][m][n] = __builtin_amdgcn_mfma_f32_16x16x32_bf16(Bt[n][k], At[m][k], acc[ai][bj][m][n], 0, 0, 0); __builtin_amdgcn_s_setprio(0); } while (0)
#define PG8_WAIT_V(n) asm volatile("s_waitcnt vmcnt(" #n ")" ::: "memory")
#define PG8_WAIT_L(n) asm volatile("s_waitcnt lgkmcnt(" #n ")" ::: "memory")
#define PG8_BAR __builtin_amdgcn_s_barrier()
#define PG8_SCHED __builtin_amdgcn_sched_barrier(0)
    Unit cur, nxt; int ui = 0;
    if (!S.next(0, cur)) return;
    f32x4 acc[2][2][4][2];
#pragma unroll
    for (int a = 0; a < 2; ++a)
#pragma unroll
        for (int b = 0; b < 2; ++b)
#pragma unroll
            for (int m = 0; m < 4; ++m)
#pragma unroll
                for (int n = 0; n < 2; ++n) acc[a][b][m][n] = (f32x4){0.f, 0.f, 0.f, 0.f};
    bf16x8 At[4][2], B0[2][2], B1[2][2];
    const char* cA = (const char*)g.A + (size_t)cur.pm * tstep; const char* cB = (const char*)g.Bt + (size_t)cur.pn * tstep;
    S.a_ready(cur);
    if constexpr (SP2) {
        PG8_STAGE(PG8_SB(0, 0), cB, voffB); PG8_STAGE(PG8_SB(0, 1), cB + hstep, voffB); PG8_STAGE(PG8_SA(0, 0), cA, voffA); PG8_STAGE(PG8_SA(0, 1), cA + hstep, voffA);
        if (wr == 1) PG8_BAR;
        PG8_WAIT_V(2); PG8_BAR;
        PG8_STAGE(PG8_SB(1, 0), cB + kstep, voffB); PG8_STAGE(PG8_SA(1, 0), cA + kstep, voffA); PG8_STAGE(PG8_SB(1, 1), cB + hstep + kstep, voffB);
        PG8_WAIT_V(6); PG8_BAR;
    } else {
        PG8_STAGE(PG8_SB(0, 0), cB, voffB); PG8_STAGE(PG8_SA(0, 0), cA, voffA); PG8_STAGE(PG8_SB(0, 1), cB + hstep, voffB); PG8_STAGE(PG8_SA(0, 1), cA + hstep, voffA);
        if (wr == 1) PG8_BAR;
        PG8_WAIT_V(4); PG8_BAR;
        PG8_STAGE(PG8_SB(1, 0), cB + kstep, voffB); PG8_STAGE(PG8_SA(1, 0), cA + kstep, voffA); PG8_STAGE(PG8_SB(1, 1), cB + hstep + kstep, voffB);
        PG8_WAIT_V(6); PG8_BAR;
    }
    for (;;) {
        const bool has_next = S.next(ui + 1, nxt);
        const char* nA = has_next ? (const char*)g.A + (size_t)nxt.pm * tstep : cA; const char* nB = has_next ? (const char*)g.Bt + (size_t)nxt.pn * tstep : cB;
        for (int t = 0; t < nt; t += 2) {
            const bool last = (t == nt - 2);
            const char* a1 = cA + (size_t)(t + 1) * kstep;
            const char* a2 = last ? nA : cA + (size_t)(t + 2) * kstep; const char* b2 = last ? nB : cB + (size_t)(t + 2) * kstep;
            const char* a3 = a2 + kstep; const char* b3 = b2 + kstep;
            if (last && has_next) S.a_ready(nxt);
            if constexpr (SP2) {
            PG8_LDB(B0, 0, 0); PG8_LDB(B1, 0, 1); PG8_SCHED; PG8_LDA(At, 0, 0); PG8_STAGE(PG8_SA(1, 1), a1 + hstep, voffA);
            PG8_WAIT_V(8); PG8_WAIT_L(0); PG8_BAR; PG8_MMA(0, 0, At, B0); PG8_MMA(0, 1, At, B1); PG8_BAR; PG8_SCHED;
            PG8_LDA(At, 0, 1); PG8_STAGE(PG8_SB(0, 0), b2, voffB); PG8_STAGE(PG8_SB(0, 1), b2 + hstep, voffB); PG8_STAGE(PG8_SA(0, 0), a2, voffA);
            PG8_WAIT_V(8); PG8_WAIT_L(0); PG8_BAR; PG8_MMA(1, 0, At, B0); PG8_MMA(1, 1, At, B1); PG8_BAR; PG8_SCHED;
            PG8_LDB(B0, 1, 0); PG8_LDB(B1, 1, 1); PG8_SCHED; PG8_LDA(At, 1, 0); PG8_STAGE(PG8_SA(0, 1), a2 + hstep, voffA);
            PG8_WAIT_V(8); PG8_WAIT_L(0); PG8_BAR; PG8_MMA(0, 0, At, B0); PG8_MMA(0, 1, At, B1); PG8_BAR; PG8_SCHED;
            PG8_LDA(At, 1, 1); PG8_STAGE(PG8_SB(1, 0), b3, voffB); PG8_STAGE(PG8_SB(1, 1), b3 + hstep, voffB); PG8_STAGE(PG8_SA(1, 0), a3, voffA);
            PG8_WAIT_V(8); PG8_WAIT_L(0); PG8_BAR; PG8_MMA(1, 0, At, B0); PG8_MMA(1, 1, At, B1); PG8_BAR; PG8_SCHED;
            } else {
            PG8_LDB(B0, 0, 0); PG8_SCHED; PG8_LDA(At, 0, 0); PG8_STAGE(PG8_SA(1, 1), a1 + hstep, voffA);
            PG8_WAIT_L(8); PG8_BAR; PG8_WAIT_L(0); PG8_MMA(0, 0, At, B0); PG8_BAR; PG8_SCHED;
            PG8_LDB(B1, 0, 1); PG8_STAGE(PG8_SB(0, 0), b2, voffB);
            PG8_BAR; PG8_WAIT_L(0); PG8_MMA(0, 1, At, B1); PG8_BAR;
            PG8_LDA(At, 0, 1); PG8_STAGE(PG8_SA(0, 0), a2, voffA);
            PG8_BAR; PG8_WAIT_L(0); PG8_MMA(1, 0, At, B0); PG8_BAR; PG8_SCHED;
            PG8_STAGE(PG8_SB(0, 1), b2 + hstep, voffB);
            PG8_WAIT_V(6); PG8_BAR; PG8_MMA(1, 1, At, B1); PG8_BAR;
            PG8_LDB(B0, 1, 0); PG8_SCHED; PG8_LDA(At, 1, 0); PG8_STAGE(PG8_SA(0, 1), a2 + hstep, voffA);
            PG8_WAIT_L(8); PG8_BAR; PG8_WAIT_L(0); PG8_MMA(0, 0, At, B0); PG8_BAR; PG8_SCHED;
            PG8_LDB(B1, 1, 1); PG8_STAGE(PG8_SB(1, 0), b3, voffB);
            PG8_BAR; PG8_WAIT_L(0); PG8_MMA(0, 1, At, B1); PG8_BAR;
            PG8_LDA(At, 1, 1); PG8_STAGE(PG8_SA(1, 0), a3, voffA);
            PG8_BAR; PG8_WAIT_L(0); PG8_MMA(1, 0, At, B0); PG8_BAR; PG8_SCHED;
            PG8_STAGE(PG8_SB(1, 1), b3 + hstep, voffB);
            PG8_WAIT_V(6); PG8_BAR; PG8_MMA(1, 1, At, B1); PG8_BAR;
            }
        }
        if constexpr (ALIGN_EPI) { if (wr == 0) PG8_BAR; }
        if constexpr (!Epi::AFTER_DRAIN) { E(acc, cur, wr, wc, fr, fq); S.done(cur); }
        if (!has_next) break;
#pragma unroll
        for (int a = 0; a < 2; ++a)
#pragma unroll
            for (int b = 0; b < 2; ++b)
#pragma unroll
                for (int m = 0; m < 4; ++m)
#pragma unroll
                    for (int n = 0; n < 2; ++n) acc[a][b][m][n] = (f32x4){0.f, 0.f, 0.f, 0.f};
        cur = nxt; cA = nA; cB = nB; ++ui;
        if constexpr (ALIGN_EPI) { if (wr == 1) PG8_BAR; }
    }
    PG8_WAIT_V(0);
    if constexpr (!ALIGN_EPI) { if (wr == 0) PG8_BAR; }
    PG8_BAR;
    if constexpr (Epi::AFTER_DRAIN) { E.fused(acc, cur, wr, wc, fr, fq, lds, wid, lane); S.done(cur); }
#undef PG8_SA
#undef PG8_SB
#undef PG8_STAGE
#undef PG8_LDA
#undef PG8_LDB
#undef PG8_MMA
#undef PG8_WAIT_V
#undef PG8_WAIT_L
#undef PG8_BAR
#undef PG8_SCHED
}
}
namespace pg8 {
__device__ __forceinline__ float gelu_tanh(float x) {
    const float y2 = x * (1.5957691216057308f + 0.07135481627613502f * x * x);
    const float e = __builtin_amdgcn_exp2f(-1.4426950408889634f * y2);
    return x * __builtin_amdgcn_rcpf(1.0f + e);
}
struct EpiInProj {
    static constexpr bool PERM = true, AFTER_DRAIN = false;
    bf16_t* Oq; size_t region_stride; const float* rope; float qscale;
    __device__ __forceinline__ void operator()(const f32x4 (&acc)[2][2][4][2], const Unit& u, int wr, int wc, int fr, int fq) const {
        const int region = u.pn >> 2;
        bf16_t* base = Oq + (size_t)region * region_stride;
        const int row0 = u.pm * BM + wr * 64 + fr, col0 = (u.pn & 3) * 256 + wc * 32 + 8 * fq;
        const bool do_rope = (region < 2) && ((wc & 1) == 0) && (fq < 2);
        const bool do_gelu = (region >= 3);
        const float sc = (region == 0) ? qscale : 1.f;
#pragma unroll
        for (int ai = 0; ai < 2; ++ai)
#pragma unroll
            for (int m = 0; m < 4; ++m) { const int row = row0 + ai * HALF + m * 16; bf16_t* rowp = base + (size_t)row * 1024 + col0;
                f32x4 cs0 = (f32x4){1.f, 0.f, 1.f, 0.f}, cs1 = (f32x4){1.f, 0.f, 1.f, 0.f};
                if (do_rope) { const float* rp = rope + ((size_t)(row & 16383) * 8 + 4 * fq) * 2; cs0 = *(const f32x4*)rp; cs1 = *(const f32x4*)(rp + 4); }
#pragma unroll
                for (int bj = 0; bj < 2; ++bj) { f32x4 v0 = acc[ai][bj][m][0], v1 = acc[ai][bj][m][1];
                    if (do_rope) {
                        f32x4 r0, r1;
                        r0[0] = v0[0] * cs0[0] - v0[1] * cs0[1]; r0[1] = v0[1] * cs0[0] + v0[0] * cs0[1];
                        r0[2] = v0[2] * cs0[2] - v0[3] * cs0[3]; r0[3] = v0[3] * cs0[2] + v0[2] * cs0[3];
                        r1[0] = v1[0] * cs1[0] - v1[1] * cs1[1]; r1[1] = v1[1] * cs1[0] + v1[0] * cs1[1];
                        r1[2] = v1[2] * cs1[2] - v1[3] * cs1[3]; r1[3] = v1[3] * cs1[2] + v1[2] * cs1[3];
                        v0 = r0; v1 = r1; }
                    if (do_gelu) {
#pragma unroll
                        for (int e = 0; e < 4; ++e) { v0[e] = gelu_tanh(v0[e]); v1[e] = gelu_tanh(v1[e]); } }
                    v0 = v0 * sc; v1 = v1 * sc; u32x4 w; w.x = cvt_pk_bf16(v0[0], v0[1]); w.y = cvt_pk_bf16(v0[2], v0[3]); w.z = cvt_pk_bf16(v1[0], v1[1]); w.w = cvt_pk_bf16(v1[2], v1[3]);
                    *(u32x4*)(rowp + bj * HALF) = w; } }
    }
};
struct EpiF32Res {
    static constexpr bool PERM = false, AFTER_DRAIN = false;
    float* C; int ldc; const float* R;
    __device__ __forceinline__ void operator()(const f32x4 (&acc)[2][2][4][2], const Unit& u, int wr, int wc, int fr, int fq) const {
        const int row0 = u.pm * BM + wr * 64 + fr, col0 = u.pn * BM + wc * 32 + 4 * fq;
#pragma unroll
        for (int ai = 0; ai < 2; ++ai)
#pragma unroll
            for (int m = 0; m < 4; ++m) { const size_t off = (size_t)(row0 + ai * HALF + m * 16) * ldc + col0;
#pragma unroll
                for (int bj = 0; bj < 2; ++bj)
#pragma unroll
                    for (int n = 0; n < 2; ++n) { f32x4 v = acc[ai][bj][m][n]; if (R) v = v + *(const f32x4*)(R + off + bj * HALF + n * 16); *(f32x4*)(C + off + bj * HALF + n * 16) = v; } }
    }
};
struct EpiResX1 {
    static constexpr bool PERM = true, AFTER_DRAIN = false;
    const float* rinv; const float* gain; bf16_t* XB; float* SSQ; int nrows; int ldc;
    __device__ __forceinline__ void operator()(const f32x4 (&acc)[2][2][4][2], const Unit& u, int wr, int wc, int fr, int fq) const {
        const int row0 = u.pm * BM + wr * 64 + fr, col0 = u.pn * BM + wc * 32 + 8 * fq;
        f32x4 gi[2][2];
#pragma unroll
        for (int bj = 0; bj < 2; ++bj)
#pragma unroll
            for (int n = 0; n < 2; ++n) { const f32x4 gg = *(const f32x4*)(gain + col0 + bj * HALF + 4 * n);
                gi[bj][n] = (f32x4){__builtin_amdgcn_rcpf(gg[0]), __builtin_amdgcn_rcpf(gg[1]), __builtin_amdgcn_rcpf(gg[2]), __builtin_amdgcn_rcpf(gg[3])}; }
#pragma unroll
        for (int ai = 0; ai < 2; ++ai)
#pragma unroll
            for (int m = 0; m < 4; ++m) { const int row = row0 + ai * HALF + m * 16; const size_t off = (size_t)row * ldc + col0; float ss = 0.f; const float ri = rinv[row];
#pragma unroll
                for (int bj = 0; bj < 2; ++bj) { const u32x4 xb = *(const u32x4*)(XB + off + bj * HALF);
                    const f32x4 x0 = (f32x4){__builtin_bit_cast(float, xb.x << 16), __builtin_bit_cast(float, xb.x & 0xffff0000u), __builtin_bit_cast(float, xb.y << 16), __builtin_bit_cast(float, xb.y & 0xffff0000u)};
                    const f32x4 x1 = (f32x4){__builtin_bit_cast(float, xb.z << 16), __builtin_bit_cast(float, xb.z & 0xffff0000u), __builtin_bit_cast(float, xb.w << 16), __builtin_bit_cast(float, xb.w & 0xffff0000u)};
                    const f32x4 v0 = acc[ai][bj][m][0] + x0 * gi[bj][0] * ri, v1 = acc[ai][bj][m][1] + x1 * gi[bj][1] * ri;
                    ss += ((v0[0] * v0[0] + v0[1] * v0[1]) + (v0[2] * v0[2] + v0[3] * v0[3])) + ((v1[0] * v1[0] + v1[1] * v1[1]) + (v1[2] * v1[2] + v1[3] * v1[3]));
                    u32x4 w; w.x = cvt_pk_bf16(v0[0], v0[1]); w.y = cvt_pk_bf16(v0[2], v0[3]); w.z = cvt_pk_bf16(v1[0], v1[1]); w.w = cvt_pk_bf16(v1[2], v1[3]);
                    *(u32x4*)(XB + off + bj * HALF) = w; }
                ss += __shfl_xor(ss, 16); ss += __shfl_xor(ss, 32);
                if (fq == 0) SSQ[(size_t)(u.pn * 4 + wc) * nrows + row] = ss; }
    }
};
struct TokenOrder {
    StaticOrder so; int vcu, nsteps; bool tokM, fixed;
    __device__ void init(int M, int N, int G_, int c_, int vcu_, bool tokM_) { so.init(M, N, G_, c_); vcu = vcu_; tokM = tokM_; const int ntok = (tokM_ ? M : N) / BM, noth = (tokM_ ? N : M) / BM;
        fixed = (G_ == 256 && ntok == 128 && (noth % 2) == 0); nsteps = noth / 2; }
    __device__ bool next(int i, Unit& u) const {
        if (!fixed) return so.next(i, u);
        if (i >= nsteps) return false;
        const int tok = vcu >> 1, oth = (vcu & 1) * nsteps + i; u.pm = tokM ? tok : oth; u.pn = tokM ? oth : tok; return true; }
    __device__ __forceinline__ void a_ready(const Unit&) const {}
    __device__ __forceinline__ void done(const Unit&) const {}
};
}
#include <hip/hip_bf16.h>
#include <cmath>
namespace attn_body {
using bf16=__hip_bfloat16;
using bf16x8=__attribute__((ext_vector_type(8)))short;
using s16x4=__attribute__((ext_vector_type(4)))short;
using f32x16=__attribute__((ext_vector_type(16)))float;
using u32x4=__attribute__((ext_vector_type(4)))unsigned;
constexpr int BATCH=2,NHEAD=16,SEQ=16384,D=64,DM=NHEAD*D;
constexpr int NW=8,QBLK=32,QB=QBLK*NW,KVBLK=64,NQB=SEQ/QB;
constexpr int ATTN_PITCH=DM, ATTN_UNIT_ROWS=QB;
__device__ __forceinline__ int crow(int r,int hi){return (r&3)+8*(r>>2)+4*hi;}
#define SBAR() __builtin_amdgcn_sched_barrier(0)
__device__ __forceinline__ void cmask(f32x16&p0,f32x16&p1,int jb,int qrel,int hi){
  const float NEG=-INFINITY; (void)hi;
  if(jb>(qrel>>6)){
  #pragma unroll
  for(int r=0;r<16;++r){p0[r]=NEG;p1[r]=NEG;} }
}

constexpr int NSLOT=3, SLOTB=8192;
constexpr int VSLOTB=2*SLOTB;
constexpr int LDS_K=0, LDS_V=NSLOT*SLOTB, LDS_WS=LDS_V+NSLOT*VSLOTB, LDS_OST=LDS_WS+NW*64*4, LDS_BYTES=LDS_OST+NW*4096;
constexpr float C2=0.125f*1.4426950408889634f;
__device__ __forceinline__ void glds16(const void*gsrc,unsigned lds_dst){unsigned keep;
  asm volatile("s_mov_b32 %0, m0\n\ts_mov_b32 m0, %2\n\ts_nop 0\n\tglobal_load_lds_dwordx4 %1, off\n\ts_mov_b32 m0, %0":"=&s"(keep):"v"(gsrc),"s"(lds_dst):"memory");}
__device__ __forceinline__ float max3f(float a,float b,float c){float r;asm("v_max3_f32 %0, %1, %2, %3":"=v"(r):"v"(a),"v"(b),"v"(c));return r;}
__device__ __forceinline__ float max2f(float a,float b){float r;asm("v_max_f32_e32 %0, %1, %2":"=v"(r):"v"(a),"v"(b));return r;}
__device__ __forceinline__ float fadd_s(float a,float b){float r;asm("v_add_f32_e32 %0, %1, %2":"=v"(r):"v"(a),"v"(b));return r;}
__device__ __forceinline__ float fsub_s(float a,float b){float r;asm("v_sub_f32_e32 %0, %1, %2":"=v"(r):"v"(a),"v"(b));return r;}
typedef float f32x2_t __attribute__((ext_vector_type(2))); typedef __bf16 bf16x2_t __attribute__((ext_vector_type(2)));
__device__ __forceinline__ unsigned cvtpk_s(float lo,float hi){f32x2_t v={lo,hi};bf16x2_t b=__builtin_convertvector(v,bf16x2_t);return __builtin_bit_cast(unsigned,b);}
#define WAIT_BAR(N) asm volatile("s_waitcnt vmcnt(" #N ") lgkmcnt(0)\n\ts_barrier":::"memory")

__device__ __forceinline__ void qkt(f32x16&p0,f32x16&p1,const char*Kslot,const bf16x8*qr,int r32,int hi){
  const char*kb=Kslot+hi*1024+r32*16;
  #pragma unroll
  for(int d0=0;d0<4;++d0){
    const bf16x8 b0=*reinterpret_cast<const bf16x8*>(kb+d0*2048);
    const bf16x8 b1=*reinterpret_cast<const bf16x8*>(kb+d0*2048+512);
    if(d0==0){p0=__builtin_amdgcn_mfma_f32_32x32x16_bf16(b0,qr[0],f32x16{},0,0,0);p1=__builtin_amdgcn_mfma_f32_32x32x16_bf16(b1,qr[0],f32x16{},0,0,0);}
    else{p0=__builtin_amdgcn_mfma_f32_32x32x16_bf16(b0,qr[d0],p0,0,0,0);p1=__builtin_amdgcn_mfma_f32_32x32x16_bf16(b1,qr[d0],p1,0,0,0);}}
}
typedef __attribute__((address_space(3))) const char* lds_cptr;
typedef short v4i16_t __attribute__((ext_vector_type(4)));
__device__ __forceinline__ void kload8(bf16x8*kf,lds_cptr kp){
  kf[0]=*(const __attribute__((address_space(3))) bf16x8*)(kp);      kf[1]=*(const __attribute__((address_space(3))) bf16x8*)(kp+512);
  kf[2]=*(const __attribute__((address_space(3))) bf16x8*)(kp+2048); kf[3]=*(const __attribute__((address_space(3))) bf16x8*)(kp+2560);
  kf[4]=*(const __attribute__((address_space(3))) bf16x8*)(kp+4096); kf[5]=*(const __attribute__((address_space(3))) bf16x8*)(kp+4608);
  kf[6]=*(const __attribute__((address_space(3))) bf16x8*)(kp+6144); kf[7]=*(const __attribute__((address_space(3))) bf16x8*)(kp+6656);
}
__device__ __forceinline__ void kload2(bf16x8*kf,lds_cptr kp,int j){ kf[2*j]=*(const __attribute__((address_space(3))) bf16x8*)(kp+j*2048); kf[2*j+1]=*(const __attribute__((address_space(3))) bf16x8*)(kp+j*2048+512); }
__device__ __forceinline__ s16x4 vtr(lds_cptr p){ return __builtin_bit_cast(s16x4,__builtin_amdgcn_ds_read_tr16_b64_v4i16((__attribute__((address_space(3))) v4i16_t*)p)); }
__device__ __forceinline__ float rowmax(const f32x16&p0,const f32x16&p1){
  float a=max3f(p0[0],p0[1],p1[0]),b=max3f(p0[2],p0[3],p1[1]);a=max3f(a,p1[2],p1[3]);
  #pragma unroll
  for(int r=4;r<16;r+=4){a=max3f(a,p0[r],p0[r+1]);b=max3f(b,p0[r+2],p0[r+3]);a=max3f(a,p1[r],p1[r+1]);b=max3f(b,p1[r+2],p1[r+3]);}
  const float m=max2f(a,b);
  auto rr=__builtin_amdgcn_permlane32_swap(__float_as_uint(m),__float_as_uint(m),false,false);
  return max2f(__uint_as_float(rr[0]),__uint_as_float(rr[1]));
}
__device__ __forceinline__ void pv(f32x16*o,int vb,bf16x8 pa0,bf16x8 pa1,bf16x8 pa2,bf16x8 pa3){
  #pragma unroll
  for(int d0=0;d0<4;++d0){s16x4 lo[4],hi[4];
    #pragma unroll
    for(int ks=0;ks<4;++ks){
      asm volatile("ds_read_b64_tr_b16 %0,%1 offset:%c2":"=&v"(lo[ks]):"v"(vb),"i"(d0*4096+ks*1024):"memory");
      asm volatile("ds_read_b64_tr_b16 %0,%1 offset:%c2":"=&v"(hi[ks]):"v"(vb),"i"(d0*4096+ks*1024+512):"memory");}
    asm volatile("s_waitcnt lgkmcnt(0)":::"memory");SBAR();
    #define PK(k) (bf16x8){lo[k][0],lo[k][1],lo[k][2],lo[k][3],hi[k][0],hi[k][1],hi[k][2],hi[k][3]}
    o[d0]=__builtin_amdgcn_mfma_f32_32x32x16_bf16(pa0,PK(0),o[d0],0,0,0);
    o[d0]=__builtin_amdgcn_mfma_f32_32x32x16_bf16(pa1,PK(1),o[d0],0,0,0);
    o[d0]=__builtin_amdgcn_mfma_f32_32x32x16_bf16(pa2,PK(2),o[d0],0,0,0);
    o[d0]=__builtin_amdgcn_mfma_f32_32x32x16_bf16(pa3,PK(3),o[d0],0,0,0);
    #undef PK
  }
}

#ifndef ATTN_STORE16
#define ATTN_STORE16(p,v) (*(u32x4*)(p)=(v))
#endif
template<int THRL> __device__ __forceinline__ void attn_unit(int b,int hq,int hv,int qb,const bf16*Q,const bf16*__restrict__ K,const bf16*__restrict__ V,bf16*O,char*shm){
  int tid_=threadIdx.x; asm volatile("":"+v"(tid_));
  const int tid=tid_,lane=tid&63,r32=lane&31,hi=lane>>5; const int wid=__builtin_amdgcn_readfirstlane(tid>>6);
  const long rowbase=(long)b*SEQ; const int q0=qb*QB;
  const bf16*Qw=Q+(rowbase+q0+wid*QBLK)*DM+hq*D;
  const bf16*Kh=K+rowbase*DM+hq*D,*Vh=V+rowbase*DM+hv*2*D;
  const unsigned lds0=(unsigned)(uintptr_t)shm;
  float*wsf=(float*)(shm+LDS_WS)+wid*64;
  const bf16*ksrc=Kh+(long)lane*DM+wid*8;
  const bf16*vsrc=Vh+(long)(16*(wid&3)+(lane>>2))*DM+(wid>>2)*32+(lane&3)*8;
  const unsigned kdst=lds0+LDS_K+wid*1024, vdst=lds0+LDS_V+wid*1024;
  #define DMA_K(t,slot) glds16(ksrc+(long)(t)*KVBLK*DM,(unsigned)__builtin_amdgcn_readfirstlane(kdst+(slot)))
  #define DMA_V(t,slot) do{ glds16(vsrc+(long)(t)*KVBLK*DM,(unsigned)__builtin_amdgcn_readfirstlane(vdst+2*(slot))); glds16(vsrc+(long)(t)*KVBLK*DM+64,(unsigned)__builtin_amdgcn_readfirstlane(vdst+2*(slot)+8192)); }while(0)
  const int vb0=(int)(lds0+LDS_V)+((lane>>4)&1)*32+(lane&3)*8+(4*hi+((lane&15)>>2))*64;
  const char*Kbase=shm+LDS_K; bf16x8 kf[8];
  const lds_cptr shm3=(lds_cptr)shm; const lds_cptr kp0=shm3+LDS_K+hi*1024+r32*16; const lds_cptr vp0=shm3+LDS_V+((lane>>4)&1)*32+(lane&3)*8+(4*hi+((lane&15)>>2))*64;
  const int NT=(q0+QB)/KVBLK;
  DMA_K(0,0);DMA_V(0,0);DMA_K(1,SLOTB);
  bf16x8 qr[4];
  #pragma unroll
  for(int d0=0;d0<4;++d0)qr[d0]=*reinterpret_cast<const bf16x8*>(&Qw[(long)r32*DM+d0*16+hi*8]);
  float mhat=0.f,l_reg=0.f;f32x16 o[4];o[0]=f32x16{};o[1]=f32x16{};o[2]=f32x16{};o[3]=f32x16{};
  const int qrel=wid*QBLK+r32;
  #define CMASK(P0,P1,t) do{int jb_=(t)-(NT-4); if(jb_>=0)cmask(P0,P1,jb_,qrel,hi);}while(0)
  bool resc=false;
  #define START(P0,P1) do{ const float rm=rowmax(P0,P1); resc=false; \
    { const float dl=rm; mhat=fadd_s(mhat,dl); \
      _Pragma("unroll") for(int r=0;r<16;++r){P0[r]=fsub_s(P0[r],dl);P1[r]=fsub_s(P1[r],dl);} } \
    _Pragma("unroll") for(int r=0;r<16;++r)P0[r]=__builtin_amdgcn_exp2f(P0[r]); }while(0)
  #define RESC() do{ if(resc){ asm volatile("s_waitcnt lgkmcnt(0)":::"memory"); \
      _Pragma("unroll") for(int d_=0;d_<4;++d_) _Pragma("unroll") for(int r=0;r<16;++r)o[d_][r]*=wsf[crow(r,hi)]; } }while(0)
  f32x16 pA0,pA1,pB0,pB1;
  int sl_prev=0,sl_cur=0,sl_next=SLOTB;
  #define ROT() do{sl_prev=sl_cur;sl_cur=sl_next;sl_next=(sl_next==(NSLOT-1)*SLOTB)?0:sl_next+SLOTB;}while(0)
  DMA_K(2,2*SLOTB);
  WAIT_BAR(4);
  qkt(pA0,pA1,Kbase,qr,r32,hi);asm volatile("s_nop 15\n\ts_nop 7":"+v"(pA0),"+v"(pA1));CMASK(pA0,pA1,0);
  START(pA0,pA1);
  _Pragma("unroll") for(int r=0;r<16;++r)pA1[r]=__builtin_amdgcn_exp2f(pA1[r]);
  WAIT_BAR(0);
  DMA_K(3,0);DMA_V(1,SLOTB);
  ROT();
  kload8(kf,kp0+sl_cur);
  WAIT_BAR(3);
  s16x4 vlo[8],vhi[8]; u32x4 pw0,pw1,pw2,pw3;
  #define PKW(P,B) cvtpk_s(P[B],P[B+1])
  #define PAF(k) __builtin_bit_cast(bf16x8,pw##k)
  #define VFR(i) (bf16x8){vlo[i][0],vlo[i][1],vlo[i][2],vlo[i][3],vhi[i][0],vhi[i][1],vhi[i][2],vhi[i][3]}
  #define PIN(x) asm volatile("":"+v"(x))
  #define MX3(a,b,c) __builtin_fmaxf(__builtin_fmaxf((a),(b)),(c))
  #define GAPA(MF,A0,A1,A2,A3,W0,W1,PW) do{ MF; sacc+=A0; sacc+=A1; sacc+=A2; sacc+=A3; PIN(sacc); W0; W1; PIN(PW); SBAR(); }while(0)
  #define EX(v) __builtin_amdgcn_exp2f(v)
  #define GAPB(MF,X,B) do{ MF; X[B]=EX(X[B]); X[B+1]=EX(X[B+1]); X[B+2]=EX(X[B+2]); X[B+3]=EX(X[B+3]); PIN(X); SBAR(); }while(0)
  #define VRD(i) do{ vlo[i]=vtr(vp_+(((i)>>2)*4096+((i)&3)*1024)); vhi[i]=vtr(vp_+(((i)>>2)*4096+((i)&3)*1024+512)); }while(0)
  #define VRD2(i) do{ vlo[i]=vtr(vp_+(8192+((i)>>2)*4096+((i)&3)*1024)); vhi[i]=vtr(vp_+(8192+((i)>>2)*4096+((i)&3)*1024+512)); SBAR(); }while(0)
  #define GAPB2(MF,X,B) do{ MF; X[B]=EX(X[B]-mhat); X[B+1]=EX(X[B+1]-mhat); PIN(X); SBAR(); }while(0)
  #define KRD(G,j) do{ if(G){ kload2(kf,kp0+sl_next,j); SBAR(); } }while(0)
  #define STEP(C0,C1,P0,P1,t,GK,GV,GL) do{ SBAR(); \
    const lds_cptr vp_=vp0+2*sl_prev; \
    VRD(0); SBAR(); float sacc=(P0[0]+P0[1]); \
    GAPA(C0=__builtin_amdgcn_mfma_f32_32x32x16_bf16(kf[0],qr[0],f32x16{},0,0,0), P0[2],P0[3],P0[4],P0[5],     pw0[0]=PKW(P0,0), pw0[1]=PKW(P0,2), pw0); \
    VRD(4); SBAR(); GAPA(C1=__builtin_amdgcn_mfma_f32_32x32x16_bf16(kf[1],qr[0],f32x16{},0,0,0), P0[6],P0[7],P0[8],P0[9],     pw0[2]=PKW(P0,4), pw0[3]=PKW(P0,6), pw0); \
    VRD(1); SBAR(); GAPA(C0=__builtin_amdgcn_mfma_f32_32x32x16_bf16(kf[2],qr[1],C0,0,0,0),   P0[10],P0[11],P0[12],P0[13], pw1[0]=PKW(P0,8), pw1[1]=PKW(P0,10), pw1); \
    VRD(5); SBAR(); GAPA(C1=__builtin_amdgcn_mfma_f32_32x32x16_bf16(kf[3],qr[1],C1,0,0,0),   P0[14],P0[15],P1[0],P1[1],   pw1[2]=PKW(P0,12),pw1[3]=PKW(P0,14), pw1); \
    VRD(2); SBAR(); GAPA(C0=__builtin_amdgcn_mfma_f32_32x32x16_bf16(kf[4],qr[2],C0,0,0,0),   P1[2],P1[3],P1[4],P1[5],     pw2[0]=PKW(P1,0), pw2[1]=PKW(P1,2), pw2); \
    VRD(6); SBAR(); GAPA(C1=__builtin_amdgcn_mfma_f32_32x32x16_bf16(kf[5],qr[2],C1,0,0,0),   P1[6],P1[7],P1[8],P1[9],     pw2[2]=PKW(P1,4), pw2[3]=PKW(P1,6), pw2); \
    VRD(3); SBAR(); GAPA(C0=__builtin_amdgcn_mfma_f32_32x32x16_bf16(kf[6],qr[3],C0,0,0,0),   P1[10],P1[11],P1[12],P1[13], pw3[0]=PKW(P1,8), pw3[1]=PKW(P1,10), pw3); \
    VRD(7); SBAR(); GAPA(C1=__builtin_amdgcn_mfma_f32_32x32x16_bf16(kf[7],qr[3],C1,0,0,0),   P1[14],P1[15],0.f,0.f,       pw3[2]=PKW(P1,12),pw3[3]=PKW(P1,14), pw3); \
    l_reg+=sacc; \
    if(GK){DMA_K((t)+3,sl_cur);} if(GV){DMA_V((t)+1,sl_next);} \
    CMASK(C0,C1,t); \
    { float a=MX3(C0[0],C0[1],C1[0]),b=MX3(C0[2],C0[3],C1[1]); a=MX3(a,C1[2],C1[3]); \
      _Pragma("unroll") for(int r=4;r<16;r+=4){a=MX3(a,C0[r],C0[r+1]);b=MX3(b,C0[r+2],C0[r+3]);a=MX3(a,C1[r],C1[r+1]);b=MX3(b,C1[r+2],C1[r+3]);} \
      float rm=__builtin_fmaxf(a,b); { auto rr=__builtin_amdgcn_permlane32_swap(__float_as_uint(rm),__float_as_uint(rm),false,false); rm=__builtin_fmaxf(__uint_as_float(rr[0]),__uint_as_float(rr[1])); } \
      resc=false; \
      rm-=mhat;     \
      if(__builtin_expect(__any(rm>(float)THRL),0)){ const float dl=__builtin_fmaxf(rm,0.f); mhat+=dl; \
        const float f=__builtin_amdgcn_exp2f(-dl); l_reg*=f; if(hi==0)wsf[r32]=f; resc=true; } } \
    SBAR(); \
    GAPB2(o[0]=__builtin_amdgcn_mfma_f32_32x32x16_bf16(PAF(0),VFR(0),o[0],0,0,0), C0,0); VRD2(0); \
    GAPB2(o[1]=__builtin_amdgcn_mfma_f32_32x32x16_bf16(PAF(0),VFR(4),o[1],0,0,0), C0,2); VRD2(4); \
    KRD(GL,0); GAPB2(o[0]=__builtin_amdgcn_mfma_f32_32x32x16_bf16(PAF(1),VFR(1),o[0],0,0,0), C0,4); VRD2(1); \
    KRD(GL,1); GAPB2(o[1]=__builtin_amdgcn_mfma_f32_32x32x16_bf16(PAF(1),VFR(5),o[1],0,0,0), C0,6); VRD2(5); \
    KRD(GL,2); GAPB2(o[0]=__builtin_amdgcn_mfma_f32_32x32x16_bf16(PAF(2),VFR(2),o[0],0,0,0), C0,8); VRD2(2); \
    KRD(GL,3); GAPB2(o[1]=__builtin_amdgcn_mfma_f32_32x32x16_bf16(PAF(2),VFR(6),o[1],0,0,0), C0,10); VRD2(6); \
    GAPB2(o[0]=__builtin_amdgcn_mfma_f32_32x32x16_bf16(PAF(3),VFR(3),o[0],0,0,0), C0,12); VRD2(3); \
    GAPB2(o[1]=__builtin_amdgcn_mfma_f32_32x32x16_bf16(PAF(3),VFR(7),o[1],0,0,0), C0,14); VRD2(7); \
    GAPB2(o[2]=__builtin_amdgcn_mfma_f32_32x32x16_bf16(PAF(0),VFR(0),o[2],0,0,0), C1,0); \
    GAPB2(o[3]=__builtin_amdgcn_mfma_f32_32x32x16_bf16(PAF(0),VFR(4),o[3],0,0,0), C1,2); \
    GAPB2(o[2]=__builtin_amdgcn_mfma_f32_32x32x16_bf16(PAF(1),VFR(1),o[2],0,0,0), C1,4); \
    GAPB2(o[3]=__builtin_amdgcn_mfma_f32_32x32x16_bf16(PAF(1),VFR(5),o[3],0,0,0), C1,6); \
    GAPB2(o[2]=__builtin_amdgcn_mfma_f32_32x32x16_bf16(PAF(2),VFR(2),o[2],0,0,0), C1,8); \
    GAPB2(o[3]=__builtin_amdgcn_mfma_f32_32x32x16_bf16(PAF(2),VFR(6),o[3],0,0,0), C1,10); \
    GAPB2(o[2]=__builtin_amdgcn_mfma_f32_32x32x16_bf16(PAF(3),VFR(3),o[2],0,0,0), C1,12); \
    GAPB2(o[3]=__builtin_amdgcn_mfma_f32_32x32x16_bf16(PAF(3),VFR(7),o[3],0,0,0), C1,14); \
    }while(0)
  int t=1;
  #undef CMASK
  #define CMASK(P0,P1,t) do{}while(0)
  for(;t+5<NT;t+=2){
    STEP(pB0,pB1,pA0,pA1,t,true,true,true);     WAIT_BAR(3); RESC(); ROT();
    STEP(pA0,pA1,pB0,pB1,t+1,true,true,true);   WAIT_BAR(3); RESC(); ROT();
  }
  #undef CMASK
  #define CMASK(P0,P1,t) do{int jb_=(t)-(NT-4); if(jb_>=0)cmask(P0,P1,jb_,qrel,hi);}while(0)
  #define ENDW(tt) do{ if((tt)+3<NT){WAIT_BAR(3);} else if((tt)+2<NT){WAIT_BAR(2);} else {WAIT_BAR(0);} }while(0)
  for(;t+1<NT;t+=2){
    STEP(pB0,pB1,pA0,pA1,t,(t+3<NT),(t+1<NT),(t+1<NT));       ENDW(t);   RESC(); ROT();
    STEP(pA0,pA1,pB0,pB1,t+1,(t+4<NT),(t+2<NT),(t+2<NT));     ENDW(t+1); RESC(); ROT();
  }
  STEP(pB0,pB1,pA0,pA1,NT-1,false,false,false); RESC();
  { float sacc=pB0[0]+pB0[1]; _Pragma("unroll") for(int r=2;r<16;++r)sacc+=pB0[r]; _Pragma("unroll") for(int r=0;r<16;++r)sacc+=pB1[r]; l_reg+=sacc;
    pw0=(u32x4){PKW(pB0,0),PKW(pB0,2),PKW(pB0,4),PKW(pB0,6)};pw1=(u32x4){PKW(pB0,8),PKW(pB0,10),PKW(pB0,12),PKW(pB0,14)};pw2=(u32x4){PKW(pB1,0),PKW(pB1,2),PKW(pB1,4),PKW(pB1,6)};pw3=(u32x4){PKW(pB1,8),PKW(pB1,10),PKW(pB1,12),PKW(pB1,14)};
    SBAR(); pv(o,vb0+2*sl_cur,PAF(0),PAF(1),PAF(2),PAF(3)); }
  #undef PKW
  #undef PAF
  #undef VFR
  #undef PIN
  #undef MX3
  #undef GAPA
  #undef GAPB
  #undef GAPB2
  #undef VRD2
  #undef EX
  #undef VRD
  #undef KRD
  #undef STEP
  #undef ENDW
  {auto rr=__builtin_amdgcn_permlane32_swap(__float_as_uint(l_reg),__float_as_uint(l_reg),false,false);l_reg=__uint_as_float(rr[0])+__uint_as_float(rr[1]);}
  if(hi==0)wsf[32+r32]=l_reg;asm volatile("s_waitcnt lgkmcnt(0)":::"memory");
  float rli[16];
  #pragma unroll
  for(int r=0;r<16;++r)rli[r]=__builtin_amdgcn_rcpf(wsf[32+crow(r,hi)]);
  bf16*Ow=O+(rowbase+q0+wid*QBLK)*DM+hv*2*D;
  { bf16*stg=(bf16*)(shm+LDS_OST)+wid*2048;
    #pragma unroll
    for(int ps=0;ps<2;++ps){
    #pragma unroll
    for(int r=0;r<16;++r){const int orow=crow(r,hi);
      #pragma unroll
      for(int d0=0;d0<2;++d0)stg[orow*64+d0*32+r32]=__float2bfloat16(o[2*ps+d0][r]*rli[r]);}
    asm volatile("s_waitcnt lgkmcnt(0)":::"memory");
    #pragma unroll
    for(int i=0;i<4;++i){const int row=i*8+(lane>>3),ch=lane&7; const u32x4 v=*(const u32x4*)(stg+row*64+ch*8); ATTN_STORE16(Ow+(long)row*DM+ps*64+ch*8,v);}
    asm volatile("s_waitcnt lgkmcnt(0)":::"memory"); } }
  asm volatile("s_waitcnt lgkmcnt(0)\n\ts_barrier":::"memory");
  #undef DMA_K
  #undef DMA_V
  #undef CMASK
  #undef START
  #undef RESC
  #undef ROT
}
constexpr int ATTN_LDS_BYTES=LDS_BYTES;
struct AttnTensors { const bf16* Q; const bf16* K; const bf16* V; bf16* O0; bf16* O1; };
template<int THRL=8> __device__ __forceinline__ void attn_phase(char*lds,const AttnTensors&T,int vcu){
  const int combo=vcu>>3, s=vcu&7, m=combo&1, h=(combo>>1)&7, b=combo>>4;
  bf16* O = m ? T.O1 : T.O0;
  for(int i=0;i<8;++i){ const int j=i>>1, qb=(i&1)?(16*j+15-s):(16*j+s); attn_unit<THRL>(b,2*h+m,h,qb,T.Q,T.K,T.V,O,lds); }
}
#undef SBAR
#undef WAIT_BAR
}
constexpr int NWAVES = 8;
#ifndef MK_N_LAUNCHES
#define MK_N_LAUNCHES 1
#endif
constexpr int N_PHASES = 9;
#ifndef PROBE_DUP
#define PROBE_DUP (-1)
#endif
#define REPS(k) for (int rep_ = 0; rep_ < ((PROBE_DUP == (k)) ? 2 : 1); ++rep_)
constexpr int N_LAUNCHES = MK_N_LAUNCHES;
static_assert(N_LAUNCHES == 1 || N_LAUNCHES == N_PHASES, "MK_N_LAUNCHES is 1 or 9");

constexpr int T = 32768, SEQL = 16384, D = 2048, NIN = 5120;
constexpr float EPS = 1e-6f;
constexpr float LAMBDA_INIT = 0.2f;

constexpr size_t MiB = 1u << 20;
constexpr size_t WS_CTL = 0, CTL_ZERO_BYTES = 32768;
constexpr size_t WS_WIN = 2 * MiB;
constexpr size_t WS_WOUT = 22 * MiB;
constexpr size_t WS_WSC = 30 * MiB;
constexpr size_t WS_ROPE = 38 * MiB;
constexpr size_t WS_USC = 39 * MiB, WS_VSC = 39 * MiB + 65536;
constexpr size_t WS_RT = 39 * MiB + 262144;
constexpr size_t WS_RINV = 39 * MiB + 524288;
constexpr size_t WS_XN = 40 * MiB;
constexpr size_t WS_Q = 168 * MiB, WS_K = 232 * MiB, WS_V = 296 * MiB, WS_U = 360 * MiB, WS_Z = 424 * MiB;
constexpr size_t WS_O0 = 488 * MiB, WS_O1 = 552 * MiB;
constexpr size_t WS_MIX = 616 * MiB;
constexpr size_t WS_SC = 168 * MiB;
constexpr size_t WS_IDX = 872 * MiB, WS_GATE = 888 * MiB;
constexpr size_t WS_SSQ = 904 * MiB;
constexpr size_t WS_UT2 = 776 * MiB, WS_VT2 = 840 * MiB;
constexpr size_t WS_EB16 = 568 * MiB;
constexpr size_t WS_END = 908 * MiB;
static_assert(WS_SC + (size_t)2048 * T * 4 <= WS_Z, "SC overlay stays inside Q|K|V|U");
constexpr int CW_TMO = 0;
constexpr int CW_BAR = 4096;
static_assert((CW_BAR + 3456) * 4 <= (int)CTL_ZERO_BYTES, "barrier words inside the per-call memset");

constexpr int RING_OFF = 0, RING_BYTES = 131072;
constexpr int LDSCTL_OFF = RING_BYTES, MISC_OFF = LDSCTL_OFF + 320;
constexpr int SMALL_OFF = RING_BYTES + 1024;
constexpr int LDS_BYTES = 147456;
static_assert(MISC_OFF + 128 <= SMALL_OFF && SMALL_OFF + 4096 <= LDS_BYTES, "LDS map");

#define GAS __attribute__((address_space(1)))
#define LAS __attribute__((address_space(3)))
typedef unsigned short bf16;
typedef unsigned v4u __attribute__((ext_vector_type(4)));
typedef float f32x4 __attribute__((ext_vector_type(4)));
typedef short bf16x8 __attribute__((ext_vector_type(8)));
typedef GAS unsigned gu32;
typedef GAS unsigned long long gu64;
#define RLX_AGENT __ATOMIC_RELAXED, __HIP_MEMORY_SCOPE_AGENT
#define LDS_WAIT() asm volatile("s_waitcnt lgkmcnt(0)" ::: "memory")
#define VM_WAIT() asm volatile("s_waitcnt vmcnt(0)" ::: "memory")
__device__ __forceinline__ unsigned long long rt() { return __builtin_amdgcn_s_memrealtime(); }
__device__ __forceinline__ unsigned f2bf(float f) { unsigned u = __builtin_bit_cast(unsigned, f); return (u + 0x7fffu + ((u >> 16) & 1u)) >> 16; }
__device__ __forceinline__ unsigned pk2(float lo, float hi) { return f2bf(lo) | (f2bf(hi) << 16); }

#define XB_TMO      128
#define XB_XCNT(j)  (256  + 64 * (j))
#define XB_XSUB(j)  (1280 + 64 * (j))
#define XB_XGEN(j)  (2304 + 64 * (j))
#define XB_TOP      3328
#define XB_TOPGEN   3392
#define XCD_BAR_WORDS 3456
#define XB_SPIN_CAP (1u << 18)

__device__ __forceinline__ unsigned xb_ld(unsigned* p)              { return __hip_atomic_load(p, __ATOMIC_RELAXED, __HIP_MEMORY_SCOPE_AGENT); }
__device__ __forceinline__ unsigned xb_add(unsigned* p, unsigned v) { return __hip_atomic_fetch_add(p, v, __ATOMIC_RELAXED, __HIP_MEMORY_SCOPE_AGENT); }
__device__ __forceinline__ unsigned xb_xcc_id() { return (unsigned)__builtin_amdgcn_s_getreg((3 << 11) | 20) & 0xFu; }
#define XB_SPIN(cond, bar) do { unsigned _sp = 0; while (cond) { __builtin_amdgcn_s_sleep(1); \
    if ((++_sp & 255u) == 0u) { if (xb_ld(&(bar)[XB_TMO])) break; if (_sp > XB_SPIN_CAP) { atomicAdd(&(bar)[XB_TMO], 1u); break; } } } } while (0)

struct XcdBarrier {
    unsigned* bar; unsigned x;
    volatile LAS unsigned* st;
};

__device__ __forceinline__ XcdBarrier xcd_barrier_post(unsigned* bar, volatile LAS unsigned* st) {
    XcdBarrier b; b.bar = bar; b.x = xb_xcc_id(); b.st = st;
    if (threadIdx.x == 0) (void)xb_add(&bar[XB_XCNT(b.x)], 1u);
    return b;
}
__device__ __forceinline__ void xcd_barrier_complete(unsigned* bar, unsigned x, unsigned& nloc, unsigned& nx) {
    const unsigned G = gridDim.x * gridDim.y * gridDim.z;
    unsigned sum, cnt, mine, sp = 0u;
    for (;;) {
        sum = 0u; cnt = 0u; mine = 0u;
#pragma unroll
        for (unsigned j = 0; j < 16; ++j) { const unsigned c = xb_ld(&bar[XB_XCNT(j)]); sum += c; cnt += (c > 0u) ? 1u : 0u; mine = (j == x) ? c : mine; }
        if (sum == G) break;
        __builtin_amdgcn_s_sleep(1);
        if ((++sp & 255u) == 0u) { if (xb_ld(&bar[XB_TMO])) break; if (sp > XB_SPIN_CAP) { atomicAdd(&bar[XB_TMO], 1u); break; } }
    }
    nloc = mine > 0u ? mine : 1u; nx = cnt > 0u ? cnt : 1u;
}

__device__ __forceinline__ void xcd_barrier(const XcdBarrier& b) {
    asm volatile("s_waitcnt vmcnt(0)" ::: "memory");
    __syncthreads();
    if (threadIdx.x == 0) {
        unsigned* bar = b.bar;
        __builtin_amdgcn_s_waitcnt(0);
        unsigned nloc = b.st[0], nx = b.st[1];
        if (nloc == 0u) { xcd_barrier_complete(bar, b.x, nloc, nx); b.st[0] = nloc; b.st[1] = nx; }
        const unsigned old = xb_add(&bar[XB_XSUB(b.x)], 1u);
        const unsigned gen = old / nloc;
        if (old + 1u == (gen + 1u) * nloc) {
            __builtin_amdgcn_fence(__ATOMIC_RELEASE, "agent");
            asm volatile("s_waitcnt vmcnt(0)" ::: "memory");
            const unsigned og = xb_add(&bar[XB_TOP], 1u);
            const unsigned tg = og / nx;
            if (og + 1u == (tg + 1u) * nx) xb_add(&bar[XB_TOPGEN], 1u);
            else XB_SPIN(xb_ld(&bar[XB_TOPGEN]) == tg, bar);
            __builtin_amdgcn_fence(__ATOMIC_ACQUIRE, "agent");
            xb_add(&bar[XB_XGEN(b.x)], 1u);
            asm volatile("s_waitcnt vmcnt(0)" ::: "memory");
        } else {
            XB_SPIN(xb_ld(&bar[XB_XGEN(b.x)]) == gen, bar);
            __builtin_amdgcn_fence(__ATOMIC_ACQUIRE, "agent");
            asm volatile("s_waitcnt vmcnt(0)" ::: "memory");
        }
    }
    __syncthreads();
}


typedef unsigned long long u64;
typedef float f32x2v __attribute__((ext_vector_type(2)));
typedef __bf16 bf16x2_t __attribute__((ext_vector_type(2)));
__device__ __forceinline__ float bflo(unsigned u) { return __builtin_bit_cast(float, u << 16); }
__device__ __forceinline__ float bfhi(unsigned u) { return __builtin_bit_cast(float, u & 0xffff0000u); }
__device__ __forceinline__ float wave_sum(float v) {
#pragma unroll
    for (int o = 1; o < 64; o <<= 1) v += __shfl_xor(v, o);
    return v;
}
__device__ __forceinline__ float gelu_tanh(float x) { return pg8::gelu_tanh(x); }

__device__ const float c_invf[8] = {1.0f, 0.1939227432012558f, 0.03760603070259094f, 0.007292664609849453f, 0.0014142135623842478f, 0.00027424818836152554f, 5.318296098266728e-05f, 1.0313386155758053e-05f};

struct Args { const float* in[19]; float* out; unsigned char* ws; int ph_lo, ph_hi, li, pad; };
#define F_IN(k) (args.in[k])
#define F_WS(ty, off) ((ty*)(F.ws + (off)))
struct Frame {
    LAS unsigned char* lds;
    volatile LAS unsigned* MISC;
    gu32* ctl;
    int tid, lane, wave;
    int vcu, G;
    float* out; unsigned char* ws;
};

__device__ __forceinline__ void p0_transpose_item(const float* W, int K, int N, bf16* WT, LAS float* scr, int item, int lane, int rope_rows) {
    const int nblk = N / 32, kb = item / nblk, nb = item % nblk, k0 = 64 * kb, n0 = 32 * nb;
#pragma unroll 8
    for (int i = 0; i < 32; ++i) { const int kk = 2 * i + (lane >> 5); scr[kk * 33 + (lane & 31)] = W[(size_t)(k0 + kk) * N + n0 + (lane & 31)]; }
    LDS_WAIT(); asm volatile("" ::: "memory");
    const int c = lane & 7;
    const bool perm = (n0 < rope_rows) && ((n0 & 63) == 0);
#pragma unroll
    for (int j = 0; j < 4; ++j) { const int n = (lane >> 3) + 8 * j; const int src = (perm && n < 16) ? ((n >> 1) + 8 * (n & 1)) : n; const LAS float* s = scr + (8 * c) * 33 + src;
        v4u o; o.x = pk2(s[0 * 33], s[1 * 33]); o.y = pk2(s[2 * 33], s[3 * 33]); o.z = pk2(s[4 * 33], s[5 * 33]); o.w = pk2(s[6 * 33], s[7 * 33]);
        *(GAS v4u*)(WT + (size_t)(n0 + n) * K + k0 + 8 * c) = o; }
    LDS_WAIT(); asm volatile("" ::: "memory");
}
struct RmsRows2 { f32x4 v[8], w[8]; };
__device__ __forceinline__ void rms_rows2_load(RmsRows2& R, const float* xrow0, const float* xrow1, int lane) {
    const GAS f32x4* xr0 = (const GAS f32x4*)xrow0 + lane; const GAS f32x4* xr1 = (const GAS f32x4*)xrow1 + lane;
#pragma unroll
    for (int j = 0; j < 8; ++j) { R.v[j] = xr0[64 * j]; R.w[j] = xr1[64 * j]; }
}
__device__ __forceinline__ void rms_rows2_finish(const RmsRows2& R, const float* g, bf16* orow0, bf16* orow1, int lane, float* rinv0, float* rinv1) {
    float s0 = 0.f, s1 = 0.f;
#pragma unroll
    for (int j = 0; j < 8; ++j) { s0 += (R.v[j].x * R.v[j].x + R.v[j].y * R.v[j].y) + (R.v[j].z * R.v[j].z + R.v[j].w * R.v[j].w); s1 += (R.w[j].x * R.w[j].x + R.w[j].y * R.w[j].y) + (R.w[j].z * R.w[j].z + R.w[j].w * R.w[j].w); }
    const float q0 = sqrtf(wave_sum(s0) * (1.f / D) + EPS), q1 = sqrtf(wave_sum(s1) * (1.f / D) + EPS); const float r0 = 1.f / q0, r1 = 1.f / q1;
    if (lane == 0) { *rinv0 = q0; *rinv1 = q1; }
    const GAS f32x4* gr = (const GAS f32x4*)g + lane;
    GAS u64* o0 = (GAS u64*)orow0 + lane; GAS u64* o1 = (GAS u64*)orow1 + lane;
#pragma unroll
    for (int j = 0; j < 8; ++j) { const f32x4 gg = gr[64 * j];
        o0[64 * j] = (u64)pk2(R.v[j].x * r0 * gg.x, R.v[j].y * r0 * gg.y) | ((u64)pk2(R.v[j].z * r0 * gg.z, R.v[j].w * r0 * gg.w) << 32);
        o1[64 * j] = (u64)pk2(R.w[j].x * r1 * gg.x, R.w[j].y * r1 * gg.y) | ((u64)pk2(R.w[j].z * r1 * gg.z, R.w[j].w * r1 * gg.w) << 32); }
}
__device__ __forceinline__ void p0_wsc_item(Frame& F, const Args& args, int it) {
    const int g = it >> 5, kk0 = (it & 31) * 64;
    LAS float* sk = (LAS float*)(F.lds + RING_OFF);
    LAS float* wq = sk + 128 * 129;
    const float* skg = F_IN(15) + (size_t)g * 128 * 128;
    for (int i = F.tid; i < 128 * 32; i += NWAVES * 64) { const int k = i >> 5, d4 = (i & 31) * 4; const f32x4 v = *(const GAS f32x4*)(skg + k * 128 + d4);
        sk[k * 129 + d4] = v.x; sk[k * 129 + d4 + 1] = v.y; sk[k * 129 + d4 + 2] = v.z; sk[k * 129 + d4 + 3] = v.w; }
    for (int i = F.tid; i < 64 * 32; i += NWAVES * 64) { const int r = i >> 5, d4 = (i & 31) * 4; const f32x4 v = *(const GAS f32x4*)(F_IN(14) + (size_t)(kk0 + r) * 2048 + g * 128 + d4);
        wq[r * 129 + d4] = v.x; wq[r * 129 + d4 + 1] = v.y; wq[r * 129 + d4 + 2] = v.z; wq[r * 129 + d4 + 3] = v.w; }
    __syncthreads();
    const int kkl = F.tid & 63, kb = (F.tid >> 6) * 16;
    float acc[16];
#pragma unroll
    for (int j = 0; j < 16; ++j) acc[j] = 0.f;
    for (int d = 0; d < 128; ++d) { const float a = wq[kkl * 129 + d];
#pragma unroll
        for (int j = 0; j < 16; ++j) acc[j] += a * sk[(kb + j) * 129 + d]; }
    const float fg = F_IN(13)[kk0 + kkl];
#pragma unroll
    for (int j = 0; j < 16; ++j) F_WS(bf16, WS_WSC)[(size_t)(g * 128 + kb + j) * 2048 + kk0 + kkl] = (bf16)f2bf(acc[j] * fg);
    __syncthreads();
}
__device__ __forceinline__ void p0_prologue(Frame& F, const Args& args) {
    LAS float* scr = (LAS float*)(F.lds + RING_OFF + F.wave * 16384);
    const int gw = F.vcu * NWAVES + F.wave, NGW = F.G * NWAVES;
    constexpr int I_IN = (D / 64) * (NIN / 32), I_OUT = (D / 64) * (D / 32);
    for (int it = gw; it < I_IN + I_OUT; it += NGW) {
        if (it < I_IN) p0_transpose_item(F_IN(2), D, NIN, F_WS(bf16, WS_WIN), scr, it, F.lane, 2048);
        else p0_transpose_item(F_IN(12), D, D, F_WS(bf16, WS_WOUT), scr, it - I_IN, F.lane, 0);
    }
    __syncthreads();
    for (int it = F.vcu; it < 512; it += F.G) p0_wsc_item(F, args, it);
    { const int gt = F.vcu * (NWAVES * 64) + F.tid, NGT = F.G * NWAVES * 64;
      for (int i = gt; i < SEQL * 8; i += NGT) { const int pos = i >> 3, f = i & 7;
          const float angf = (float)pos * c_invf[f];
          const double a = (double)angf, n = __builtin_rint(a * 0.15915494309189535);
          double r = __builtin_fma(-n, 6.283185307179586, a); r = __builtin_fma(-n, 2.4492935982947064e-16, r);
          const double r2 = r * r; double sn = 1.0, cs = 1.0;
#pragma unroll
          for (int k = 12; k >= 1; --k) { sn = 1.0 - r2 * (1.0 / (double)((2 * k) * (2 * k + 1))) * sn; cs = 1.0 - r2 * (1.0 / (double)((2 * k - 1) * (2 * k))) * cs; }
          sn *= r;
          *(GAS f32x2v*)(F_WS(float, WS_ROPE) + (size_t)i * 2) = (f32x2v){(float)cs, (float)sn}; } }
    for (int r0 = gw; r0 < T; r0 += 2 * NGW) { RmsRows2 XR;
        rms_rows2_load(XR, F_IN(0) + (size_t)r0 * D, F_IN(0) + (size_t)(r0 + NGW) * D, F.lane);
        rms_rows2_finish(XR, F_IN(1), F_WS(bf16, WS_XN) + (size_t)r0 * D, F_WS(bf16, WS_XN) + (size_t)(r0 + NGW) * D, F.lane, F_WS(float, WS_RINV) + r0, F_WS(float, WS_RINV) + r0 + NGW); }
}

__device__ __forceinline__ void peer_tables_rows(Frame& F, const Args& args) {
    const int gw = F.vcu * NWAVES + F.wave, NGW = F.G * NWAVES;
    {   f32x4 fg[8];
#pragma unroll
        for (int x = 0; x < 8; ++x) fg[x] = ((const GAS f32x4*)F_IN(13))[64 * x + F.lane];
        LAS unsigned char* cb = F.lds + RING_OFF + F.wave * 16384;
        constexpr int NR = 2 * 16384;
#define P0_LOAD_ROW(V, rr_) { const int rq = (rr_) < NR ? (rr_) : gw; const bool sec_ = rq >= 16384; const int row_ = sec_ ? rq - 16384 : rq; \
        const GAS f32x4* src = (const GAS f32x4*)((sec_ ? F_IN(17) : F_IN(16)) + (size_t)row_ * D) + F.lane; \
        _Pragma("unroll") for (int x = 0; x < 8; ++x) V[x] = src[64 * x]; }
        f32x4 v0[8], v1[8], v2[8];
        P0_LOAD_ROW(v0, gw) P0_LOAD_ROW(v1, gw + NGW)
        for (int rr = gw; rr < NR; rr += NGW) {
            P0_LOAD_ROW(v2, rr + 2 * NGW)
            const bool second = rr >= 16384; const int row = second ? rr - 16384 : rr; const int lane = F.lane;
            if (!second) {
#pragma unroll
                for (int x = 0; x < 8; ++x) v0[x] = v0[x] * fg[x]; }
            float am = 0.f;
#pragma unroll
            for (int x = 0; x < 8; ++x)
#pragma unroll
                for (int i = 0; i < 4; ++i) am = fmaxf(am, fabsf(v0[x][i]));
#pragma unroll
            for (int o = 1; o < 64; o <<= 1) am = fmaxf(am, __shfl_xor(am, o));
            const float sc = am > 0.f ? 6.f / am : 1.f, inv = am > 0.f ? am * (1.f / 6.f) : 1.f;
#pragma unroll
            for (int x = 0; x < 8; ++x) { unsigned p = 0u;
                p = __builtin_amdgcn_cvt_scalef32_pk_fp4_f32(p, v0[x][0] * sc, v0[x][1] * sc, 1.0f, 0);
                p = __builtin_amdgcn_cvt_scalef32_pk_fp4_f32(p, v0[x][2] * sc, v0[x][3] * sc, 1.0f, 1);
                const unsigned c0 = p & 15u, c1 = (p >> 4) & 15u, c2 = (p >> 8) & 15u, c3 = (p >> 12) & 15u;
                if (!second) *(LAS unsigned*)(cb + x * 256 + 4 * lane) = c0 | (c1 << 8) | (c2 << 16) | (c3 << 24);
                else { LAS unsigned char* q = cb + x * 256 + 64 * (lane & 3) + (lane >> 2);
                    q[0] = (unsigned char)c0; q[16] = (unsigned char)c1; q[32] = (unsigned char)c2; q[48] = (unsigned char)c3; } }
            asm volatile("s_waitcnt lgkmcnt(0)" ::: "memory");
            const v4u q0 = *(const LAS v4u*)(cb + 32 * lane), q1 = *(const LAS v4u*)(cb + 32 * lane + 16);
            asm volatile("s_waitcnt lgkmcnt(0)" ::: "memory");
            v4u o;
#define PK16(w) ((((w) | ((w) >> 4)) & 0xffu) | ((((w) | ((w) >> 4)) >> 8) & 0xff00u))
            o.x = PK16(q0.x) | (PK16(q0.y) << 16); o.y = PK16(q0.z) | (PK16(q0.w) << 16); o.z = PK16(q1.x) | (PK16(q1.y) << 16); o.w = PK16(q1.z) | (PK16(q1.w) << 16);
#undef PK16
            *(GAS v4u*)((GAS unsigned char*)(F.ws + (second ? WS_VT2 : WS_UT2)) + ((size_t)(lane >> 3) * 16384 + row) * 128 + (lane & 7) * 16) = o;
            if (lane == 0) (second ? F_WS(float, WS_VSC) : F_WS(float, WS_USC))[row] = inv;
#pragma unroll
            for (int x = 0; x < 8; ++x) { v0[x] = v1[x]; v1[x] = v2[x]; } }
#undef P0_LOAD_ROW
    }
}

__device__ __forceinline__ void combine_row(Frame& F, const Args& args, int t0, int t1, float lam) {
    v4u a[2][2], b[2][2];
#pragma unroll
    for (int u = 0; u < 2; ++u)
#pragma unroll
        for (int j = 0; j < 2; ++j) { const size_t off = (size_t)(u ? t1 : t0) * 1024 + 8 * F.lane + 512 * j; a[u][j] = *(const GAS v4u*)(F_WS(bf16, WS_O0) + off); b[u][j] = *(const GAS v4u*)(F_WS(bf16, WS_O1) + off); }
    const int d0 = (8 * F.lane) & 127;
    const f32x4 g0 = *(const GAS f32x4*)(F_IN(7) + d0), g1 = *(const GAS f32x4*)(F_IN(7) + d0 + 4);
#pragma unroll
    for (int u = 0; u < 2; ++u)
#pragma unroll
    for (int j = 0; j < 2; ++j) { const int t = u ? t1 : t0;
        float o[8]; float ss = 0.f;
#pragma unroll
        for (int i = 0; i < 4; ++i) { o[2 * i] = bflo(a[u][j][i]) - lam * bflo(b[u][j][i]); o[2 * i + 1] = bfhi(a[u][j][i]) - lam * bfhi(b[u][j][i]); ss += o[2 * i] * o[2 * i] + o[2 * i + 1] * o[2 * i + 1]; }
        ss += __shfl_xor(ss, 1); ss += __shfl_xor(ss, 2); ss += __shfl_xor(ss, 4); ss += __shfl_xor(ss, 8);
        const float r = (1.f - LAMBDA_INIT) / sqrtf(ss * (1.f / 128.f) + EPS);
        v4u w; w.x = pk2(o[0] * r * g0.x, o[1] * r * g0.y); w.y = pk2(o[2] * r * g0.z, o[3] * r * g0.w); w.z = pk2(o[4] * r * g1.x, o[5] * r * g1.y); w.w = pk2(o[6] * r * g1.z, o[7] * r * g1.w);
        *(GAS v4u*)(F_WS(bf16, WS_MIX) + (size_t)t * 2048 + 8 * F.lane + 512 * j) = w; }
}
typedef float f32x16g __attribute__((ext_vector_type(16)));
__device__ __forceinline__ int gm_crow(int r, int hi) { return (r & 3) + 8 * (r >> 2) + 4 * hi; }
__device__ __forceinline__ void gmlp_unit(Frame& F, const Args& args, int unit) {
    constexpr int ROWB = 272;
    constexpr int SZS = 132;
    LAS unsigned char* aimg = F.lds + RING_OFF;
    LAS unsigned char* bimg = aimg + 128 * ROWB;
    LAS float* szt = (LAS float*)(F.lds + RING_OFF);
    LAS float* rq = (LAS float*)(F.lds + SMALL_OFF);
    static_assert(128 * SZS * 4 <= 2 * 128 * ROWB, "product tile fits over the images");
    const int t0 = unit * 128;
    const int lane = F.lane, r32 = lane & 31, hi = lane >> 5, w = F.wave, pb = 32 * (w & 3), cb = 64 * (w >> 2);
    const int q = F.tid >> 2, cq = F.tid & 3;
    const GAS bf16* zrow = (const GAS bf16*)(F_WS(bf16, WS_Z) + (size_t)(t0 + q) * 1024 + 8 * cq);
    const GAS bf16* urow = (const GAS bf16*)(F_WS(bf16, WS_U) + (size_t)(t0 + q) * 1024 + 8 * cq);
    GAS bf16* mrow = (GAS bf16*)(F_WS(bf16, WS_MIX) + (size_t)(t0 + q) * 2048 + 1024 + 8 * cq);
    v4u rawz[4], ucur[4]; f32x4 wreg[8];
#define GM_LOAD_ZW(g_) do { _Pragma("unroll") for (int j = 0; j < 4; ++j) rawz[j] = *(const GAS v4u*)(zrow + (g_) * 128 + 32 * j); \
        _Pragma("unroll") for (int i = 0; i < 8; ++i) { const int idx = F.tid + NWAVES * 64 * i; wreg[i] = *(const GAS f32x4*)(F_IN(9) + ((size_t)(g_) * 128 + (idx >> 5)) * 128 + (idx & 31) * 4); } } while (0)
    GM_LOAD_ZW(0);
#pragma unroll
    for (int j = 0; j < 4; ++j) ucur[j] = *(const GAS v4u*)(urow + 32 * j);
    float ssrow = 0.f;
    for (int g = 0; g < 8; ++g) {
        __syncthreads();
        { float ss = 0.f;
#pragma unroll
          for (int j = 0; j < 4; ++j)
#pragma unroll
              for (int i = 0; i < 4; ++i) { const float a = bflo(rawz[j][i]), b = bfhi(rawz[j][i]); ss += a * a + b * b;
                  const int c = 8 * cq + 32 * j + 2 * i;
                  *(LAS unsigned short*)(bimg + c * ROWB + q * 2) = (unsigned short)(rawz[j][i] & 0xffffu);
                  *(LAS unsigned short*)(bimg + (c + 1) * ROWB + q * 2) = (unsigned short)(rawz[j][i] >> 16); }
          ss += __shfl_xor(ss, 1); ss += __shfl_xor(ss, 2);
          if (cq == 0) rq[q] = 1.f / sqrtf(ss * (1.f / 128.f) + EPS); }
        __syncthreads();
#pragma unroll
        for (int i = 0; i < 8; ++i) { const int idx = F.tid + NWAVES * 64 * i, p = idx >> 5, q4 = (idx & 31) * 4;
            f32x4 wv = wreg[i];
            if (p < 64 && q4 >= 64) wv = (f32x4){0.f, 0.f, 0.f, 0.f};
            const f32x4 rr = *(const LAS f32x4*)(rq + q4);
            *(LAS u64*)(aimg + p * ROWB + q4 * 2) = (u64)pk2(wv.x * rr.x, wv.y * rr.y) | ((u64)pk2(wv.z * rr.z, wv.w * rr.w) << 32); }
        v4u unext[4];
        if (g < 7) { GM_LOAD_ZW(g + 1);
#pragma unroll
            for (int j = 0; j < 4; ++j) unext[j] = *(const GAS v4u*)(urow + (g + 1) * 128 + 32 * j); }
        __syncthreads();
        f32x16g acc[2];
#pragma unroll
        for (int nb = 0; nb < 2; ++nb)
#pragma unroll
            for (int r = 0; r < 16; ++r) acc[nb][r] = 0.f;
        const int nks = (pb < 64) ? 4 : 8;
        for (int sI = 0; sI < nks; ++sI) {
            const bf16x8 af = *(const LAS bf16x8*)(aimg + (pb + r32) * ROWB + 32 * sI + 16 * hi);
#pragma unroll
            for (int nb = 0; nb < 2; ++nb) { const bf16x8 bfr = *(const LAS bf16x8*)(bimg + (cb + 32 * nb + r32) * ROWB + 32 * sI + 16 * hi);
                acc[nb] = __builtin_amdgcn_mfma_f32_32x32x16_bf16(af, bfr, acc[nb], 0, 0, 0); } }
        __syncthreads();
#pragma unroll
        for (int nb = 0; nb < 2; ++nb)
#pragma unroll
            for (int r = 0; r < 16; ++r) szt[(pb + gm_crow(r, hi)) * SZS + cb + 32 * nb + r32] = acc[nb][r];
        __syncthreads();
        { const float bias = F_IN(10)[g * 128 + q];
#pragma unroll
          for (int j = 0; j < 4; ++j) { const int c0 = 8 * cq + 32 * j;
              const f32x4 s0 = *(const LAS f32x4*)(szt + q * SZS + c0), s1 = *(const LAS f32x4*)(szt + q * SZS + c0 + 4);
              const f32x4 g0 = *(const GAS f32x4*)(F_IN(8) + g * 128 + c0), g1 = *(const GAS f32x4*)(F_IN(8) + g * 128 + c0 + 4);
              const v4u uu = ucur[j];
              const float o0 = (s0.x * g0.x + bias) * bflo(uu[0]), o1 = (s0.y * g0.y + bias) * bfhi(uu[0]), o2 = (s0.z * g0.z + bias) * bflo(uu[1]), o3 = (s0.w * g0.w + bias) * bfhi(uu[1]);
              const float o4 = (s1.x * g1.x + bias) * bflo(uu[2]), o5 = (s1.y * g1.y + bias) * bfhi(uu[2]), o6 = (s1.z * g1.z + bias) * bflo(uu[3]), o7 = (s1.w * g1.w + bias) * bfhi(uu[3]);
              ssrow += (o0 * o0 + o1 * o1) + (o2 * o2 + o3 * o3) + (o4 * o4 + o5 * o5) + (o6 * o6 + o7 * o7);
              *(GAS v4u*)(mrow + g * 128 + 32 * j) = (v4u){pk2(o0, o1), pk2(o2, o3), pk2(o4, o5), pk2(o6, o7)}; } }
        if (g < 7) {
#pragma unroll
            for (int j = 0; j < 4; ++j) ucur[j] = unext[j]; }
    }
#undef GM_LOAD_ZW
    ssrow += __shfl_xor(ssrow, 1); ssrow += __shfl_xor(ssrow, 2);
    const float rr = 1.f / sqrtf(ssrow * (1.f / 1024.f) + EPS);
    VM_WAIT();
    for (int g = 0; g < 8; ++g) { u64 raw[4][2];
#pragma unroll
        for (int j = 0; j < 4; ++j) { GAS u64* ptr = (GAS u64*)(mrow + g * 128 + 32 * j); raw[j][0] = __hip_atomic_load(ptr, __ATOMIC_RELAXED, __HIP_MEMORY_SCOPE_AGENT); raw[j][1] = __hip_atomic_load(ptr + 1, __ATOMIC_RELAXED, __HIP_MEMORY_SCOPE_AGENT); }
#pragma unroll
        for (int j = 0; j < 4; ++j) { const int c0 = 8 * cq + 32 * j;
            const f32x4 g0 = *(const GAS f32x4*)(F_IN(11) + g * 128 + c0), g1 = *(const GAS f32x4*)(F_IN(11) + g * 128 + c0 + 4);
            const unsigned a0 = (unsigned)raw[j][0], a1 = (unsigned)(raw[j][0] >> 32), a2 = (unsigned)raw[j][1], a3 = (unsigned)(raw[j][1] >> 32);
            *(GAS v4u*)(mrow + g * 128 + 32 * j) = (v4u){pk2(bflo(a0) * rr * g0.x, bfhi(a0) * rr * g0.y), pk2(bflo(a1) * rr * g0.z, bfhi(a1) * rr * g0.w),
                                                         pk2(bflo(a2) * rr * g1.x, bfhi(a2) * rr * g1.y), pk2(bflo(a3) * rr * g1.z, bfhi(a3) * rr * g1.w)}; } }
    __syncthreads();
}

__device__ __forceinline__ void topk_unit(Frame& F, const Args& args, int wu) {
    const int t = (wu >> 3) * 64 + F.lane, h = wu & 7;
    int LA[16], LB[16];
#pragma unroll
    for (int j = 0; j < 16; ++j) { LA[j] = (int)0x80000000; LB[j] = (int)0x80000000; }
    const GAS float* scA = (const GAS float*)F_WS(float, WS_SC) + (size_t)(2 * h) * 128 * T + t;
    const GAS float* scB = scA + (size_t)128 * T;
#define TK_CE(a, b) { const int hi_ = (a) > (b) ? (a) : (b); const int lo_ = (a) > (b) ? (b) : (a); (a) = hi_; (b) = lo_; }
#define TK_SORT16_ASC(c) { _Pragma("unroll") for (int k_ = 2; k_ <= 16; k_ <<= 1) { _Pragma("unroll") for (int j_ = k_ >> 1; j_ > 0; j_ >>= 1) { _Pragma("unroll") for (int i_ = 0; i_ < 16; ++i_) { const int l_ = i_ ^ j_; \
        if (l_ > i_) { if ((i_ & k_) == 0) { TK_CE(c[l_], c[i_]) } else { TK_CE(c[i_], c[l_]) } } } } } }
#define TK_MERGE16(L, c) { _Pragma("unroll") for (int i_ = 0; i_ < 16; ++i_) L[i_] = L[i_] > c[i_] ? L[i_] : c[i_]; \
        _Pragma("unroll") for (int j_ = 8; j_ > 0; j_ >>= 1) { _Pragma("unroll") for (int i_ = 0; i_ < 16; ++i_) { const int l_ = i_ ^ j_; if (l_ > i_) { TK_CE(L[i_], L[l_]) } } } }
    int ca[16], cbv[16];
#pragma unroll
    for (int i = 0; i < 16; ++i) { ca[i] = __builtin_bit_cast(int, scA[(size_t)i * T]); cbv[i] = __builtin_bit_cast(int, scB[(size_t)i * T]); }
#pragma unroll 1
    for (int k0 = 0; k0 < 128; k0 += 16) {
        int na[16], nb[16];
        const int kn = (k0 + 16 < 128) ? k0 + 16 : k0;
#pragma unroll
        for (int i = 0; i < 16; ++i) { na[i] = __builtin_bit_cast(int, scA[(size_t)(kn + i) * T]); nb[i] = __builtin_bit_cast(int, scB[(size_t)(kn + i) * T]); }
#pragma unroll
        for (int i = 0; i < 16; ++i) { const int k = k0 + i; int ka = ca[i], kb = cbv[i];
            ka ^= (ka >> 31) & 0x7fffffff; kb ^= (kb >> 31) & 0x7fffffff;
            ca[i] = (ka & ~127) | (127 - k); cbv[i] = (kb & ~127) | (127 - k); }
        TK_SORT16_ASC(ca) TK_SORT16_ASC(cbv)
        TK_MERGE16(LA, ca) TK_MERGE16(LB, cbv)
#pragma unroll
        for (int i = 0; i < 16; ++i) { ca[i] = na[i]; cbv[i] = nb[i]; }
    }
#undef TK_CE
#undef TK_SORT16_ASC
#undef TK_MERGE16
    float ssq = 0.f;
    { float sv[32];
#pragma unroll
      for (int i = 0; i < 32; ++i) sv[i] = F_WS(float, WS_SSQ)[(size_t)i * T + t];
#pragma unroll
      for (int i = 0; i < 32; ++i) ssq += sv[i]; }
    const float rt = 1.f / sqrtf(ssq * (1.f / D) + EPS);
    if (h == 0) F_WS(float, WS_RT)[t] = rt;
    float va[16], vb[16]; int ia[16], ib[16];
#pragma unroll
    for (int j = 0; j < 16; ++j) { int a = LA[j] & ~127; ia[j] = 127 - (LA[j] & 127); a ^= (a >> 31) & 0x7fffffff; va[j] = __builtin_bit_cast(float, a) * rt;
                                   int b = LB[j] & ~127; ib[j] = 127 - (LB[j] & 127); b ^= (b >> 31) & 0x7fffffff; vb[j] = __builtin_bit_cast(float, b) * rt; }
    float S[16]; int P[16];
#pragma unroll
    for (int q = 0; q < 16; ++q) { S[q] = -INFINITY; P[q] = 0; }
#pragma unroll
    for (int i = 0; i < 16; ++i)
#pragma unroll
        for (int j = 0; j < 16; ++j) if ((i + 1) * (j + 1) <= 16) {
            float s = va[i] + vb[j]; int p = ia[i] * 128 + ib[j];
#pragma unroll
            for (int q = 0; q < 16; ++q) { const bool gt = s > S[q]; const float s2 = gt ? S[q] : s; const int p2 = gt ? P[q] : p; S[q] = gt ? s : S[q]; P[q] = gt ? p : P[q]; s = s2; p = p2; }
        }
    float e[16]; float sum = 0.f;
#pragma unroll
    for (int q = 0; q < 16; ++q) { e[q] = __expf(S[q] - S[0]); sum += e[q]; }
    const float inv = 1.f / sum;
    { GAS unsigned* e16 = (GAS unsigned*)((GAS unsigned char*)(F.ws + WS_EB16) + (size_t)t * 256) + h;
#pragma unroll
      for (int g8 = 0; g8 < 8; ++g8) e16[g8 * 8] = (unsigned)P[g8] | ((unsigned)P[g8 + 8] << 16); }
    GAS v4u* ip = (GAS v4u*)(F_WS(int, WS_IDX) + (size_t)t * 128 + h * 16); GAS f32x4* gp = (GAS f32x4*)(F_WS(float, WS_GATE) + (size_t)t * 128 + h * 16);
#pragma unroll
    for (int q = 0; q < 4; ++q) { ip[q] = (v4u){(unsigned)P[4 * q], (unsigned)P[4 * q + 1], (unsigned)P[4 * q + 2], (unsigned)P[4 * q + 3]};
                                  gp[q] = (f32x4){e[4 * q] * inv, e[4 * q + 1] * inv, e[4 * q + 2] * inv, e[4 * q + 3] * inv}; }
}

typedef int v8i_t __attribute__((ext_vector_type(8)));
typedef int v2i_t __attribute__((ext_vector_type(2)));
constexpr float PEER_XS = 8.f;
constexpr size_t WS_PD = 424 * MiB;
constexpr size_t WS_WQ = 552 * MiB;
constexpr size_t WS_WSCL = 600 * MiB;
constexpr size_t WS_SSQ2 = 601 * MiB;
constexpr int PEER_SC1 = 0x7f7f7f7f;

__device__ __forceinline__ float wave_max(float v) {
#pragma unroll
    for (int o = 1; o < 64; o <<= 1) v = fmaxf(v, __shfl_xor(v, o));
    return v;
}
__device__ __forceinline__ float clamp448(float v) { return fminf(fmaxf(v, -448.f), 448.f); }
__device__ __forceinline__ void fp8_split4(float v0, float v1, float v2, float v3, unsigned& hi, unsigned& lo) {
    v0 = clamp448(v0); v1 = clamp448(v1); v2 = clamp448(v2); v3 = clamp448(v3);
    int h = __builtin_amdgcn_cvt_pk_fp8_f32(v0, v1, 0, false); h = __builtin_amdgcn_cvt_pk_fp8_f32(v2, v3, h, true);
    const auto d0 = __builtin_amdgcn_cvt_pk_f32_fp8(h, false), d1 = __builtin_amdgcn_cvt_pk_f32_fp8(h, true);
    int l = __builtin_amdgcn_cvt_pk_fp8_f32((v0 - d0[0]) * 16.f, (v1 - d0[1]) * 16.f, 0, false); l = __builtin_amdgcn_cvt_pk_fp8_f32((v2 - d1[0]) * 16.f, (v3 - d1[1]) * 16.f, l, true);
    hi = (unsigned)h; lo = (unsigned)l;
}

#define PEER_EID(E, j) (((E)[(j) >> 3][((j) >> 1) & 3] >> (16 * ((j) & 1))) & 0xffffu)
__device__ __forceinline__ void peer_udots_loop(Frame& F, const Args& args, int x, int t0, int tstep) {
    int lane_ = F.lane; asm volatile("" : "+v"(lane_)); const int lane = lane_;
    const int n = lane & 15, kb = lane >> 4, g = lane >> 3, cc = lane & 7;
    LAS unsigned char* tile = F.lds + RING_OFF + F.wave * 16384;
    LAS unsigned char* xq = F.lds + SMALL_OFF + F.wave * 512;
    const LAS unsigned char* ab = xq + (n & 1) * 256 + 16 * kb;
    const LAS unsigned char* brow = tile + n * 128;
    const int swz0 = (cc ^ ((g >> 1) & 7)) * 16, swz1 = (cc ^ ((4 + (g >> 1)) & 7)) * 16;
    const GAS unsigned char* ub = (const GAS unsigned char*)(F.ws + WS_UT2) + (size_t)x * (16384 * 128);
    if (t0 >= T) return;
    const int tlast = t0 + ((T - 1 - t0) / tstep) * tstep;
#define UD_CL(tt) ((tt) <= tlast ? (tt) : tlast)
#define UD_LOAD_E(E, tt) { const GAS v4u* ep = (const GAS v4u*)((const GAS unsigned char*)(F.ws + WS_EB16) + (size_t)(tt) * 256 + g * 32); E[0] = ep[0]; E[1] = ep[1]; }
#define UD_LOAD_X(XR, SC, tt) { XR = *(const GAS u64*)(F_WS(bf16, WS_XN) + (size_t)(tt) * D + 256 * x + 4 * lane); SC = F_WS(float, WS_RT)[tt]; }
#define UD_DMA(E) { _Pragma("unroll") for (int i = 0; i < 16; ++i) { const int k = 8 * i + g; \
        R[i] = *(const GAS v4u*)(ub + ((PEER_EID(E, i) << 7) + (unsigned)((i & 1) ? swz1 : swz0))); } }
#define UD_PUT() { _Pragma("unroll") for (int i = 0; i < 16; ++i) *(LAS v4u*)(tile + i * 1024 + lane * 16) = R[i]; }
#define UD_STEP(XR, SC, tt, E1, E3, X2, SC2) { \
      UD_PUT() \
      asm volatile("s_waitcnt lgkmcnt(0)" ::: "memory"); \
      UD_DMA(E1) \
      __builtin_amdgcn_sched_barrier(0); \
      UD_LOAD_E(E3, UD_CL((tt) + 3 * tstep)) UD_LOAD_X(X2, SC2, UD_CL((tt) + 2 * tstep)) \
      __builtin_amdgcn_sched_barrier(0); \
      v4u bu[8][2]; \
      _Pragma("unroll") for (int rg = 0; rg < 8; ++rg) { _Pragma("unroll") for (int ks = 0; ks < 2; ++ks) bu[rg][ks] = *(const LAS v4u*)(brow + rg * 2048 + (((4 * ks + kb) ^ (n >> 1)) * 16)); } \
      { const unsigned w0 = (unsigned)XR, w1 = (unsigned)(XR >> 32); unsigned hi, lo; const float sc_ = SC * PEER_XS; \
        fp8_split4(bflo(w0) * sc_, bfhi(w0) * sc_, bflo(w1) * sc_, bfhi(w1) * sc_, hi, lo); \
        ((LAS unsigned*)xq)[lane] = hi; ((LAS unsigned*)(xq + 256))[lane] = lo; } \
      asm volatile("s_waitcnt lgkmcnt(0)" ::: "memory"); \
      v8i_t ax[2]; \
      _Pragma("unroll") for (int ks = 0; ks < 2; ++ks) { const v4u p = *(const LAS v4u*)(ab + ks * 128), q = *(const LAS v4u*)(ab + ks * 128 + 64); \
          ax[ks] = (v8i_t){(int)p.x, (int)p.y, (int)p.z, (int)p.w, (int)q.x, (int)q.y, (int)q.z, (int)q.w}; } \
      asm volatile("s_waitcnt lgkmcnt(0)" ::: "memory"); \
      float res[8]; \
      _Pragma("unroll") for (int rg = 0; rg < 8; ++rg) { f32x4 c = (f32x4){0.f, 0.f, 0.f, 0.f}; \
          _Pragma("unroll") for (int ks = 0; ks < 2; ++ks) { const v8i_t b = (v8i_t){(int)bu[rg][ks].x, (int)bu[rg][ks].y, (int)bu[rg][ks].z, (int)bu[rg][ks].w, 0, 0, 0, 0}; \
              c = __builtin_amdgcn_mfma_scale_f32_16x16x128_f8f6f4(ax[ks], b, c, 0, 4, 0, PEER_SC1, 0, PEER_SC1); } \
          res[rg] = (c[0] + c[1] * 0.0625f) * (1.f / PEER_XS); } \
      { GAS v4u* pd = (GAS v4u*)(F_WS(bf16, WS_PD) + ((size_t)x * T + (tt)) * 128 + n * 8); \
        if (lane < 16) pd[0] = (v4u){pg8::cvt_pk_bf16(res[0], res[1]), pg8::cvt_pk_bf16(res[2], res[3]), pg8::cvt_pk_bf16(res[4], res[5]), pg8::cvt_pk_bf16(res[6], res[7])}; } }
    v4u eA[2], eB[2], eC[2]; u64 xrA, xrB, xrC; float scA, scB, scC; v4u R[16];
    UD_LOAD_E(eA, t0) UD_LOAD_E(eB, UD_CL(t0 + tstep)) UD_LOAD_E(eC, UD_CL(t0 + 2 * tstep))
    UD_LOAD_X(xrA, scA, t0) UD_LOAD_X(xrB, scB, UD_CL(t0 + tstep))
    xrC = xrA; scC = scA;
    UD_DMA(eA)
    __builtin_amdgcn_sched_barrier(0);
#pragma unroll 1
    for (int t = t0; t <= tlast; t += 3 * tstep) {
        UD_STEP(xrA, scA, t, eB, eA, xrC, scC)
        if (t + tstep > tlast) break;
        UD_STEP(xrB, scB, t + tstep, eC, eB, xrA, scA)
        if (t + 2 * tstep > tlast) break;
        UD_STEP(xrC, scC, t + 2 * tstep, eA, eC, xrB, scB)
    }
    asm volatile("" :: "v"(R[0]), "v"(R[15]));
#undef UD_LOAD_E
#undef UD_LOAD_X
#undef UD_DMA
#undef UD_PUT
#undef UD_STEP
}

__device__ __forceinline__ void peer_weights4(Frame& F, const Args& args, int t0, int ts) {
    int lane_ = F.lane; asm volatile("" : "+v"(lane_)); const int lane = lane_;
    float s[4][2]; int ex[4][2]; float gt[4][2];
    const int q0 = ((2 * lane) & 7) * 16 + (lane >> 2), q1 = q0 + 16;
#pragma unroll
    for (int k = 0; k < 4; ++k) { const int t = t0 + k * ts;
        float pv[2][8];
#pragma unroll
        for (int x = 0; x < 8; ++x) { const unsigned pw = ((const GAS unsigned*)(F_WS(bf16, WS_PD) + ((size_t)x * T + t) * 128))[lane]; pv[0][x] = bflo(pw); pv[1][x] = bfhi(pw); }
        ex[k][0] = F_WS(int, WS_IDX)[(size_t)t * 128 + q0]; ex[k][1] = F_WS(int, WS_IDX)[(size_t)t * 128 + q1];
        gt[k][0] = F_WS(float, WS_GATE)[(size_t)t * 128 + q0]; gt[k][1] = F_WS(float, WS_GATE)[(size_t)t * 128 + q1];
        s[k][0] = ((pv[0][0] + pv[0][1]) + (pv[0][2] + pv[0][3])) + ((pv[0][4] + pv[0][5]) + (pv[0][6] + pv[0][7]));
        s[k][1] = ((pv[1][0] + pv[1][1]) + (pv[1][2] + pv[1][3])) + ((pv[1][4] + pv[1][5]) + (pv[1][6] + pv[1][7])); }
    float usc[4][2], vsc[4][2];
#pragma unroll
    for (int k = 0; k < 4; ++k)
#pragma unroll
        for (int u = 0; u < 2; ++u) { usc[k][u] = F_WS(float, WS_USC)[ex[k][u]]; vsc[k][u] = F_WS(float, WS_VSC)[ex[k][u]]; }
#pragma unroll
    for (int k = 0; k < 4; ++k) { const int t = t0 + k * ts;
        float w[2];
#pragma unroll
        for (int u = 0; u < 2; ++u) w[u] = gt[k][u] * gelu_tanh(s[k][u] * usc[k][u]) * vsc[k][u];
        const float wm = wave_max(fmaxf(fabsf(w[0]), fabsf(w[1])));
        int sb = 260 - (int)((__builtin_bit_cast(unsigned, wm) >> 23) & 0xffu);
        sb = wm > 0.f ? (sb < 1 ? 1 : (sb > 253 ? 253 : sb)) : 127;
        const float S = __builtin_bit_cast(float, (unsigned)sb << 23), Sinv = __builtin_bit_cast(float, (unsigned)(254 - sb) << 23);
#pragma unroll
        for (int u = 0; u < 2; ++u) { const float ws_ = clamp448(w[u] * S);
            const int h = __builtin_amdgcn_cvt_pk_fp8_f32(ws_, 0.f, 0, false); const float dec = __builtin_amdgcn_cvt_pk_f32_fp8(h, false)[0];
            const int l = __builtin_amdgcn_cvt_pk_fp8_f32((ws_ - dec) * 16.f, 0.f, 0, false);
            GAS unsigned char* wq = (GAS unsigned char*)(F.ws + WS_WQ) + (size_t)t * 256 + (u ? q1 : q0);
            wq[0] = (unsigned char)(h & 0xff); wq[128] = (unsigned char)(l & 0xff); }
        if (lane == 0) F_WS(float, WS_WSCL)[t] = Sinv; }
}

__device__ __forceinline__ void peer_vsum_loop(Frame& F, const Args& args, int x, int t0, int tstep) {
    int lane_ = F.lane; asm volatile("" : "+v"(lane_)); const int lane = lane_;
    const int n = lane & 15, kb = lane >> 4, g = lane >> 3, cc = lane & 7;
    LAS unsigned char* tile = F.lds + RING_OFF + F.wave * 16384;
    const LAS unsigned char* r1 = tile + (32 * kb + n) * 128;
    const int swz0 = (cc ^ ((g >> 1) & 7)) * 16, swz1 = (cc ^ ((4 + (g >> 1)) & 7)) * 16;
    const GAS unsigned char* vb = (const GAS unsigned char*)(F.ws + WS_VT2) + (size_t)x * (16384 * 128);
    if (t0 >= T) return;
    const int tlast = t0 + ((T - 1 - t0) / tstep) * tstep;
#define VS_LOAD_E(E, tt) { const GAS v4u* ep = (const GAS v4u*)((const GAS unsigned char*)(F.ws + WS_EB16) + (size_t)(tt) * 256 + g * 32); E[0] = ep[0]; E[1] = ep[1]; }
#define VS_DMA(E) { _Pragma("unroll") for (int i = 0; i < 16; ++i) { const int k = 8 * i + g; \
        R[i] = *(const GAS v4u*)(vb + ((PEER_EID(E, i) << 7) + (unsigned)((i & 1) ? swz1 : swz0))); } }
#define VS_PUT() { _Pragma("unroll") for (int i = 0; i < 16; ++i) *(LAS v4u*)(tile + i * 1024 + lane * 16) = R[i]; }
#define VS_LOAD_M(A0, A1, SI, X0, X1, tt) { const GAS unsigned char* wq = (const GAS unsigned char*)(F.ws + WS_WQ) + (size_t)(tt) * 256 + (n & 1) * 128 + 16 * kb; \
        A0 = *(const GAS v4u*)wq; A1 = *(const GAS v4u*)(wq + 64); SI = F_WS(float, WS_WSCL)[tt]; \
        const GAS v4u* xp = (const GAS v4u*)(F_WS(bf16, WS_XN) + (size_t)(tt) * D + 256 * x + 16 * n); X0 = xp[0]; X1 = xp[1]; }
#define X2PAIR(dst, src, d0) { const float a_ = bflo(src) + y[d0], b_ = bfhi(src) + y[(d0) + 1]; ss += a_ * a_ + b_ * b_; dst = pg8::cvt_pk_bf16(a_, b_); }
#define VS_STEP(A0, A1, SI, X0, X1, tt, E1, E3, NA0, NA1, NSI, NX0, NX1) { \
      VS_PUT() \
      asm volatile("s_waitcnt lgkmcnt(0)" ::: "memory"); \
      VS_DMA(E1) \
      __builtin_amdgcn_sched_barrier(0); \
      VS_LOAD_E(E3, UD_CL((tt) + 3 * tstep)) VS_LOAD_M(NA0, NA1, NSI, NX0, NX1, UD_CL((tt) + 2 * tstep)) \
      __builtin_amdgcn_sched_barrier(0); \
      v2i_t tr[16][2]; \
      _Pragma("unroll") for (int dg = 0; dg < 16; ++dg) { const int off = (((dg >> 1) ^ (n >> 1)) * 16) + (dg & 1) * 8; \
          tr[dg][0] = __builtin_amdgcn_ds_read_tr4_b64_v2i32((LAS v2i_t*)(r1 + off)); tr[dg][1] = __builtin_amdgcn_ds_read_tr4_b64_v2i32((LAS v2i_t*)(r1 + 2048 + off)); } \
      asm volatile("s_waitcnt lgkmcnt(0)" ::: "memory"); \
      const v8i_t aw = (v8i_t){(int)A0.x, (int)A0.y, (int)A0.z, (int)A0.w, (int)A1.x, (int)A1.y, (int)A1.z, (int)A1.w}; \
      float y[16]; \
      _Pragma("unroll") for (int dg = 0; dg < 16; ++dg) { const v8i_t b = (v8i_t){tr[dg][0].x, tr[dg][0].y, tr[dg][1].x, tr[dg][1].y, 0, 0, 0, 0}; \
          f32x4 c = (f32x4){0.f, 0.f, 0.f, 0.f}; \
          c = __builtin_amdgcn_mfma_scale_f32_16x16x128_f8f6f4(aw, b, c, 0, 4, 0, PEER_SC1, 0, PEER_SC1); \
          y[dg] = (c[0] + c[1] * 0.0625f) * SI; } \
      float ss = 0.f; v4u o0, o1; \
      X2PAIR(o0.x, X0.x, 0) X2PAIR(o0.y, X0.y, 2) X2PAIR(o0.z, X0.z, 4) X2PAIR(o0.w, X0.w, 6) \
      X2PAIR(o1.x, X1.x, 8) X2PAIR(o1.y, X1.y, 10) X2PAIR(o1.z, X1.z, 12) X2PAIR(o1.w, X1.w, 14) \
      ss += __shfl_xor(ss, 1); ss += __shfl_xor(ss, 2); ss += __shfl_xor(ss, 4); ss += __shfl_xor(ss, 8); \
      if (lane < 16) { GAS v4u* xo = (GAS v4u*)(F_WS(bf16, WS_XN) + (size_t)(tt) * D + 256 * x + 16 * n); xo[0] = o0; xo[1] = o1; F_WS(float, WS_SSQ2)[(size_t)x * T + (tt)] = ss; } }
    v4u R[16]; v4u eA[2], eB[2], eC[2]; v4u a0A, a1A, x0A, x1A, a0B, a1B, x0B, x1B, a0C, a1C, x0C, x1C; float siA, siB, siC;
    VS_LOAD_E(eA, t0) VS_LOAD_E(eB, UD_CL(t0 + tstep)) VS_LOAD_E(eC, UD_CL(t0 + 2 * tstep))
    VS_LOAD_M(a0A, a1A, siA, x0A, x1A, t0) VS_LOAD_M(a0B, a1B, siB, x0B, x1B, UD_CL(t0 + tstep))
    a0C = a0A; a1C = a1A; x0C = x0A; x1C = x1A; siC = siA;
    VS_DMA(eA)
    __builtin_amdgcn_sched_barrier(0);
#pragma unroll 1
    for (int t = t0; t <= tlast; t += 3 * tstep) {
        VS_STEP(a0A, a1A, siA, x0A, x1A, t, eB, eA, a0C, a1C, siC, x0C, x1C)
        if (t + tstep > tlast) break;
        VS_STEP(a0B, a1B, siB, x0B, x1B, t + tstep, eC, eB, a0A, a1A, siA, x0A, x1A)
        if (t + 2 * tstep > tlast) break;
        VS_STEP(a0C, a1C, siC, x0C, x1C, t + 2 * tstep, eA, eC, a0B, a1B, siB, x0B, x1B)
    }
    asm volatile("" :: "v"(R[0]), "v"(R[15]));
#undef VS_LOAD_E
#undef VS_DMA
#undef VS_PUT
#undef VS_LOAD_M
#undef X2PAIR
#undef VS_STEP
#undef UD_CL
}

__device__ __forceinline__ void peer_final4(Frame& F, const Args& args, int t0, int ts, float* dst) {
    int lane_ = F.lane; asm volatile("" : "+v"(lane_)); const int lane = lane_;
    v4u xr[4][4]; float ssq[4];
#pragma unroll
    for (int k = 0; k < 4; ++k) { const int t = t0 + k * ts; const GAS v4u* xp = (const GAS v4u*)(F_WS(bf16, WS_XN) + (size_t)t * D) + lane;
#pragma unroll
        for (int j = 0; j < 4; ++j) xr[k][j] = xp[64 * j];
        float sv[8];
#pragma unroll
        for (int x = 0; x < 8; ++x) sv[x] = F_WS(float, WS_SSQ2)[(size_t)x * T + t];
        ssq[k] = ((sv[0] + sv[1]) + (sv[2] + sv[3])) + ((sv[4] + sv[5]) + (sv[6] + sv[7])); }
    f32x4 ga[4], gb[4];
#pragma unroll
    for (int j = 0; j < 4; ++j) { ga[j] = *(const GAS f32x4*)(F_IN(18) + 8 * lane + 512 * j); gb[j] = *(const GAS f32x4*)(F_IN(18) + 8 * lane + 512 * j + 4); }
#pragma unroll
    for (int k = 0; k < 4; ++k) { const int t = t0 + k * ts; const float r = 1.f / sqrtf(ssq[k] * (1.f / D) + EPS); float* drow = dst + (size_t)t * D;
#pragma unroll
        for (int j = 0; j < 4; ++j) { const v4u v = xr[k][j];
            *(GAS f32x4*)(drow + 8 * lane + 512 * j) = (f32x4){bflo(v.x) * r * ga[j].x, bfhi(v.x) * r * ga[j].y, bflo(v.y) * r * ga[j].z, bfhi(v.y) * r * ga[j].w};
            *(GAS f32x4*)(drow + 8 * lane + 512 * j + 4) = (f32x4){bflo(v.z) * r * gb[j].x, bfhi(v.z) * r * gb[j].y, bflo(v.w) * r * gb[j].z, bfhi(v.w) * r * gb[j].w}; } }
}

__global__ void __launch_bounds__(NWAVES * 64, 2) mk_fwd(Args args) {
    extern __shared__ __attribute__((aligned(16))) unsigned char lds[];
    Frame F;
    F.lds = (LAS unsigned char*)lds;
    F.MISC = (volatile LAS unsigned*)(F.lds + MISC_OFF);
    F.tid = threadIdx.x; F.lane = F.tid & 63; F.wave = __builtin_amdgcn_readfirstlane(F.tid >> 6);
    F.G = gridDim.x; { const int bx = blockIdx.x; F.vcu = (F.G % 8 == 0) ? (bx % 8) * (F.G / 8) + bx / 8 : bx; }
    unsigned char* ws = args.ws;
    F.ctl = (gu32*)(ws + WS_CTL);
    F.out = args.out; F.ws = ws;
    for (int u = F.tid; u < (LDS_BYTES - LDSCTL_OFF) / 4; u += NWAVES * 64) ((LAS unsigned*)(F.lds + LDSCTL_OFF))[u] = 0u;
    __syncthreads();
    XcdBarrier bar; bar.bar = (unsigned*)(F.ctl + CW_BAR); bar.x = 0; bar.st = nullptr;
    if (N_LAUNCHES == 1) bar = xcd_barrier_post((unsigned*)(F.ctl + CW_BAR), F.MISC + 8);
#define GRID_BAR() do { if (N_LAUNCHES == 1) xcd_barrier(bar); } while (0)
    const int lo = args.ph_lo, hi = args.ph_hi;
#define IN(k) (lo <= (k) && (k) < hi)
#define BOTH(k) (IN(k) && IN((k) + 1))
    const int gw = F.vcu * NWAVES + F.wave, NGW = F.G * NWAVES;

    if (IN(0)) { REPS(0) p0_prologue(F, args); if (BOTH(0)) GRID_BAR(); }

    if (IN(1)) {
        pg8::Gemm g{F_WS(bf16, WS_XN), F_WS(bf16, WS_WIN), T, NIN, D}; pg8::TokenOrder S; S.init(T, NIN, F.G, (int)blockIdx.x, F.vcu, true);
        static_assert(WS_K - WS_Q == 64 * MiB && WS_V - WS_K == 64 * MiB && WS_U - WS_V == 64 * MiB && WS_Z - WS_U == 64 * MiB, "q|k|v|u|z regions equally spaced");
        pg8::EpiInProj E{F_WS(bf16, WS_Q), (size_t)(32 * MiB), F_WS(float, WS_ROPE), attn_body::C2};
        const bool stag = ((F.vcu >> 1) & 1) != 0;
        if (stag) { peer_tables_rows(F, args); __syncthreads(); }
        REPS(1) pg8::gemm_phase<pg8::EpiInProj, pg8::TokenOrder, true, true>(F.lds + RING_OFF, g, S, E);
        if (!stag) { __syncthreads(); peer_tables_rows(F, args); }
        if (BOTH(1)) GRID_BAR();
    }

    if (IN(2)) {
        static_assert(attn_body::ATTN_LDS_BYTES <= RING_BYTES, "attention scratch fits the ring region");
        const attn_body::AttnTensors AT{(const attn_body::bf16*)F_WS(bf16, WS_Q), (const attn_body::bf16*)F_WS(bf16, WS_K), (const attn_body::bf16*)F_WS(bf16, WS_V), (attn_body::bf16*)F_WS(bf16, WS_O0), (attn_body::bf16*)F_WS(bf16, WS_O1)};
        REPS(2) for (int v = F.vcu; v < 256; v += F.G) attn_body::attn_phase<8>((char*)lds + RING_OFF, AT, v);
        if (BOTH(2)) GRID_BAR();
    }

    if (IN(3)) {
        REPS(3) for (int unit = F.vcu; unit < 256; unit += F.G) gmlp_unit(F, args, unit);
        float d1 = F_IN(3)[F.lane] * F_IN(4)[F.lane], d2 = F_IN(5)[F.lane] * F_IN(6)[F.lane];
        d1 = wave_sum(d1); d2 = wave_sum(d2);
        const float lam = __expf(d1) - __expf(d2) + LAMBDA_INIT;
        for (int t = gw; t < T; t += 2 * NGW) combine_row(F, args, t, t + NGW, lam);
        if (BOTH(3)) GRID_BAR();
    }

    if (IN(4)) {
        pg8::Gemm g{F_WS(bf16, WS_MIX), F_WS(bf16, WS_WOUT), T, D, D}; pg8::TokenOrder S; S.init(T, D, F.G, (int)blockIdx.x, F.vcu, true);
        pg8::EpiResX1 E{F_WS(float, WS_RINV), F_IN(1), F_WS(bf16, WS_XN), F_WS(float, WS_SSQ), T, D};
        REPS(4) pg8::gemm_phase<pg8::EpiResX1, pg8::TokenOrder, true, true>(F.lds + RING_OFF, g, S, E);
        if (BOTH(4)) GRID_BAR();
    }


    if (IN(6)) {
        pg8::Gemm g{F_WS(bf16, WS_WSC), F_WS(bf16, WS_XN), 2048, T, D}; pg8::TokenOrder S; S.init(2048, T, F.G, (int)blockIdx.x, F.vcu, false);
        pg8::EpiF32Res E{F_WS(float, WS_SC), T, nullptr};
        REPS(6) pg8::gemm_phase<pg8::EpiF32Res, pg8::TokenOrder, true, true>(F.lds + RING_OFF, g, S, E);
        if (BOTH(6)) GRID_BAR();
    }

    if (IN(7)) {
        REPS(7) for (int wu = gw; wu < (T / 64) * 8; wu += NGW) topk_unit(F, args, wu);
        if (BOTH(7)) GRID_BAR();
    }

    if (IN(8)) {
        { const int bx = (int)blockIdx.x, nsl = (F.G % 8 == 0) ? 8 : 1, jg = bx / nsl, WPG = (F.G / nsl) * NWAVES;
          for (int x = bx % nsl; x < 8; x += nsl) peer_udots_loop(F, args, x, jg * NWAVES + F.wave, WPG);
          GRID_BAR();
          for (int t = gw; t < T; t += 4 * NGW) peer_weights4(F, args, t, NGW);
          GRID_BAR();
          for (int x = bx % nsl; x < 8; x += nsl) peer_vsum_loop(F, args, x, jg * NWAVES + F.wave, WPG);
          GRID_BAR();
          for (int t = gw; t < T; t += 4 * NGW) peer_final4(F, args, t, NGW, F.out);
        }
    }
#undef IN
#undef BOTH
}

extern "C" void kernel_launch(void* const* d_in, const int* in_sizes, int n_in, void* d_out, int out_size, void* d_ws, size_t ws_size, hipStream_t stream) {
    static int grid = 0;
    if (grid == 0) {
        if (n_in != 19 || in_sizes[0] != T * D || out_size != T * D || ws_size < WS_END) { fprintf(stderr, "kernel_launch: unexpected shapes (n_in %d, in0 %d, out %d, ws %zu); nothing launched\n", n_in, n_in > 0 ? in_sizes[0] : -1, out_size, ws_size); grid = -1; return; }
        int dev = 0, cus = 0, per_cu = 0;
        if (hipGetDevice(&dev) != hipSuccess || hipDeviceGetAttribute(&cus, hipDeviceAttributeMultiprocessorCount, dev) != hipSuccess) { fprintf(stderr, "kernel_launch: device query failed\n"); grid = -1; return; }
        if (hipFuncSetAttribute((const void*)mk_fwd, hipFuncAttributeMaxDynamicSharedMemorySize, LDS_BYTES) != hipSuccess) { fprintf(stderr, "kernel_launch: hipFuncSetAttribute failed\n"); grid = -1; return; }
        if (hipOccupancyMaxActiveBlocksPerMultiprocessor(&per_cu, (const void*)mk_fwd, NWAVES * 64, LDS_BYTES) != hipSuccess || per_cu < 1)
            fprintf(stderr, "kernel_launch: note: occupancy query reports %d workgroups per CU\n", per_cu);
        (void)hipGetLastError();
        grid = 1; while (grid * 2 <= cus && grid * 2 <= 256) grid *= 2;
    }
    if (grid < 0) return;
    if (hipMemsetAsync((char*)d_ws + WS_CTL, 0, CTL_ZERO_BYTES, stream) != hipSuccess) { fprintf(stderr, "kernel_launch: memset failed\n"); return; }
    Args a{};
    for (int i = 0; i < 19; ++i) a.in[i] = (const float*)d_in[i];
    a.out = (float*)d_out; a.ws = (unsigned char*)d_ws;
    for (int li = 0; li < N_LAUNCHES; ++li) {
        a.ph_lo = (N_LAUNCHES == 1) ? 0 : li; a.ph_hi = (N_LAUNCHES == 1) ? N_PHASES : li + 1; a.li = li; a.pad = 0;
        hipLaunchKernelGGL(mk_fwd, dim3(grid), dim3(NWAVES * 64), LDS_BYTES, stream, a);
        const hipError_t le = hipPeekAtLastError();
        if (le != hipSuccess) { fprintf(stderr, "kernel_launch: launch %d failed: %s\n", li, hipGetErrorName(le)); break; }
    }
}
```

```cpp
#include <hip/hip_runtime.h>
#include <cstdio>
#include <cstdint>
namespace pg8 {
#define PG8_LAS __attribute__((address_space(3)))
typedef unsigned short bf16_t;
typedef short bf16x8 __attribute__((ext_vector_type(8)));
typedef float f32x4 __attribute__((ext_vector_type(4)));
typedef unsigned u32x4 __attribute__((ext_vector_type(4)));
constexpr int BM = 256, BK = 64, HALF = 128, HTB = HALF * BK * 2  , STAGE_BYTES = 8 * HTB, NXCD = 8, WGM = 8;

__host__ __device__ __forceinline__ int lds_byte(int r, int c) { const int st = (r >> 4) * 2 + (c >> 5), rr = r & 15, cc = c & 31, ob = rr * 64 + cc * 2; return st * 1024 + (ob ^ (((ob >> 9) & 1) << 5)); }
__host__ __device__ __forceinline__ void stage_rc(int b, int& R, int& C) { const int st = b / 1024, sb = b % 1024, swz = sb ^ (((sb >> 9) & 1) << 5); R = (st >> 1) * 16 + swz / 64; C = (st & 1) * 32 + (swz % 64) / 2; }
__host__ __device__ __forceinline__ int perm32(int rho) { const int n = rho >> 4, i = rho & 15; return 8 * (i >> 2) + 4 * n + (i & 3); }

struct Unit { int pm, pn; };
struct Gemm { const bf16_t* A; const bf16_t* Bt; int M, N, K; };

struct StaticOrder {
    int nM, nN, nwg, G, c;
    __host__ __device__ void init(int M, int N, int G_, int c_) { nM = M / BM; nN = N / BM; nwg = nM * nN; G = G_; c = c_; }
    __host__ __device__ bool next(int i, Unit& u) const {
        const long L = (long)i * G + c; if (L >= nwg) return false;
        int wgid = (int)L; { const int q = nwg / NXCD, r = nwg % NXCD, xcd = wgid % NXCD, off = wgid / NXCD; wgid = (xcd < r ? xcd * (q + 1) : r * (q + 1) + (xcd - r) * q) + off; }
        const int nig = WGM * nN, gid = wgid / nig, fm = gid * WGM, gsz = (nM - fm) < WGM ? (nM - fm) : WGM;
        u.pm = fm + ((wgid % nig) % gsz); u.pn = (wgid % nig) / gsz; return true;
    }
    __device__ __forceinline__ void a_ready(const Unit&) const {}
    __device__ __forceinline__ void done(const Unit&) const {}
};

__device__ __forceinline__ unsigned cvt_pk_bf16(float lo, float hi) { unsigned r; asm volatile("v_cvt_pk_bf16_f32 %0, %1, %2" : "=v"(r) : "v"(lo), "v"(hi)); return r; }
typedef float f32x2 __attribute__((ext_vector_type(2)));
__device__ __forceinline__ f32x2 gelu_pk(f32x2 v) {
    const f32x2 av = __builtin_elementwise_abs(v), d = av * 0.2316418882f + 1.0f;
    f32x2 t; t.x = __builtin_amdgcn_rcpf(d.x); t.y = __builtin_amdgcn_rcpf(d.y);
    f32x2 q = t * 0.5307027145f + (-0.7265760135f); q = q * t + 0.7107068705f; q = q * t + (-0.142248368f); q = q * t + 0.127414796f; q = q * t;
    const f32x2 s = (v * v) * (-0.72134752044f);
    f32x2 e; e.x = __builtin_amdgcn_exp2f(s.x); e.y = __builtin_amdgcn_exp2f(s.y);
    const f32x2 m = v * (q * e), r = v - m;
    f32x2 o; o.x = v.x < 0.f ? m.x : r.x; o.y = v.y < 0.f ? m.y : r.y; return o;
}

template <class Epi, class Sched, bool ALIGN_EPI = false, bool SP2 = false>
__device__ __forceinline__ void gemm_phase(PG8_LAS unsigned char* lds, const Gemm g, const Sched& S, const Epi& E) {
    const int tid = threadIdx.x, wid = __builtin_amdgcn_readfirstlane(tid >> 6), lane = tid & 63, wr = wid >> 2, wc = wid & 3, fr = lane & 15, fq = lane >> 4;
    const int K = g.K, nt = K / BK;
    unsigned voffA[2], voffB[2];
#pragma unroll
    for (int i = 0; i < 2; ++i) { int R, C; stage_rc(tid * 16 + i * 8192, R, C); const int Rb = Epi::PERM ? ((R & ~31) + perm32(R & 31)) : R;
        voffA[i] = (unsigned)(R * K + C) * 2u; voffB[i] = (unsigned)(Rb * K + C) * 2u; }
    const size_t kstep = (size_t)(BK * 2);
    const size_t hstep = (size_t)HALF * K * 2;
    const size_t tstep = 2 * hstep;
    const unsigned ldsw = (unsigned)wid * 1024u;
    const int aoff = lds_byte(wr * 64 + fr, fq * 8), boff = lds_byte(wc * 32 + fr, fq * 8);
#define PG8_SA(b, h) (((b) * 2 + (h)) * HTB)
#define PG8_SB(b, h) ((4 + (b) * 2 + (h)) * HTB)
#define PG8_STAGE(bufoff, gbase, voff) do { _Pragma("unroll") for (int _i = 0; _i < 2; ++_i) \
        __builtin_amdgcn_global_load_lds((const unsigned*)((const char*)(gbase) + (voff)[_i]), (PG8_LAS unsigned*)(lds + (bufoff) + ldsw + _i * 8192), 16, 0, 0); } while (0)
#define PG8_LDA(dst, b, h) do { _Pragma("unroll") for (int m = 0; m < 4; ++m) _Pragma("unroll") for (int k = 0; k < 2; ++k) dst[m][k] = *(const PG8_LAS bf16x8*)(lds + PG8_SA(b, h) + aoff + m * 2048 + k * 1024); } while (0)
#define PG8_LDB(dst, b, h) do { _Pragma("unroll") for (int n = 0; n < 2; ++n) _Pragma("unroll") for (int k = 0; k < 2; ++k) dst[n][k] = *(const PG8_LAS bf16x8*)(lds + PG8_SB(b, h) + boff + n * 2048 + k * 1024); } while (0)
#define PG8_MMA(ai, bj, At, Bt) do { __builtin_amdgcn_s_setprio(1); _Pragma("unroll") for (int m = 0; m < 4; ++m) _Pragma("unroll") for (int n = 0; n < 2; ++n) _Pragma("unroll") for (int k = 0; k < 2; ++k) \
        acc[ai][bj][m][n] = __builtin_amdgcn_mfma_f32_16x16x32_bf16(Bt[n][k], At[m][k], acc[ai][bj][m][n], 0, 0, 0); __builtin_amdgcn_s_setprio(0); } while (0)
#define PG8_WAIT_V(n) asm volatile("s_waitcnt vmcnt(" #n ")" ::: "memory")
#define PG8_WAIT_L(n) asm volatile("s_waitcnt lgkmcnt(" #n ")" ::: "memory")
#define PG8_BAR __builtin_amdgcn_s_barrier()
#define PG8_SCHED __builtin_amdgcn_sched_barrier(0)
    Unit cur, nxt; int ui = 0;
    if (!S.next(0, cur)) return;
    f32x4 acc[2][2][4][2];
#pragma unroll
    for (int a = 0; a < 2; ++a)
#pragma unroll
        for (int b = 0; b < 2; ++b)
#pragma unroll
            for (int m = 0; m < 4; ++m)
#pragma unroll
                for (int n = 0; n < 2; ++n) acc[a][b][m][n] = (f32x4){0.f, 0.f, 0.f, 0.f};
    bf16x8 At[4][2], B0[2][2], B1[2][2];
    const char* cA = (const char*)g.A + (size_t)cur.pm * tstep; const char* cB = (const char*)g.Bt + (size_t)cur.pn * tstep;
    S.a_ready(cur);
    if constexpr (SP2) {
        PG8_STAGE(PG8_SB(0, 0), cB, voffB); PG8_STAGE(PG8_SB(0, 1), cB + hstep, voffB); PG8_STAGE(PG8_SA(0, 0), cA, voffA); PG8_STAGE(PG8_SA(0, 1), cA + hstep, voffA);
        if (wr == 1) PG8_BAR;
        PG8_WAIT_V(2); PG8_BAR;
        PG8_STAGE(PG8_SB(1, 0), cB + kstep, voffB); PG8_STAGE(PG8_SA(1, 0), cA + kstep, voffA); PG8_STAGE(PG8_SB(1, 1), cB + hstep + kstep, voffB);
        PG8_WAIT_V(6); PG8_BAR;
    } else {
        PG8_STAGE(PG8_SB(0, 0), cB, voffB); PG8_STAGE(PG8_SA(0, 0), cA, voffA); PG8_STAGE(PG8_SB(0, 1), cB + hstep, voffB); PG8_STAGE(PG8_SA(0, 1), cA + hstep, voffA);
        if (wr == 1) PG8_BAR;
        PG8_WAIT_V(4); PG8_BAR;
        PG8_STAGE(PG8_SB(1, 0), cB + kstep, voffB); PG8_STAGE(PG8_SA(1, 0), cA + kstep, voffA); PG8_STAGE(PG8_SB(1, 1), cB + hstep + kstep, voffB);
        PG8_WAIT_V(6); PG8_BAR;
    }
    for (;;) {
        const bool has_next = S.next(ui + 1, nxt);
        const char* nA = has_next ? (const char*)g.A + (size_t)nxt.pm * tstep : cA; const char* nB = has_next ? (const char*)g.Bt + (size_t)nxt.pn * tstep : cB;
        for (int t = 0; t < nt; t += 2) {
            const bool last = (t == nt - 2);
            const char* a1 = cA + (size_t)(t + 1) * kstep;
            const char* a2 = last ? nA : cA + (size_t)(t + 2) * kstep; const char* b2 = last ? nB : cB + (size_t)(t + 2) * kstep;
            const char* a3 = a2 + kstep; const char* b3 = b2 + kstep;
            if (last && has_next) S.a_ready(nxt);
            if constexpr (SP2) {
            PG8_LDB(B0, 0, 0); PG8_LDB(B1, 0, 1); PG8_SCHED; PG8_LDA(At, 0, 0); PG8_STAGE(PG8_SA(1, 1), a1 + hstep, voffA);
            PG8_WAIT_V(8); PG8_WAIT_L(0); PG8_BAR; PG8_MMA(0, 0, At, B0); PG8_MMA(0, 1, At, B1); PG8_BAR; PG8_SCHED;
            PG8_LDA(At, 0, 1); PG8_STAGE(PG8_SB(0, 0), b2, voffB); PG8_STAGE(PG8_SB(0, 1), b2 + hstep, voffB); PG8_STAGE(PG8_SA(0, 0), a2, voffA);
            PG8_WAIT_V(8); PG8_WAIT_L(0); PG8_BAR; PG8_MMA(1, 0, At, B0); PG8_MMA(1, 1, At, B1); PG8_BAR; PG8_SCHED;
            PG8_LDB(B0, 1, 0); PG8_LDB(B1, 1, 1); PG8_SCHED; PG8_LDA(At, 1, 0); PG8_STAGE(PG8_SA(0, 1), a2 + hstep, voffA);
            PG8_WAIT_V(8); PG8_WAIT_L(0); PG8_BAR; PG8_MMA(0, 0, At, B0); PG8_MMA(0, 1, At, B1); PG8_BAR; PG8_SCHED;
            PG8_LDA(At, 1, 1); PG8_STAGE(PG8_SB(1, 0), b3, voffB); PG8_STAGE(PG8_SB(1, 1), b3 + hstep, voffB); PG8_STAGE(PG8_SA(1, 0), a3, voffA);
            PG8_WAIT_V(8); PG8_WAIT_L(0); PG8_BAR; PG8_MMA(1, 0, At, B0); PG8_MMA(1, 1, At, B1); PG8_BAR; PG8_SCHED;
            } else {
            PG8_LDB(B0, 0, 0); PG8_SCHED; PG8_LDA(At, 0, 0); PG8_STAGE(PG8_SA(1, 1), a1 + hstep, voffA);
            PG8_WAIT_L(8); PG8_BAR; PG8_WAIT_L(0); PG8_MMA(0, 0, At, B0); PG8_BAR; PG8_SCHED;
            PG8_LDB(B1, 0, 1); PG8_STAGE(PG8_SB(0, 0), b2, voffB);
            PG8_BAR; PG8_WAIT_L(0); PG8_MMA(0, 1, At, B1); PG8_BAR;
            PG8_LDA(At, 0, 1); PG8_STAGE(PG8_SA(0, 0), a2, voffA);
            PG8_BAR; PG8_WAIT_L(0); PG8_MMA(1, 0, At, B0); PG8_BAR; PG8_SCHED;
            PG8_STAGE(PG8_SB(0, 1), b2 + hstep, voffB);
            PG8_WAIT_V(6); PG8_BAR; PG8_MMA(1, 1, At, B1); PG8_BAR;
            PG8_LDB(B0, 1, 0); PG8_SCHED; PG8_LDA(At, 1, 0); PG8_STAGE(PG8_SA(0, 1), a2 + hstep, voffA);
            PG8_WAIT_L(8); PG8_BAR; PG8_WAIT_L(0); PG8_MMA(0, 0, At, B0); PG8_BAR; PG8_SCHED;
            PG8_LDB(B1, 1, 1); PG8_STAGE(PG8_SB(1, 0), b3, voffB);
            PG8_BAR; PG8_WAIT_L(0); PG8_MMA(0, 1, At, B1); PG8_BAR;
            PG8_LDA(At, 1, 1); PG8_STAGE(PG8_SA(1, 0), a3, voffA);
            PG8_BAR; PG8_WAIT_L(0); PG8_MMA(1, 0, At, B0); PG8_BAR; PG8_SCHED;
            PG8_STAGE(PG8_SB(1, 1), b3 + hstep, voffB);
            PG8_WAIT_V(6); PG8_BAR; PG8_MMA(1, 1, At, B1); PG8_BAR;
            }
        }
        if constexpr (ALIGN_EPI) { if (wr == 0) PG8_BAR; }
        if constexpr (!Epi::AFTER_DRAIN) { E(acc, cur, wr, wc, fr, fq); S.done(cur); }
        if (!has_next) break;
#pragma unroll
        for (int a = 0; a < 2; ++a)
#pragma unroll
            for (int b = 0; b < 2; ++b)
#pragma unroll
                for (int m = 0; m < 4; ++m)
#pragma unroll
                    for (int n = 0; n < 2; ++n) acc[a][b][m][n] = (f32x4){0.f, 0.f, 0.f, 0.f};
        cur = nxt; cA = nA; cB = nB; ++ui;
        if constexpr (ALIGN_EPI) { if (wr == 1) PG8_BAR; }
    }
    PG8_WAIT_V(0);
    if constexpr (!ALIGN_EPI) { if (wr == 0) PG8_BAR; }
    PG8_BAR;
    if constexpr (Epi::AFTER_DRAIN) { E.fused(acc, cur, wr, wc, fr, fq, lds, wid, lane); S.done(cur); }
#undef PG8_SA
#undef PG8_SB
#undef PG8_STAGE
#undef PG8_LDA
#undef PG8_LDB
#undef PG8_MMA
#undef PG8_WAIT_V
#undef PG8_WAIT_L
#undef PG8_BAR
#undef PG8_SCHED
}
}
namespace pg8 {
__device__ __forceinline__ float gelu_tanh(float x) {
    const float y2 = x * (1.5957691216057308f + 0.07135481627613502f * x * x);
    const float e = __builtin_amdgcn_exp2f(-1.4426950408889634f * y2);
    return x * __builtin_amdgcn_rcpf(1.0f + e);
}
struct EpiInProj {
    static constexpr bool PERM = true, AFTER_DRAIN = false;
    bf16_t* Oq; size_t region_stride; const float* rope; float qscale;
    __device__ __forceinline__ void operator()(const f32x4 (&acc)[2][2][4][2], const Unit& u, int wr, int wc, int fr, int fq) const {
        const int region = u.pn >> 2;
        bf16_t* base = Oq + (size_t)region * region_stride;
        const int row0 = u.pm * BM + wr * 64 + fr, col0 = (u.pn & 3) * 256 + wc * 32 + 8 * fq;
        const bool do_rope = (region < 2) && ((wc & 1) == 0) && (fq < 2);
        const bool do_gelu = (region >= 3);
        const float sc = (region == 0) ? qscale : 1.f;
#pragma unroll
        for (int ai = 0; ai < 2; ++ai)
#pragma unroll
            for (int m = 0; m < 4; ++m) { const int row = row0 + ai * HALF + m * 16; bf16_t* rowp = base + (size_t)row * 1024 + col0;
                f32x4 cs0 = (f32x4){1.f, 0.f, 1.f, 0.f}, cs1 = (f32x4){1.f, 0.f, 1.f, 0.f};
                if (do_rope) { const float* rp = rope + ((size_t)(row & 16383) * 8 + 4 * fq) * 2; cs0 = *(const f32x4*)rp; cs1 = *(const f32x4*)(rp + 4); }
#pragma unroll
                for (int bj = 0; bj < 2; ++bj) { f32x4 v0 = acc[ai][bj][m][0], v1 = acc[ai][bj][m][1];
                    if (do_rope) {
                        f32x4 r0, r1;
                        r0[0] = v0[0] * cs0[0] - v0[1] * cs0[1]; r0[1] = v0[1] * cs0[0] + v0[0] * cs0[1];
                        r0[2] = v0[2] * cs0[2] - v0[3] * cs0[3]; r0[3] = v0[3] * cs0[2] + v0[2] * cs0[3];
                        r1[0] = v1[0] * cs1[0] - v1[1] * cs1[1]; r1[1] = v1[1] * cs1[0] + v1[0] * cs1[1];
                        r1[2] = v1[2] * cs1[2] - v1[3] * cs1[3]; r1[3] = v1[3] * cs1[2] + v1[2] * cs1[3];
                        v0 = r0; v1 = r1; }
                    if (do_gelu) {
#pragma unroll
                        for (int e = 0; e < 4; ++e) { v0[e] = gelu_tanh(v0[e]); v1[e] = gelu_tanh(v1[e]); } }
                    v0 = v0 * sc; v1 = v1 * sc; u32x4 w; w.x = cvt_pk_bf16(v0[0], v0[1]); w.y = cvt_pk_bf16(v0[2], v0[3]); w.z = cvt_pk_bf16(v1[0], v1[1]); w.w = cvt_pk_bf16(v1[2], v1[3]);
                    *(u32x4*)(rowp + bj * HALF) = w; } }
    }
};
struct EpiF16 {
    static constexpr bool PERM = true, AFTER_DRAIN = false;
    unsigned short* C; int ldc;
    __device__ __forceinline__ void operator()(const f32x4 (&acc)[2][2][4][2], const Unit& u, int wr, int wc, int fr, int fq) const {
        typedef _Float16 h2 __attribute__((ext_vector_type(2)));
        const int row0 = u.pm * BM + wr * 64 + fr, col0 = u.pn * BM + wc * 32 + 8 * fq;
#pragma unroll
        for (int ai = 0; ai < 2; ++ai)
#pragma unroll
            for (int m = 0; m < 4; ++m) { unsigned short* rowp = C + (size_t)(row0 + ai * HALF + m * 16) * ldc + col0;
#pragma unroll
                for (int bj = 0; bj < 2; ++bj) { f32x4 v0 = acc[ai][bj][m][0], v1 = acc[ai][bj][m][1]; u32x4 w;
#pragma unroll
                    for (int e = 0; e < 4; ++e) { v0[e] = fminf(fmaxf(v0[e], -65504.f), 65504.f); v1[e] = fminf(fmaxf(v1[e], -65504.f), 65504.f); }
                    w.x = __builtin_bit_cast(unsigned, (h2){(_Float16)v0[0], (_Float16)v0[1]}); w.y = __builtin_bit_cast(unsigned, (h2){(_Float16)v0[2], (_Float16)v0[3]});
                    w.z = __builtin_bit_cast(unsigned, (h2){(_Float16)v1[0], (_Float16)v1[1]}); w.w = __builtin_bit_cast(unsigned, (h2){(_Float16)v1[2], (_Float16)v1[3]});
                    *(u32x4*)(rowp + bj * HALF) = w; } }
    }
};
struct EpiF32Res {
    static constexpr bool PERM = false, AFTER_DRAIN = false;
    float* C; int ldc; const float* R;
    __device__ __forceinline__ void operator()(const f32x4 (&acc)[2][2][4][2], const Unit& u, int wr, int wc, int fr, int fq) const {
        const int row0 = u.pm * BM + wr * 64 + fr, col0 = u.pn * BM + wc * 32 + 4 * fq;
#pragma unroll
        for (int ai = 0; ai < 2; ++ai)
#pragma unroll
            for (int m = 0; m < 4; ++m) { const size_t off = (size_t)(row0 + ai * HALF + m * 16) * ldc + col0;
#pragma unroll
                for (int bj = 0; bj < 2; ++bj)
#pragma unroll
                    for (int n = 0; n < 2; ++n) { f32x4 v = acc[ai][bj][m][n]; if (R) v = v + *(const f32x4*)(R + off + bj * HALF + n * 16); *(f32x4*)(C + off + bj * HALF + n * 16) = v; } }
    }
};
struct EpiResX1 {
    static constexpr bool PERM = true, AFTER_DRAIN = false;
    const float* rinv; const float* gain; bf16_t* XB; float* SSQ; int nrows; int ldc;
    __device__ __forceinline__ void operator()(const f32x4 (&acc)[2][2][4][2], const Unit& u, int wr, int wc, int fr, int fq) const {
        const int row0 = u.pm * BM + wr * 64 + fr, col0 = u.pn * BM + wc * 32 + 8 * fq;
        f32x4 gi[2][2];
#pragma unroll
        for (int bj = 0; bj < 2; ++bj)
#pragma unroll
            for (int n = 0; n < 2; ++n) { const f32x4 gg = *(const f32x4*)(gain + col0 + bj * HALF + 4 * n);
                gi[bj][n] = (f32x4){__builtin_amdgcn_rcpf(gg[0]), __builtin_amdgcn_rcpf(gg[1]), __builtin_amdgcn_rcpf(gg[2]), __builtin_amdgcn_rcpf(gg[3])}; }
#pragma unroll
        for (int ai = 0; ai < 2; ++ai)
#pragma unroll
            for (int m = 0; m < 4; ++m) { const int row = row0 + ai * HALF + m * 16; const size_t off = (size_t)row * ldc + col0; float ss = 0.f; const float ri = rinv[row];
#pragma unroll
                for (int bj = 0; bj < 2; ++bj) { const u32x4 xb = *(const u32x4*)(XB + off + bj * HALF);
                    const f32x4 x0 = (f32x4){__builtin_bit_cast(float, xb.x << 16), __builtin_bit_cast(float, xb.x & 0xffff0000u), __builtin_bit_cast(float, xb.y << 16), __builtin_bit_cast(float, xb.y & 0xffff0000u)};
                    const f32x4 x1 = (f32x4){__builtin_bit_cast(float, xb.z << 16), __builtin_bit_cast(float, xb.z & 0xffff0000u), __builtin_bit_cast(float, xb.w << 16), __builtin_bit_cast(float, xb.w & 0xffff0000u)};
                    const f32x4 v0 = acc[ai][bj][m][0] + x0 * gi[bj][0] * ri, v1 = acc[ai][bj][m][1] + x1 * gi[bj][1] * ri;
                    ss += ((v0[0] * v0[0] + v0[1] * v0[1]) + (v0[2] * v0[2] + v0[3] * v0[3])) + ((v1[0] * v1[0] + v1[1] * v1[1]) + (v1[2] * v1[2] + v1[3] * v1[3]));
                    u32x4 w; w.x = cvt_pk_bf16(v0[0], v0[1]); w.y = cvt_pk_bf16(v0[2], v0[3]); w.z = cvt_pk_bf16(v1[0], v1[1]); w.w = cvt_pk_bf16(v1[2], v1[3]);
                    *(u32x4*)(XB + off + bj * HALF) = w; }
                ss += __shfl_xor(ss, 16); ss += __shfl_xor(ss, 32);
                if (fq == 0) SSQ[(size_t)(u.pn * 4 + wc) * nrows + row] = ss; }
    }
};
struct TokenOrder {
    StaticOrder so; int vcu, nsteps; bool tokM, fixed;
    __device__ void init(int M, int N, int G_, int c_, int vcu_, bool tokM_) { so.init(M, N, G_, c_); vcu = vcu_; tokM = tokM_; const int ntok = (tokM_ ? M : N) / BM, noth = (tokM_ ? N : M) / BM;
        fixed = (G_ == 256 && ntok == 128 && (noth % 2) == 0); nsteps = noth / 2; }
    __device__ bool next(int i, Unit& u) const {
        if (!fixed) return so.next(i, u);
        if (i >= nsteps) return false;
        const int tok = vcu >> 1, oth = (vcu & 1) * nsteps + i; u.pm = tokM ? tok : oth; u.pn = tokM ? oth : tok; return true; }
    __device__ __forceinline__ void a_ready(const Unit&) const {}
    __device__ __forceinline__ void done(const Unit&) const {}
};
}
#include <hip/hip_bf16.h>
#include <cmath>
namespace attn_body {
using bf16=__hip_bfloat16;
using bf16x8=__attribute__((ext_vector_type(8)))short;
using s16x4=__attribute__((ext_vector_type(4)))short;
using f32x16=__attribute__((ext_vector_type(16)))float;
using u32x4=__attribute__((ext_vector_type(4)))unsigned;
constexpr int BATCH=2,NHEAD=16,SEQ=16384,D=64,DM=NHEAD*D;
constexpr int NW=8,QBLK=32,QB=QBLK*NW,KVBLK=64,NQB=SEQ/QB;
constexpr int ATTN_PITCH=DM, ATTN_UNIT_ROWS=QB;
__device__ __forceinline__ int crow(int r,int hi){return (r&3)+8*(r>>2)+4*hi;}
#define SBAR() __builtin_amdgcn_sched_barrier(0)
__device__ __forceinline__ void cmask(f32x16&p0,f32x16&p1,int jb,int qrel,int hi){
  const float NEG=-INFINITY; (void)hi;
  if(jb>(qrel>>6)){
  #pragma unroll
  for(int r=0;r<16;++r){p0[r]=NEG;p1[r]=NEG;} }
}

constexpr int NSLOT=3, SLOTB=8192;
constexpr int VSLOTB=2*SLOTB;
constexpr int LDS_K=0, LDS_V=NSLOT*SLOTB, LDS_WS=LDS_V+NSLOT*VSLOTB, LDS_OST=LDS_WS+NW*64*4, LDS_BYTES=LDS_OST+NW*4096;
constexpr float C2=0.125f*1.4426950408889634f;
__device__ __forceinline__ void glds16(const void*gsrc,unsigned lds_dst){unsigned keep;
  asm volatile("s_mov_b32 %0, m0\n\ts_mov_b32 m0, %2\n\ts_nop 0\n\tglobal_load_lds_dwordx4 %1, off\n\ts_mov_b32 m0, %0":"=&s"(keep):"v"(gsrc),"s"(lds_dst):"memory");}
__device__ __forceinline__ float max3f(float a,float b,float c){float r;asm("v_max3_f32 %0, %1, %2, %3":"=v"(r):"v"(a),"v"(b),"v"(c));return r;}
__device__ __forceinline__ float max2f(float a,float b){float r;asm("v_max_f32_e32 %0, %1, %2":"=v"(r):"v"(a),"v"(b));return r;}
__device__ __forceinline__ float fadd_s(float a,float b){float r;asm("v_add_f32_e32 %0, %1, %2":"=v"(r):"v"(a),"v"(b));return r;}
__device__ __forceinline__ float fsub_s(float a,float b){float r;asm("v_sub_f32_e32 %0, %1, %2":"=v"(r):"v"(a),"v"(b));return r;}
typedef float f32x2_t __attribute__((ext_vector_type(2))); typedef __bf16 bf16x2_t __attribute__((ext_vector_type(2)));
__device__ __forceinline__ unsigned cvtpk_s(float lo,float hi){f32x2_t v={lo,hi};bf16x2_t b=__builtin_convertvector(v,bf16x2_t);return __builtin_bit_cast(unsigned,b);}
#define WAIT_BAR(N) asm volatile("s_waitcnt vmcnt(" #N ") lgkmcnt(0)\n\ts_barrier":::"memory")

__device__ __forceinline__ void qkt(f32x16&p0,f32x16&p1,const char*Kslot,const bf16x8*qr,int r32,int hi){
  const char*kb=Kslot+hi*1024+r32*16;
  #pragma unroll
  for(int d0=0;d0<4;++d0){
    const bf16x8 b0=*reinterpret_cast<const bf16x8*>(kb+d0*2048);
    const bf16x8 b1=*reinterpret_cast<const bf16x8*>(kb+d0*2048+512);
    if(d0==0){p0=__builtin_amdgcn_mfma_f32_32x32x16_bf16(b0,qr[0],f32x16{},0,0,0);p1=__builtin_amdgcn_mfma_f32_32x32x16_bf16(b1,qr[0],f32x16{},0,0,0);}
    else{p0=__builtin_amdgcn_mfma_f32_32x32x16_bf16(b0,qr[d0],p0,0,0,0);p1=__builtin_amdgcn_mfma_f32_32x32x16_bf16(b1,qr[d0],p1,0,0,0);}}
}
typedef __attribute__((address_space(3))) const char* lds_cptr;
typedef short v4i16_t __attribute__((ext_vector_type(4)));
__device__ __forceinline__ void kload8(bf16x8*kf,lds_cptr kp){
  kf[0]=*(const __attribute__((address_space(3))) bf16x8*)(kp);      kf[1]=*(const __attribute__((address_space(3))) bf16x8*)(kp+512);
  kf[2]=*(const __attribute__((address_space(3))) bf16x8*)(kp+2048); kf[3]=*(const __attribute__((address_space(3))) bf16x8*)(kp+2560);
  kf[4]=*(const __attribute__((address_space(3))) bf16x8*)(kp+4096); kf[5]=*(const __attribute__((address_space(3))) bf16x8*)(kp+4608);
  kf[6]=*(const __attribute__((address_space(3))) bf16x8*)(kp+6144); kf[7]=*(const __attribute__((address_space(3))) bf16x8*)(kp+6656);
}
__device__ __forceinline__ void kload2(bf16x8*kf,lds_cptr kp,int j){ kf[2*j]=*(const __attribute__((address_space(3))) bf16x8*)(kp+j*2048); kf[2*j+1]=*(const __attribute__((address_space(3))) bf16x8*)(kp+j*2048+512); }
__device__ __forceinline__ s16x4 vtr(lds_cptr p){ return __builtin_bit_cast(s16x4,__builtin_amdgcn_ds_read_tr16_b64_v4i16((__attribute__((address_space(3))) v4i16_t*)p)); }
__device__ __forceinline__ float rowmax(const f32x16&p0,const f32x16&p1){
  float a=max3f(p0[0],p0[1],p1[0]),b=max3f(p0[2],p0[3],p1[1]);a=max3f(a,p1[2],p1[3]);
  #pragma unroll
  for(int r=4;r<16;r+=4){a=max3f(a,p0[r],p0[r+1]);b=max3f(b,p0[r+2],p0[r+3]);a=max3f(a,p1[r],p1[r+1]);b=max3f(b,p1[r+2],p1[r+3]);}
  const float m=max2f(a,b);
  auto rr=__builtin_amdgcn_permlane32_swap(__float_as_uint(m),__float_as_uint(m),false,false);
  return max2f(__uint_as_float(rr[0]),__uint_as_float(rr[1]));
}
__device__ __forceinline__ void pv(f32x16*o,int vb,bf16x8 pa0,bf16x8 pa1,bf16x8 pa2,bf16x8 pa3){
  #pragma unroll
  for(int d0=0;d0<4;++d0){s16x4 lo[4],hi[4];
    #pragma unroll
    for(int ks=0;ks<4;++ks){
      asm volatile("ds_read_b64_tr_b16 %0,%1 offset:%c2":"=&v"(lo[ks]):"v"(vb),"i"(d0*4096+ks*1024):"memory");
      asm volatile("ds_read_b64_tr_b16 %0,%1 offset:%c2":"=&v"(hi[ks]):"v"(vb),"i"(d0*4096+ks*1024+512):"memory");}
    asm volatile("s_waitcnt lgkmcnt(0)":::"memory");SBAR();
    #define PK(k) (bf16x8){lo[k][0],lo[k][1],lo[k][2],lo[k][3],hi[k][0],hi[k][1],hi[k][2],hi[k][3]}
    o[d0]=__builtin_amdgcn_mfma_f32_32x32x16_bf16(pa0,PK(0),o[d0],0,0,0);
    o[d0]=__builtin_amdgcn_mfma_f32_32x32x16_bf16(pa1,PK(1),o[d0],0,0,0);
    o[d0]=__builtin_amdgcn_mfma_f32_32x32x16_bf16(pa2,PK(2),o[d0],0,0,0);
    o[d0]=__builtin_amdgcn_mfma_f32_32x32x16_bf16(pa3,PK(3),o[d0],0,0,0);
    #undef PK
  }
}

#ifndef ATTN_STORE16
#define ATTN_STORE16(p,v) (*(u32x4*)(p)=(v))
#endif
template<int THRL> __device__ __forceinline__ void attn_unit(int b,int hq,int hv,int qb,const bf16*Q,const bf16*__restrict__ K,const bf16*__restrict__ V,bf16*O,char*shm){
  int tid_=threadIdx.x; asm volatile("":"+v"(tid_));
  const int tid=tid_,lane=tid&63,r32=lane&31,hi=lane>>5; const int wid=__builtin_amdgcn_readfirstlane(tid>>6);
  const long rowbase=(long)b*SEQ; const int q0=qb*QB;
  const bf16*Qw=Q+(rowbase+q0+wid*QBLK)*DM+hq*D;
  const bf16*Kh=K+rowbase*DM+hq*D,*Vh=V+rowbase*DM+hv*2*D;
  const unsigned lds0=(unsigned)(uintptr_t)shm;
  float*wsf=(float*)(shm+LDS_WS)+wid*64;
  const bf16*ksrc=Kh+(long)lane*DM+wid*8;
  const bf16*vsrc=Vh+(long)(16*(wid&3)+(lane>>2))*DM+(wid>>2)*32+(lane&3)*8;
  const unsigned kdst=lds0+LDS_K+wid*1024, vdst=lds0+LDS_V+wid*1024;
  #define DMA_K(t,slot) glds16(ksrc+(long)(t)*KVBLK*DM,(unsigned)__builtin_amdgcn_readfirstlane(kdst+(slot)))
  #define DMA_V(t,slot) do{ glds16(vsrc+(long)(t)*KVBLK*DM,(unsigned)__builtin_amdgcn_readfirstlane(vdst+2*(slot))); glds16(vsrc+(long)(t)*KVBLK*DM+64,(unsigned)__builtin_amdgcn_readfirstlane(vdst+2*(slot)+8192)); }while(0)
  const int vb0=(int)(lds0+LDS_V)+((lane>>4)&1)*32+(lane&3)*8+(4*hi+((lane&15)>>2))*64;
  const char*Kbase=shm+LDS_K; bf16x8 kf[8];
  const lds_cptr shm3=(lds_cptr)shm; const lds_cptr kp0=shm3+LDS_K+hi*1024+r32*16; const lds_cptr vp0=shm3+LDS_V+((lane>>4)&1)*32+(lane&3)*8+(4*hi+((lane&15)>>2))*64;
  const int NT=(q0+QB)/KVBLK;
  DMA_K(0,0);DMA_V(0,0);DMA_K(1,SLOTB);
  bf16x8 qr[4];
  #pragma unroll
  for(int d0=0;d0<4;++d0)qr[d0]=*reinterpret_cast<const bf16x8*>(&Qw[(long)r32*DM+d0*16+hi*8]);
  float mhat=0.f,l_reg=0.f;f32x16 o[4];o[0]=f32x16{};o[1]=f32x16{};o[2]=f32x16{};o[3]=f32x16{};
  const int qrel=wid*QBLK+r32;
  #define CMASK(P0,P1,t) do{int jb_=(t)-(NT-4); if(jb_>=0)cmask(P0,P1,jb_,qrel,hi);}while(0)
  bool resc=false;
  #define START(P0,P1) do{ const float rm=rowmax(P0,P1); resc=false; \
    { const float dl=rm; mhat=fadd_s(mhat,dl); \
      _Pragma("unroll") for(int r=0;r<16;++r){P0[r]=fsub_s(P0[r],dl);P1[r]=fsub_s(P1[r],dl);} } \
    _Pragma("unroll") for(int r=0;r<16;++r)P0[r]=__builtin_amdgcn_exp2f(P0[r]); }while(0)
  #define RESC() do{ if(resc){ asm volatile("s_waitcnt lgkmcnt(0)":::"memory"); \
      _Pragma("unroll") for(int d_=0;d_<4;++d_) _Pragma("unroll") for(int r=0;r<16;++r)o[d_][r]*=wsf[crow(r,hi)]; } }while(0)
  f32x16 pA0,pA1,pB0,pB1;
  int sl_prev=0,sl_cur=0,sl_next=SLOTB;
  #define ROT() do{sl_prev=sl_cur;sl_cur=sl_next;sl_next=(sl_next==(NSLOT-1)*SLOTB)?0:sl_next+SLOTB;}while(0)
  DMA_K(2,2*SLOTB);
  WAIT_BAR(4);
  qkt(pA0,pA1,Kbase,qr,r32,hi);asm volatile("s_nop 15\n\ts_nop 7":"+v"(pA0),"+v"(pA1));CMASK(pA0,pA1,0);
  START(pA0,pA1);
  _Pragma("unroll") for(int r=0;r<16;++r)pA1[r]=__builtin_amdgcn_exp2f(pA1[r]);
  WAIT_BAR(0);
  DMA_K(3,0);DMA_V(1,SLOTB);
  ROT();
  kload8(kf,kp0+sl_cur);
  WAIT_BAR(3);
  s16x4 vlo[8],vhi[8]; u32x4 pw0,pw1,pw2,pw3;
  #define PKW(P,B) cvtpk_s(P[B],P[B+1])
  #define PAF(k) __builtin_bit_cast(bf16x8,pw##k)
  #define VFR(i) (bf16x8){vlo[i][0],vlo[i][1],vlo[i][2],vlo[i][3],vhi[i][0],vhi[i][1],vhi[i][2],vhi[i][3]}
  #define PIN(x) asm volatile("":"+v"(x))
  #define MX3(a,b,c) __builtin_fmaxf(__builtin_fmaxf((a),(b)),(c))
  #define GAPA(MF,A0,A1,A2,A3,W0,W1,PW) do{ MF; sacc+=A0; sacc+=A1; sacc+=A2; sacc+=A3; PIN(sacc); W0; W1; PIN(PW); SBAR(); }while(0)
  #define EX(v) __builtin_amdgcn_exp2f(v)
  #define GAPB(MF,X,B) do{ MF; X[B]=EX(X[B]); X[B+1]=EX(X[B+1]); X[B+2]=EX(X[B+2]); X[B+3]=EX(X[B+3]); PIN(X); SBAR(); }while(0)
  #define VRD(i) do{ vlo[i]=vtr(vp_+(((i)>>2)*4096+((i)&3)*1024)); vhi[i]=vtr(vp_+(((i)>>2)*4096+((i)&3)*1024+512)); }while(0)
  #define VRD2(i) do{ vlo[i]=vtr(vp_+(8192+((i)>>2)*4096+((i)&3)*1024)); vhi[i]=vtr(vp_+(8192+((i)>>2)*4096+((i)&3)*1024+512)); SBAR(); }while(0)
  #define GAPB2(MF,X,B) do{ MF; X[B]=EX(X[B]-mhat); X[B+1]=EX(X[B+1]-mhat); PIN(X); SBAR(); }while(0)
  #define KRD(G,j) do{ if(G){ kload2(kf,kp0+sl_next,j); SBAR(); } }while(0)
  #define STEP(C0,C1,P0,P1,t,GK,GV,GL) do{ SBAR(); \
    const lds_cptr vp_=vp0+2*sl_prev; \
    VRD(0); SBAR(); float sacc=(P0[0]+P0[1]); \
    GAPA(C0=__builtin_amdgcn_mfma_f32_32x32x16_bf16(kf[0],qr[0],f32x16{},0,0,0), P0[2],P0[3],P0[4],P0[5],     pw0[0]=PKW(P0,0), pw0[1]=PKW(P0,2), pw0); \
    VRD(4); SBAR(); GAPA(C1=__builtin_amdgcn_mfma_f32_32x32x16_bf16(kf[1],qr[0],f32x16{},0,0,0), P0[6],P0[7],P0[8],P0[9],     pw0[2]=PKW(P0,4), pw0[3]=PKW(P0,6), pw0); \
    VRD(1); SBAR(); GAPA(C0=__builtin_amdgcn_mfma_f32_32x32x16_bf16(kf[2],qr[1],C0,0,0,0),   P0[10],P0[11],P0[12],P0[13], pw1[0]=PKW(P0,8), pw1[1]=PKW(P0,10), pw1); \
    VRD(5); SBAR(); GAPA(C1=__builtin_amdgcn_mfma_f32_32x32x16_bf16(kf[3],qr[1],C1,0,0,0),   P0[14],P0[15],P1[0],P1[1],   pw1[2]=PKW(P0,12),pw1[3]=PKW(P0,14), pw1); \
    VRD(2); SBAR(); GAPA(C0=__builtin_amdgcn_mfma_f32_32x32x16_bf16(kf[4],qr[2],C0,0,0,0),   P1[2],P1[3],P1[4],P1[5],     pw2[0]=PKW(P1,0), pw2[1]=PKW(P1,2), pw2); \
    VRD(6); SBAR(); GAPA(C1=__builtin_amdgcn_mfma_f32_32x32x16_bf16(kf[5],qr[2],C1,0,0,0),   P1[6],P1[7],P1[8],P1[9],     pw2[2]=PKW(P1,4), pw2[3]=PKW(P1,6), pw2); \
    VRD(3); SBAR(); GAPA(C0=__builtin_amdgcn_mfma_f32_32x32x16_bf16(kf[6],qr[3],C0,0,0,0),   P1[10],P1[11],P1[12],P1[13], pw3[0]=PKW(P1,8), pw3[1]=PKW(P1,10), pw3); \
    VRD(7); SBAR(); GAPA(C1=__builtin_amdgcn_mfma_f32_32x32x16_bf16(kf[7],qr[3],C1,0,0,0),   P1[14],P1[15],0.f,0.f,       pw3[2]=PKW(P1,12),pw3[3]=PKW(P1,14), pw3); \
    l_reg+=sacc; \
    if(GK){DMA_K((t)+3,sl_cur);} if(GV){DMA_V((t)+1,sl_next);} \
    CMASK(C0,C1,t); \
    { float a=MX3(C0[0],C0[1],C1[0]),b=MX3(C0[2],C0[3],C1[1]); a=MX3(a,C1[2],C1[3]); \
      _Pragma("unroll") for(int r=4;r<16;r+=4){a=MX3(a,C0[r],C0[r+1]);b=MX3(b,C0[r+2],C0[r+3]);a=MX3(a,C1[r],C1[r+1]);b=MX3(b,C1[r+2],C1[r+3]);} \
      float rm=__builtin_fmaxf(a,b); { auto rr=__builtin_amdgcn_permlane32_swap(__float_as_uint(rm),__float_as_uint(rm),false,false); rm=__builtin_fmaxf(__uint_as_float(rr[0]),__uint_as_float(rr[1])); } \
      resc=false; \
      rm-=mhat;     \
      if(__builtin_expect(__any(rm>(float)THRL),0)){ const float dl=__builtin_fmaxf(rm,0.f); mhat+=dl; \
        const float f=__builtin_amdgcn_exp2f(-dl); l_reg*=f; if(hi==0)wsf[r32]=f; resc=true; } } \
    SBAR(); \
    GAPB2(o[0]=__builtin_amdgcn_mfma_f32_32x32x16_bf16(PAF(0),VFR(0),o[0],0,0,0), C0,0); VRD2(0); \
    GAPB2(o[1]=__builtin_amdgcn_mfma_f32_32x32x16_bf16(PAF(0),VFR(4),o[1],0,0,0), C0,2); VRD2(4); \
    KRD(GL,0); GAPB2(o[0]=__builtin_amdgcn_mfma_f32_32x32x16_bf16(PAF(1),VFR(1),o[0],0,0,0), C0,4); VRD2(1); \
    KRD(GL,1); GAPB2(o[1]=__builtin_amdgcn_mfma_f32_32x32x16_bf16(PAF(1),VFR(5),o[1],0,0,0), C0,6); VRD2(5); \
    KRD(GL,2); GAPB2(o[0]=__builtin_amdgcn_mfma_f32_32x32x16_bf16(PAF(2),VFR(2),o[0],0,0,0), C0,8); VRD2(2); \
    KRD(GL,3); GAPB2(o[1]=__builtin_amdgcn_mfma_f32_32x32x16_bf16(PAF(2),VFR(6),o[1],0,0,0), C0,10); VRD2(6); \
    GAPB2(o[0]=__builtin_amdgcn_mfma_f32_32x32x16_bf16(PAF(3),VFR(3),o[0],0,0,0), C0,12); VRD2(3); \
    GAPB2(o[1]=__builtin_amdgcn_mfma_f32_32x32x16_bf16(PAF(3),VFR(7),o[1],0,0,0), C0,14); VRD2(7); \
    GAPB2(o[2]=__builtin_amdgcn_mfma_f32_32x32x16_bf16(PAF(0),VFR(0),o[2],0,0,0), C1,0); \
    GAPB2(o[3]=__builtin_amdgcn_mfma_f32_32x32x16_bf16(PAF(0),VFR(4),o[3],0,0,0), C1,2); \
    GAPB2(o[2]=__builtin_amdgcn_mfma_f32_32x32x16_bf16(PAF(1),VFR(1),o[2],0,0,0), C1,4); \
    GAPB2(o[3]=__builtin_amdgcn_mfma_f32_32x32x16_bf16(PAF(1),VFR(5),o[3],0,0,0), C1,6); \
    GAPB2(o[2]=__builtin_amdgcn_mfma_f32_32x32x16_bf16(PAF(2),VFR(2),o[2],0,0,0), C1,8); \
    GAPB2(o[3]=__builtin_amdgcn_mfma_f32_32x32x16_bf16(PAF(2),VFR(6),o[3],0,0,0), C1,10); \
    GAPB2(o[2]=__builtin_amdgcn_mfma_f32_32x32x16_bf16(PAF(3),VFR(3),o[2],0,0,0), C1,12); \
    GAPB2(o[3]=__builtin_amdgcn_mfma_f32_32x32x16_bf16(PAF(3),VFR(7),o[3],0,0,0), C1,14); \
    }while(0)
  int t=1;
  #undef CMASK
  #define CMASK(P0,P1,t) do{}while(0)
  for(;t+5<NT;t+=2){
    STEP(pB0,pB1,pA0,pA1,t,true,true,true);     WAIT_BAR(3); RESC(); ROT();
    STEP(pA0,pA1,pB0,pB1,t+1,true,true,true);   WAIT_BAR(3); RESC(); ROT();
  }
  #undef CMASK
  #define CMASK(P0,P1,t) do{int jb_=(t)-(NT-4); if(jb_>=0)cmask(P0,P1,jb_,qrel,hi);}while(0)
  #define ENDW(tt) do{ if((tt)+3<NT){WAIT_BAR(3);} else if((tt)+2<NT){WAIT_BAR(2);} else {WAIT_BAR(0);} }while(0)
  for(;t+1<NT;t+=2){
    STEP(pB0,pB1,pA0,pA1,t,(t+3<NT),(t+1<NT),(t+1<NT));       ENDW(t);   RESC(); ROT();
    STEP(pA0,pA1,pB0,pB1,t+1,(t+4<NT),(t+2<NT),(t+2<NT));     ENDW(t+1); RESC(); ROT();
  }
  STEP(pB0,pB1,pA0,pA1,NT-1,false,false,false); RESC();
  { float sacc=pB0[0]+pB0[1]; _Pragma("unroll") for(int r=2;r<16;++r)sacc+=pB0[r]; _Pragma("unroll") for(int r=0;r<16;++r)sacc+=pB1[r]; l_reg+=sacc;
    pw0=(u32x4){PKW(pB0,0),PKW(pB0,2),PKW(pB0,4),PKW(pB0,6)};pw1=(u32x4){PKW(pB0,8),PKW(pB0,10),PKW(pB0,12),PKW(pB0,14)};pw2=(u32x4){PKW(pB1,0),PKW(pB1,2),PKW(pB1,4),PKW(pB1,6)};pw3=(u32x4){PKW(pB1,8),PKW(pB1,10),PKW(pB1,12),PKW(pB1,14)};
    SBAR(); pv(o,vb0+2*sl_cur,PAF(0),PAF(1),PAF(2),PAF(3)); }
  #undef PKW
  #undef PAF
  #undef VFR
  #undef PIN
  #undef MX3
  #undef GAPA
  #undef GAPB
  #undef GAPB2
  #undef VRD2
  #undef EX
  #undef VRD
  #undef KRD
  #undef STEP
  #undef ENDW
  {auto rr=__builtin_amdgcn_permlane32_swap(__float_as_uint(l_reg),__float_as_uint(l_reg),false,false);l_reg=__uint_as_float(rr[0])+__uint_as_float(rr[1]);}
  if(hi==0)wsf[32+r32]=l_reg;asm volatile("s_waitcnt lgkmcnt(0)":::"memory");
  float rli[16];
  #pragma unroll
  for(int r=0;r<16;++r)rli[r]=__builtin_amdgcn_rcpf(wsf[32+crow(r,hi)]);
  bf16*Ow=O+(rowbase+q0+wid*QBLK)*DM+hv*2*D;
  { bf16*stg=(bf16*)(shm+LDS_OST)+wid*2048;
    #pragma unroll
    for(int ps=0;ps<2;++ps){
    #pragma unroll
    for(int r=0;r<16;++r){const int orow=crow(r,hi);
      #pragma unroll
      for(int d0=0;d0<2;++d0)stg[orow*64+d0*32+r32]=__float2bfloat16(o[2*ps+d0][r]*rli[r]);}
    asm volatile("s_waitcnt lgkmcnt(0)":::"memory");
    #pragma unroll
    for(int i=0;i<4;++i){const int row=i*8+(lane>>3),ch=lane&7; const u32x4 v=*(const u32x4*)(stg+row*64+ch*8); ATTN_STORE16(Ow+(long)row*DM+ps*64+ch*8,v);}
    asm volatile("s_waitcnt lgkmcnt(0)":::"memory"); } }
  asm volatile("s_waitcnt lgkmcnt(0)\n\ts_barrier":::"memory");
  #undef DMA_K
  #undef DMA_V
  #undef CMASK
  #undef START
  #undef RESC
  #undef ROT
}
constexpr int ATTN_LDS_BYTES=LDS_BYTES;
struct AttnTensors { const bf16* Q; const bf16* K; const bf16* V; bf16* O0; bf16* O1; };
template<int THRL=8> __device__ __forceinline__ void attn_phase(char*lds,const AttnTensors&T,int vcu){
  const int combo=vcu>>3, s=vcu&7, m=combo&1, h=(combo>>1)&7, b=combo>>4;
  bf16* O = m ? T.O1 : T.O0;
  for(int i=0;i<8;++i){ const int j=i>>1, qb=(i&1)?(16*j+15-s):(16*j+s); attn_unit<THRL>(b,2*h+m,h,qb,T.Q,T.K,T.V,O,lds); }
}
#undef SBAR
#undef WAIT_BAR
}
constexpr int NWAVES = 8;
#ifndef MK_N_LAUNCHES
#define MK_N_LAUNCHES 1
#endif
constexpr int N_PHASES = 9;
#ifndef PROBE_DUP
#define PROBE_DUP (-1)
#endif
#define REPS(k) for (int rep_ = 0; rep_ < ((PROBE_DUP == (k)) ? 2 : 1); ++rep_)
constexpr int N_LAUNCHES = MK_N_LAUNCHES;
static_assert(N_LAUNCHES == 1 || N_LAUNCHES == N_PHASES, "MK_N_LAUNCHES is 1 or 9");

constexpr int T = 32768, SEQL = 16384, D = 2048, NIN = 5120;
constexpr float EPS = 1e-6f;
constexpr float LAMBDA_INIT = 0.2f;

constexpr size_t MiB = 1u << 20;
constexpr size_t WS_CTL = 0, CTL_ZERO_BYTES = 32768;
constexpr size_t WS_WIN = 2 * MiB;
constexpr size_t WS_WOUT = 22 * MiB;
constexpr size_t WS_WSC = 30 * MiB;
constexpr size_t WS_ROPE = 38 * MiB;
constexpr size_t WS_USC = 39 * MiB, WS_VSC = 39 * MiB + 65536;
constexpr size_t WS_RT = 39 * MiB + 262144;
constexpr size_t WS_RINV = 39 * MiB + 524288;
constexpr size_t WS_XN = 40 * MiB;
constexpr size_t WS_Q = 168 * MiB, WS_K = 232 * MiB, WS_V = 296 * MiB, WS_U = 360 * MiB, WS_Z = 424 * MiB;
constexpr size_t WS_O0 = 488 * MiB, WS_O1 = 552 * MiB;
constexpr size_t WS_MIX = 616 * MiB;
constexpr size_t WS_SC = 168 * MiB;
constexpr size_t WS_GATE = 888 * MiB;
constexpr size_t WS_SSQ = 904 * MiB;
constexpr size_t WS_UT2 = 776 * MiB, WS_VT2 = 840 * MiB;
constexpr size_t WS_EB16 = 568 * MiB;
constexpr size_t WS_END = 908 * MiB;
static_assert(WS_SC + (size_t)2048 * T * 4 <= WS_Z, "SC overlay stays inside Q|K|V|U");
constexpr int CW_TMO = 0;
constexpr int CW_BAR = 4096;
static_assert((CW_BAR + 3456) * 4 <= (int)CTL_ZERO_BYTES, "barrier words inside the per-call memset");

constexpr int RING_OFF = 0, RING_BYTES = 131072;
constexpr int LDSCTL_OFF = RING_BYTES, MISC_OFF = LDSCTL_OFF + 320;
constexpr int SMALL_OFF = RING_BYTES + 1024;
constexpr int LDS_BYTES = 147456;
static_assert(MISC_OFF + 128 <= SMALL_OFF && SMALL_OFF + 4096 <= LDS_BYTES, "LDS map");

#define GAS __attribute__((address_space(1)))
#define LAS __attribute__((address_space(3)))
typedef unsigned short bf16;
typedef unsigned v4u __attribute__((ext_vector_type(4)));
typedef float f32x4 __attribute__((ext_vector_type(4)));
typedef short bf16x8 __attribute__((ext_vector_type(8)));
typedef GAS unsigned gu32;
typedef GAS unsigned long long gu64;
#define RLX_AGENT __ATOMIC_RELAXED, __HIP_MEMORY_SCOPE_AGENT
#define LDS_WAIT() asm volatile("s_waitcnt lgkmcnt(0)" ::: "memory")
#define VM_WAIT() asm volatile("s_waitcnt vmcnt(0)" ::: "memory")
__device__ __forceinline__ unsigned long long rt() { return __builtin_amdgcn_s_memrealtime(); }
__device__ __forceinline__ unsigned f2bf(float f) { unsigned u = __builtin_bit_cast(unsigned, f); return (u + 0x7fffu + ((u >> 16) & 1u)) >> 16; }
__device__ __forceinline__ unsigned pk2(float lo, float hi) { return f2bf(lo) | (f2bf(hi) << 16); }

#define XB_TMO      128
#define XB_XCNT(j)  (256  + 64 * (j))
#define XB_XSUB(j)  (1280 + 64 * (j))
#define XB_XGEN(j)  (2304 + 64 * (j))
#define XB_TOP      3328
#define XB_TOPGEN   3392
#define XCD_BAR_WORDS 3456
#define XB_SPIN_CAP (1u << 18)

__device__ __forceinline__ unsigned xb_ld(unsigned* p)              { return __hip_atomic_load(p, __ATOMIC_RELAXED, __HIP_MEMORY_SCOPE_AGENT); }
__device__ __forceinline__ unsigned xb_add(unsigned* p, unsigned v) { return __hip_atomic_fetch_add(p, v, __ATOMIC_RELAXED, __HIP_MEMORY_SCOPE_AGENT); }
__device__ __forceinline__ unsigned xb_xcc_id() { return (unsigned)__builtin_amdgcn_s_getreg((3 << 11) | 20) & 0xFu; }
#define XB_SPIN(cond, bar) do { unsigned _sp = 0; while (cond) { __builtin_amdgcn_s_sleep(1); \
    if ((++_sp & 255u) == 0u) { if (xb_ld(&(bar)[XB_TMO])) break; if (_sp > XB_SPIN_CAP) { atomicAdd(&(bar)[XB_TMO], 1u); break; } } } } while (0)

struct XcdBarrier {
    unsigned* bar; unsigned x;
    volatile LAS unsigned* st;
};

__device__ __forceinline__ XcdBarrier xcd_barrier_post(unsigned* bar, volatile LAS unsigned* st) {
    XcdBarrier b; b.bar = bar; b.x = xb_xcc_id(); b.st = st;
    if (threadIdx.x == 0) (void)xb_add(&bar[XB_XCNT(b.x)], 1u);
    return b;
}
__device__ __forceinline__ void xcd_barrier_complete(unsigned* bar, unsigned x, unsigned& nloc, unsigned& nx) {
    const unsigned G = gridDim.x * gridDim.y * gridDim.z;
    unsigned sum, cnt, mine, sp = 0u;
    for (;;) {
        sum = 0u; cnt = 0u; mine = 0u;
#pragma unroll
        for (unsigned j = 0; j < 16; ++j) { const unsigned c = xb_ld(&bar[XB_XCNT(j)]); sum += c; cnt += (c > 0u) ? 1u : 0u; mine = (j == x) ? c : mine; }
        if (sum == G) break;
        __builtin_amdgcn_s_sleep(1);
        if ((++sp & 255u) == 0u) { if (xb_ld(&bar[XB_TMO])) break; if (sp > XB_SPIN_CAP) { atomicAdd(&bar[XB_TMO], 1u); break; } }
    }
    nloc = mine > 0u ? mine : 1u; nx = cnt > 0u ? cnt : 1u;
}

__device__ __forceinline__ void xcd_barrier(const XcdBarrier& b) {
    asm volatile("s_waitcnt vmcnt(0)" ::: "memory");
    __syncthreads();
    if (threadIdx.x == 0) {
        unsigned* bar = b.bar;
        __builtin_amdgcn_s_waitcnt(0);
        unsigned nloc = b.st[0], nx = b.st[1];
        if (nloc == 0u) { xcd_barrier_complete(bar, b.x, nloc, nx); b.st[0] = nloc; b.st[1] = nx; }
        const unsigned old = xb_add(&bar[XB_XSUB(b.x)], 1u);
        const unsigned gen = old / nloc;
        if (old + 1u == (gen + 1u) * nloc) {
            __builtin_amdgcn_fence(__ATOMIC_RELEASE, "agent");
            asm volatile("s_waitcnt vmcnt(0)" ::: "memory");
            const unsigned og = xb_add(&bar[XB_TOP], 1u);
            const unsigned tg = og / nx;
            if (og + 1u == (tg + 1u) * nx) xb_add(&bar[XB_TOPGEN], 1u);
            else XB_SPIN(xb_ld(&bar[XB_TOPGEN]) == tg, bar);
            __builtin_amdgcn_fence(__ATOMIC_ACQUIRE, "agent");
            xb_add(&bar[XB_XGEN(b.x)], 1u);
            asm volatile("s_waitcnt vmcnt(0)" ::: "memory");
        } else {
            XB_SPIN(xb_ld(&bar[XB_XGEN(b.x)]) == gen, bar);
            __builtin_amdgcn_fence(__ATOMIC_ACQUIRE, "agent");
            asm volatile("s_waitcnt vmcnt(0)" ::: "memory");
        }
    }
    __syncthreads();
}


typedef unsigned long long u64;
typedef float f32x2v __attribute__((ext_vector_type(2)));
typedef __bf16 bf16x2_t __attribute__((ext_vector_type(2)));
__device__ __forceinline__ float bflo(unsigned u) { return __builtin_bit_cast(float, u << 16); }
__device__ __forceinline__ float bfhi(unsigned u) { return __builtin_bit_cast(float, u & 0xffff0000u); }
__device__ __forceinline__ float wave_sum(float v) {
#pragma unroll
    for (int o = 1; o < 64; o <<= 1) v += __shfl_xor(v, o);
    return v;
}
__device__ __forceinline__ float gelu_tanh(float x) { return pg8::gelu_tanh(x); }

__device__ const float c_invf[8] = {1.0f, 0.1939227432012558f, 0.03760603070259094f, 0.007292664609849453f, 0.0014142135623842478f, 0.00027424818836152554f, 5.318296098266728e-05f, 1.0313386155758053e-05f};

struct Args { const float* in[19]; float* out; unsigned char* ws; int ph_lo, ph_hi, li, pad; };
#define F_IN(k) (args.in[k])
#define F_WS(ty, off) ((ty*)(F.ws + (off)))
struct Frame {
    LAS unsigned char* lds;
    volatile LAS unsigned* MISC;
    gu32* ctl;
    int tid, lane, wave;
    int vcu, G;
    float* out; unsigned char* ws;
};

__device__ __forceinline__ void p0_transpose_item(const float* W, int K, int N, bf16* WT, LAS float* scr, int item, int lane, int rope_rows) {
    const int nblk = N / 32, kb = item / nblk, nb = item % nblk, k0 = 64 * kb, n0 = 32 * nb;
#pragma unroll 8
    for (int i = 0; i < 32; ++i) { const int kk = 2 * i + (lane >> 5); scr[kk * 33 + (lane & 31)] = W[(size_t)(k0 + kk) * N + n0 + (lane & 31)]; }
    LDS_WAIT(); asm volatile("" ::: "memory");
    const int c = lane & 7;
    const bool perm = (n0 < rope_rows) && ((n0 & 63) == 0);
#pragma unroll
    for (int j = 0; j < 4; ++j) { const int n = (lane >> 3) + 8 * j; const int src = (perm && n < 16) ? ((n >> 1) + 8 * (n & 1)) : n; const LAS float* s = scr + (8 * c) * 33 + src;
        v4u o; o.x = pk2(s[0 * 33], s[1 * 33]); o.y = pk2(s[2 * 33], s[3 * 33]); o.z = pk2(s[4 * 33], s[5 * 33]); o.w = pk2(s[6 * 33], s[7 * 33]);
        *(GAS v4u*)(WT + (size_t)(n0 + n) * K + k0 + 8 * c) = o; }
    LDS_WAIT(); asm volatile("" ::: "memory");
}
struct RmsRows2 { f32x4 v[8], w[8]; };
__device__ __forceinline__ void rms_rows2_load(RmsRows2& R, const float* xrow0, const float* xrow1, int lane) {
    const GAS f32x4* xr0 = (const GAS f32x4*)xrow0 + lane; const GAS f32x4* xr1 = (const GAS f32x4*)xrow1 + lane;
#pragma unroll
    for (int j = 0; j < 8; ++j) { R.v[j] = xr0[64 * j]; R.w[j] = xr1[64 * j]; }
}
__device__ __forceinline__ void rms_rows2_finish(const RmsRows2& R, const float* g, bf16* orow0, bf16* orow1, int lane, float* rinv0, float* rinv1) {
    float s0 = 0.f, s1 = 0.f;
#pragma unroll
    for (int j = 0; j < 8; ++j) { s0 += (R.v[j].x * R.v[j].x + R.v[j].y * R.v[j].y) + (R.v[j].z * R.v[j].z + R.v[j].w * R.v[j].w); s1 += (R.w[j].x * R.w[j].x + R.w[j].y * R.w[j].y) + (R.w[j].z * R.w[j].z + R.w[j].w * R.w[j].w); }
    const float q0 = sqrtf(wave_sum(s0) * (1.f / D) + EPS), q1 = sqrtf(wave_sum(s1) * (1.f / D) + EPS); const float r0 = 1.f / q0, r1 = 1.f / q1;
    if (lane == 0) { *rinv0 = q0; *rinv1 = q1; }
    const GAS f32x4* gr = (const GAS f32x4*)g + lane;
    GAS u64* o0 = (GAS u64*)orow0 + lane; GAS u64* o1 = (GAS u64*)orow1 + lane;
#pragma unroll
    for (int j = 0; j < 8; ++j) { const f32x4 gg = gr[64 * j];
        o0[64 * j] = (u64)pk2(R.v[j].x * r0 * gg.x, R.v[j].y * r0 * gg.y) | ((u64)pk2(R.v[j].z * r0 * gg.z, R.v[j].w * r0 * gg.w) << 32);
        o1[64 * j] = (u64)pk2(R.w[j].x * r1 * gg.x, R.w[j].y * r1 * gg.y) | ((u64)pk2(R.w[j].z * r1 * gg.z, R.w[j].w * r1 * gg.w) << 32); }
}
__device__ __forceinline__ void p0_wsc_item(Frame& F, const Args& args, int it) {
    const int g = it >> 5, kk0 = (it & 31) * 64;
    LAS float* sk = (LAS float*)(F.lds + RING_OFF);
    LAS float* wq = sk + 128 * 129;
    const float* skg = F_IN(15) + (size_t)g * 128 * 128;
    for (int i = F.tid; i < 128 * 32; i += NWAVES * 64) { const int k = i >> 5, d4 = (i & 31) * 4; const f32x4 v = *(const GAS f32x4*)(skg + k * 128 + d4);
        sk[k * 129 + d4] = v.x; sk[k * 129 + d4 + 1] = v.y; sk[k * 129 + d4 + 2] = v.z; sk[k * 129 + d4 + 3] = v.w; }
    for (int i = F.tid; i < 64 * 32; i += NWAVES * 64) { const int r = i >> 5, d4 = (i & 31) * 4; const f32x4 v = *(const GAS f32x4*)(F_IN(14) + (size_t)(kk0 + r) * 2048 + g * 128 + d4);
        wq[r * 129 + d4] = v.x; wq[r * 129 + d4 + 1] = v.y; wq[r * 129 + d4 + 2] = v.z; wq[r * 129 + d4 + 3] = v.w; }
    __syncthreads();
    const int kkl = F.tid & 63, kb = (F.tid >> 6) * 16;
    float acc[16];
#pragma unroll
    for (int j = 0; j < 16; ++j) acc[j] = 0.f;
    for (int d = 0; d < 128; ++d) { const float a = wq[kkl * 129 + d];
#pragma unroll
        for (int j = 0; j < 16; ++j) acc[j] += a * sk[(kb + j) * 129 + d]; }
    const float fg = F_IN(13)[kk0 + kkl];
#pragma unroll
    for (int j = 0; j < 16; ++j) F_WS(bf16, WS_WSC)[(size_t)(g * 128 + kb + j) * 2048 + kk0 + kkl] = (bf16)f2bf(acc[j] * fg);
    __syncthreads();
}
__device__ __forceinline__ void p0_prologue(Frame& F, const Args& args) {
    LAS float* scr = (LAS float*)(F.lds + RING_OFF + F.wave * 16384);
    const int gw = F.vcu * NWAVES + F.wave, NGW = F.G * NWAVES;
    constexpr int I_IN = (D / 64) * (NIN / 32), I_OUT = (D / 64) * (D / 32);
    for (int it = gw; it < I_IN + I_OUT; it += NGW) {
        if (it < I_IN) p0_transpose_item(F_IN(2), D, NIN, F_WS(bf16, WS_WIN), scr, it, F.lane, 2048);
        else p0_transpose_item(F_IN(12), D, D, F_WS(bf16, WS_WOUT), scr, it - I_IN, F.lane, 0);
    }
    __syncthreads();
    for (int it = F.vcu; it < 512; it += F.G) p0_wsc_item(F, args, it);
    { const int gt = F.vcu * (NWAVES * 64) + F.tid, NGT = F.G * NWAVES * 64;
      for (int i = gt; i < SEQL * 8; i += NGT) { const int pos = i >> 3, f = i & 7;
          const float angf = (float)pos * c_invf[f];
          const double a = (double)angf, n = __builtin_rint(a * 0.15915494309189535);
          double r = __builtin_fma(-n, 6.283185307179586, a); r = __builtin_fma(-n, 2.4492935982947064e-16, r);
          const double r2 = r * r; double sn = 1.0, cs = 1.0;
#pragma unroll
          for (int k = 12; k >= 1; --k) { sn = 1.0 - r2 * (1.0 / (double)((2 * k) * (2 * k + 1))) * sn; cs = 1.0 - r2 * (1.0 / (double)((2 * k - 1) * (2 * k))) * cs; }
          sn *= r;
          *(GAS f32x2v*)(F_WS(float, WS_ROPE) + (size_t)i * 2) = (f32x2v){(float)cs, (float)sn}; } }
    for (int r0 = gw; r0 < T; r0 += 2 * NGW) { RmsRows2 XR;
        rms_rows2_load(XR, F_IN(0) + (size_t)r0 * D, F_IN(0) + (size_t)(r0 + NGW) * D, F.lane);
        rms_rows2_finish(XR, F_IN(1), F_WS(bf16, WS_XN) + (size_t)r0 * D, F_WS(bf16, WS_XN) + (size_t)(r0 + NGW) * D, F.lane, F_WS(float, WS_RINV) + r0, F_WS(float, WS_RINV) + r0 + NGW); }
}

__device__ __forceinline__ void peer_tables_rows(Frame& F, const Args& args) {
    const int gw = F.vcu * NWAVES + F.wave, NGW = F.G * NWAVES;
    {   f32x4 fg[8];
#pragma unroll
        for (int x = 0; x < 8; ++x) fg[x] = ((const GAS f32x4*)F_IN(13))[64 * x + F.lane];
        LAS unsigned char* cb = F.lds + RING_OFF + F.wave * 16384;
        constexpr int NR = 2 * 16384;
#define P0_LOAD_ROW(V, rr_) { const int rq = (rr_) < NR ? (rr_) : gw; const bool sec_ = rq >= 16384; const int row_ = sec_ ? rq - 16384 : rq; \
        const GAS f32x4* src = (const GAS f32x4*)((sec_ ? F_IN(17) : F_IN(16)) + (size_t)row_ * D) + F.lane; \
        _Pragma("unroll") for (int x = 0; x < 8; ++x) V[x] = src[64 * x]; }
        f32x4 v0[8], v1[8], v2[8];
        P0_LOAD_ROW(v0, gw) P0_LOAD_ROW(v1, gw + NGW)
        for (int rr = gw; rr < NR; rr += NGW) {
            P0_LOAD_ROW(v2, rr + 2 * NGW)
            const bool second = rr >= 16384; const int row = second ? rr - 16384 : rr; const int lane = F.lane;
            if (!second) {
#pragma unroll
                for (int x = 0; x < 8; ++x) v0[x] = v0[x] * fg[x]; }
            float am = 0.f;
#pragma unroll
            for (int x = 0; x < 8; ++x)
#pragma unroll
                for (int i = 0; i < 4; ++i) am = fmaxf(am, fabsf(v0[x][i]));
#pragma unroll
            for (int o = 1; o < 64; o <<= 1) am = fmaxf(am, __shfl_xor(am, o));
            const float sc = am > 0.f ? 6.f / am : 1.f, inv = am > 0.f ? am * (1.f / 6.f) : 1.f;
#pragma unroll
            for (int x = 0; x < 8; ++x) { unsigned p = 0u;
                p = __builtin_amdgcn_cvt_scalef32_pk_fp4_f32(p, v0[x][0] * sc, v0[x][1] * sc, 1.0f, 0);
                p = __builtin_amdgcn_cvt_scalef32_pk_fp4_f32(p, v0[x][2] * sc, v0[x][3] * sc, 1.0f, 1);
                const unsigned c0 = p & 15u, c1 = (p >> 4) & 15u, c2 = (p >> 8) & 15u, c3 = (p >> 12) & 15u;
                if (!second) *(LAS unsigned*)(cb + x * 256 + 4 * lane) = c0 | (c1 << 8) | (c2 << 16) | (c3 << 24);
                else { LAS unsigned char* q = cb + x * 256 + 64 * (lane & 3) + (lane >> 2);
                    q[0] = (unsigned char)c0; q[16] = (unsigned char)c1; q[32] = (unsigned char)c2; q[48] = (unsigned char)c3; } }
            asm volatile("s_waitcnt lgkmcnt(0)" ::: "memory");
            const v4u q0 = *(const LAS v4u*)(cb + 32 * lane), q1 = *(const LAS v4u*)(cb + 32 * lane + 16);
            asm volatile("s_waitcnt lgkmcnt(0)" ::: "memory");
            v4u o;
#define PK16(w) ((((w) | ((w) >> 4)) & 0xffu) | ((((w) | ((w) >> 4)) >> 8) & 0xff00u))
            o.x = PK16(q0.x) | (PK16(q0.y) << 16); o.y = PK16(q0.z) | (PK16(q0.w) << 16); o.z = PK16(q1.x) | (PK16(q1.y) << 16); o.w = PK16(q1.z) | (PK16(q1.w) << 16);
#undef PK16
            *(GAS v4u*)((GAS unsigned char*)(F.ws + (second ? WS_VT2 : WS_UT2)) + ((size_t)(lane >> 3) * 16384 + row) * 128 + (lane & 7) * 16) = o;
            if (lane == 0) (second ? F_WS(float, WS_VSC) : F_WS(float, WS_USC))[row] = inv;
#pragma unroll
            for (int x = 0; x < 8; ++x) { v0[x] = v1[x]; v1[x] = v2[x]; } }
#undef P0_LOAD_ROW
    }
}

__device__ __forceinline__ void combine_row(Frame& F, const Args& args, int t0, int t1, float lam) {
    v4u a[2][2], b[2][2];
#pragma unroll
    for (int u = 0; u < 2; ++u)
#pragma unroll
        for (int j = 0; j < 2; ++j) { const size_t off = (size_t)(u ? t1 : t0) * 1024 + 8 * F.lane + 512 * j; a[u][j] = *(const GAS v4u*)(F_WS(bf16, WS_O0) + off); b[u][j] = *(const GAS v4u*)(F_WS(bf16, WS_O1) + off); }
    const int d0 = (8 * F.lane) & 127;
    const f32x4 g0 = *(const GAS f32x4*)(F_IN(7) + d0), g1 = *(const GAS f32x4*)(F_IN(7) + d0 + 4);
#pragma unroll
    for (int u = 0; u < 2; ++u)
#pragma unroll
    for (int j = 0; j < 2; ++j) { const int t = u ? t1 : t0;
        float o[8]; float ss = 0.f;
#pragma unroll
        for (int i = 0; i < 4; ++i) { o[2 * i] = bflo(a[u][j][i]) - lam * bflo(b[u][j][i]); o[2 * i + 1] = bfhi(a[u][j][i]) - lam * bfhi(b[u][j][i]); ss += o[2 * i] * o[2 * i] + o[2 * i + 1] * o[2 * i + 1]; }
        ss += __shfl_xor(ss, 1); ss += __shfl_xor(ss, 2); ss += __shfl_xor(ss, 4); ss += __shfl_xor(ss, 8);
        const float r = (1.f - LAMBDA_INIT) / sqrtf(ss * (1.f / 128.f) + EPS);
        v4u w; w.x = pk2(o[0] * r * g0.x, o[1] * r * g0.y); w.y = pk2(o[2] * r * g0.z, o[3] * r * g0.w); w.z = pk2(o[4] * r * g1.x, o[5] * r * g1.y); w.w = pk2(o[6] * r * g1.z, o[7] * r * g1.w);
        *(GAS v4u*)(F_WS(bf16, WS_MIX) + (size_t)t * 2048 + 8 * F.lane + 512 * j) = w; }
}
typedef float f32x16g __attribute__((ext_vector_type(16)));
__device__ __forceinline__ int gm_crow(int r, int hi) { return (r & 3) + 8 * (r >> 2) + 4 * hi; }
__device__ __forceinline__ void gmlp_unit(Frame& F, const Args& args, int unit) {
    constexpr int ROWB = 272;
    constexpr int SZS = 132;
    LAS unsigned char* aimg = F.lds + RING_OFF;
    LAS unsigned char* bimg = aimg + 128 * ROWB;
    LAS float* szt = (LAS float*)(F.lds + RING_OFF);
    LAS float* rq = (LAS float*)(F.lds + SMALL_OFF);
    static_assert(128 * SZS * 4 <= 2 * 128 * ROWB, "product tile fits over the images");
    const int t0 = unit * 128;
    const int lane = F.lane, r32 = lane & 31, hi = lane >> 5, w = F.wave, pb = 32 * (w & 3), cb = 64 * (w >> 2);
    const int q = F.tid >> 2, cq = F.tid & 3;
    const GAS bf16* zrow = (const GAS bf16*)(F_WS(bf16, WS_Z) + (size_t)(t0 + q) * 1024 + 8 * cq);
    const GAS bf16* urow = (const GAS bf16*)(F_WS(bf16, WS_U) + (size_t)(t0 + q) * 1024 + 8 * cq);
    GAS bf16* mrow = (GAS bf16*)(F_WS(bf16, WS_MIX) + (size_t)(t0 + q) * 2048 + 1024 + 8 * cq);
    v4u rawz[4], ucur[4]; f32x4 wreg[8];
#define GM_LOAD_ZW(g_) do { _Pragma("unroll") for (int j = 0; j < 4; ++j) rawz[j] = *(const GAS v4u*)(zrow + (g_) * 128 + 32 * j); \
        _Pragma("unroll") for (int i = 0; i < 8; ++i) { const int idx = F.tid + NWAVES * 64 * i; wreg[i] = *(const GAS f32x4*)(F_IN(9) + ((size_t)(g_) * 128 + (idx >> 5)) * 128 + (idx & 31) * 4); } } while (0)
    GM_LOAD_ZW(0);
#pragma unroll
    for (int j = 0; j < 4; ++j) ucur[j] = *(const GAS v4u*)(urow + 32 * j);
    float ssrow = 0.f;
    for (int g = 0; g < 8; ++g) {
        __syncthreads();
        { float ss = 0.f;
#pragma unroll
          for (int j = 0; j < 4; ++j)
#pragma unroll
              for (int i = 0; i < 4; ++i) { const float a = bflo(rawz[j][i]), b = bfhi(rawz[j][i]); ss += a * a + b * b;
                  const int c = 8 * cq + 32 * j + 2 * i;
                  *(LAS unsigned short*)(bimg + c * ROWB + q * 2) = (unsigned short)(rawz[j][i] & 0xffffu);
                  *(LAS unsigned short*)(bimg + (c + 1) * ROWB + q * 2) = (unsigned short)(rawz[j][i] >> 16); }
          ss += __shfl_xor(ss, 1); ss += __shfl_xor(ss, 2);
          if (cq == 0) rq[q] = 1.f / sqrtf(ss * (1.f / 128.f) + EPS); }
        __syncthreads();
#pragma unroll
        for (int i = 0; i < 8; ++i) { const int idx = F.tid + NWAVES * 64 * i, p = idx >> 5, q4 = (idx & 31) * 4;
            f32x4 wv = wreg[i];
            if (p < 64 && q4 >= 64) wv = (f32x4){0.f, 0.f, 0.f, 0.f};
            const f32x4 rr = *(const LAS f32x4*)(rq + q4);
            *(LAS u64*)(aimg + p * ROWB + q4 * 2) = (u64)pk2(wv.x * rr.x, wv.y * rr.y) | ((u64)pk2(wv.z * rr.z, wv.w * rr.w) << 32); }
        v4u unext[4];
        if (g < 7) { GM_LOAD_ZW(g + 1);
#pragma unroll
            for (int j = 0; j < 4; ++j) unext[j] = *(const GAS v4u*)(urow + (g + 1) * 128 + 32 * j); }
        __syncthreads();
        f32x16g acc[2];
#pragma unroll
        for (int nb = 0; nb < 2; ++nb)
#pragma unroll
            for (int r = 0; r < 16; ++r) acc[nb][r] = 0.f;
        const int nks = (pb < 64) ? 4 : 8;
        for (int sI = 0; sI < nks; ++sI) {
            const bf16x8 af = *(const LAS bf16x8*)(aimg + (pb + r32) * ROWB + 32 * sI + 16 * hi);
#pragma unroll
            for (int nb = 0; nb < 2; ++nb) { const bf16x8 bfr = *(const LAS bf16x8*)(bimg + (cb + 32 * nb + r32) * ROWB + 32 * sI + 16 * hi);
                acc[nb] = __builtin_amdgcn_mfma_f32_32x32x16_bf16(af, bfr, acc[nb], 0, 0, 0); } }
        __syncthreads();
#pragma unroll
        for (int nb = 0; nb < 2; ++nb)
#pragma unroll
            for (int r = 0; r < 16; ++r) szt[(pb + gm_crow(r, hi)) * SZS + cb + 32 * nb + r32] = acc[nb][r];
        __syncthreads();
        { const float bias = F_IN(10)[g * 128 + q];
#pragma unroll
          for (int j = 0; j < 4; ++j) { const int c0 = 8 * cq + 32 * j;
              const f32x4 s0 = *(const LAS f32x4*)(szt + q * SZS + c0), s1 = *(const LAS f32x4*)(szt + q * SZS + c0 + 4);
              const f32x4 g0 = *(const GAS f32x4*)(F_IN(8) + g * 128 + c0), g1 = *(const GAS f32x4*)(F_IN(8) + g * 128 + c0 + 4);
              const v4u uu = ucur[j];
              const float o0 = (s0.x * g0.x + bias) * bflo(uu[0]), o1 = (s0.y * g0.y + bias) * bfhi(uu[0]), o2 = (s0.z * g0.z + bias) * bflo(uu[1]), o3 = (s0.w * g0.w + bias) * bfhi(uu[1]);
              const float o4 = (s1.x * g1.x + bias) * bflo(uu[2]), o5 = (s1.y * g1.y + bias) * bfhi(uu[2]), o6 = (s1.z * g1.z + bias) * bflo(uu[3]), o7 = (s1.w * g1.w + bias) * bfhi(uu[3]);
              ssrow += (o0 * o0 + o1 * o1) + (o2 * o2 + o3 * o3) + (o4 * o4 + o5 * o5) + (o6 * o6 + o7 * o7);
              *(GAS v4u*)(mrow + g * 128 + 32 * j) = (v4u){pk2(o0, o1), pk2(o2, o3), pk2(o4, o5), pk2(o6, o7)}; } }
        if (g < 7) {
#pragma unroll
            for (int j = 0; j < 4; ++j) ucur[j] = unext[j]; }
    }
#undef GM_LOAD_ZW
    ssrow += __shfl_xor(ssrow, 1); ssrow += __shfl_xor(ssrow, 2);
    const float rr = 1.f / sqrtf(ssrow * (1.f / 1024.f) + EPS);
    VM_WAIT();
    for (int g = 0; g < 8; ++g) { u64 raw[4][2];
#pragma unroll
        for (int j = 0; j < 4; ++j) { GAS u64* ptr = (GAS u64*)(mrow + g * 128 + 32 * j); raw[j][0] = __hip_atomic_load(ptr, __ATOMIC_RELAXED, __HIP_MEMORY_SCOPE_AGENT); raw[j][1] = __hip_atomic_load(ptr + 1, __ATOMIC_RELAXED, __HIP_MEMORY_SCOPE_AGENT); }
#pragma unroll
        for (int j = 0; j < 4; ++j) { const int c0 = 8 * cq + 32 * j;
            const f32x4 g0 = *(const GAS f32x4*)(F_IN(11) + g * 128 + c0), g1 = *(const GAS f32x4*)(F_IN(11) + g * 128 + c0 + 4);
            const unsigned a0 = (unsigned)raw[j][0], a1 = (unsigned)(raw[j][0] >> 32), a2 = (unsigned)raw[j][1], a3 = (unsigned)(raw[j][1] >> 32);
            *(GAS v4u*)(mrow + g * 128 + 32 * j) = (v4u){pk2(bflo(a0) * rr * g0.x, bfhi(a0) * rr * g0.y), pk2(bflo(a1) * rr * g0.z, bfhi(a1) * rr * g0.w),
                                                         pk2(bflo(a2) * rr * g1.x, bfhi(a2) * rr * g1.y), pk2(bflo(a3) * rr * g1.z, bfhi(a3) * rr * g1.w)}; } }
    __syncthreads();
}

__device__ __forceinline__ void topk_unit(Frame& F, const Args& args, int wu) {
    const int t = (wu >> 3) * 64 + F.lane, h = wu & 7;
    int LA[16], LB[16];
#pragma unroll
    for (int j = 0; j < 16; ++j) { LA[j] = (int)0x80000000; LB[j] = (int)0x80000000; }
    const GAS unsigned short* scA = (const GAS unsigned short*)F_WS(unsigned short, WS_SC) + (size_t)(2 * h) * 128 * T + t;
    const GAS unsigned short* scB = scA + (size_t)128 * T;
#define TK_CE(a, b) { const int hi_ = (a) > (b) ? (a) : (b); const int lo_ = (a) > (b) ? (b) : (a); (a) = hi_; (b) = lo_; }
#define TK_SORT16_ASC(c) { _Pragma("unroll") for (int k_ = 2; k_ <= 16; k_ <<= 1) { _Pragma("unroll") for (int j_ = k_ >> 1; j_ > 0; j_ >>= 1) { _Pragma("unroll") for (int i_ = 0; i_ < 16; ++i_) { const int l_ = i_ ^ j_; \
        if (l_ > i_) { if ((i_ & k_) == 0) { TK_CE(c[l_], c[i_]) } else { TK_CE(c[i_], c[l_]) } } } } } }
#define TK_MERGE16(L, c) { _Pragma("unroll") for (int i_ = 0; i_ < 16; ++i_) L[i_] = L[i_] > c[i_] ? L[i_] : c[i_]; \
        _Pragma("unroll") for (int j_ = 8; j_ > 0; j_ >>= 1) { _Pragma("unroll") for (int i_ = 0; i_ < 16; ++i_) { const int l_ = i_ ^ j_; if (l_ > i_) { TK_CE(L[i_], L[l_]) } } } }
    int ca[16], cbv[16];
#pragma unroll
    for (int i = 0; i < 16; ++i) { ca[i] = (int)scA[(size_t)i * T]; cbv[i] = (int)scB[(size_t)i * T]; }
#pragma unroll 1
    for (int k0 = 0; k0 < 128; k0 += 16) {
        int na[16], nb[16];
        const int kn = (k0 + 16 < 128) ? k0 + 16 : k0;
#pragma unroll
        for (int i = 0; i < 16; ++i) { na[i] = (int)scA[(size_t)(kn + i) * T]; nb[i] = (int)scB[(size_t)(kn + i) * T]; }
#pragma unroll
        for (int i = 0; i < 16; ++i) { const int k = k0 + i;
            int ka = __builtin_bit_cast(int, (float)__builtin_bit_cast(_Float16, (unsigned short)ca[i])), kb = __builtin_bit_cast(int, (float)__builtin_bit_cast(_Float16, (unsigned short)cbv[i]));
            ka ^= (ka >> 31) & 0x7fffffff; kb ^= (kb >> 31) & 0x7fffffff;
            ca[i] = (ka & ~127) | (127 - k); cbv[i] = (kb & ~127) | (127 - k); }
        TK_SORT16_ASC(ca) TK_SORT16_ASC(cbv)
        TK_MERGE16(LA, ca) TK_MERGE16(LB, cbv)
#pragma unroll
        for (int i = 0; i < 16; ++i) { ca[i] = na[i]; cbv[i] = nb[i]; }
    }
#undef TK_CE
#undef TK_SORT16_ASC
#undef TK_MERGE16
    float ssq = 0.f;
    { float sv[32];
#pragma unroll
      for (int i = 0; i < 32; ++i) sv[i] = F_WS(float, WS_SSQ)[(size_t)i * T + t];
#pragma unroll
      for (int i = 0; i < 32; ++i) ssq += sv[i]; }
    const float rt = 1.f / sqrtf(ssq * (1.f / D) + EPS);
    if (h == 0) F_WS(float, WS_RT)[t] = rt;
    float va[16], vb[16]; int ia[16], ib[16];
#pragma unroll
    for (int j = 0; j < 16; ++j) { int a = LA[j] & ~127; ia[j] = 127 - (LA[j] & 127); a ^= (a >> 31) & 0x7fffffff; va[j] = __builtin_bit_cast(float, a) * rt;
                                   int b = LB[j] & ~127; ib[j] = 127 - (LB[j] & 127); b ^= (b >> 31) & 0x7fffffff; vb[j] = __builtin_bit_cast(float, b) * rt; }
    float S[16]; int P[16];
#pragma unroll
    for (int q = 0; q < 16; ++q) { S[q] = -INFINITY; P[q] = 0; }
#pragma unroll
    for (int i = 0; i < 16; ++i)
#pragma unroll
        for (int j = 0; j < 16; ++j) if ((i + 1) * (j + 1) <= 16) {
            float s = va[i] + vb[j]; int p = ia[i] * 128 + ib[j];
#pragma unroll
            for (int q = 0; q < 16; ++q) { const bool gt = s > S[q]; const float s2 = gt ? S[q] : s; const int p2 = gt ? P[q] : p; S[q] = gt ? s : S[q]; P[q] = gt ? p : P[q]; s = s2; p = p2; }
        }
    float e[16]; float sum = 0.f;
#pragma unroll
    for (int q = 0; q < 16; ++q) { e[q] = __expf(S[q] - S[0]); sum += e[q]; }
    const float inv = 1.f / sum;
    { GAS unsigned* e16 = (GAS unsigned*)((GAS unsigned char*)(F.ws + WS_EB16) + (size_t)t * 256) + h;
#pragma unroll
      for (int g8 = 0; g8 < 8; ++g8) e16[g8 * 8] = (unsigned)P[g8] | ((unsigned)P[g8 + 8] << 16); }
    GAS f32x4* gp = (GAS f32x4*)(F_WS(float, WS_GATE) + (size_t)t * 128 + h * 16);
#pragma unroll
    for (int q = 0; q < 4; ++q) gp[q] = (f32x4){e[4 * q] * inv, e[4 * q + 1] * inv, e[4 * q + 2] * inv, e[4 * q + 3] * inv};
}

typedef int v8i_t __attribute__((ext_vector_type(8)));
typedef int v2i_t __attribute__((ext_vector_type(2)));
constexpr float PEER_XS = 8.f;
constexpr size_t WS_PD = 424 * MiB;
constexpr size_t WS_WQ = 552 * MiB;
constexpr size_t WS_WSCL = 600 * MiB;
constexpr size_t WS_SSQ2 = 601 * MiB;
constexpr int PEER_SC1 = 0x7f7f7f7f;

__device__ __forceinline__ float wave_max(float v) {
#pragma unroll
    for (int o = 1; o < 64; o <<= 1) v = fmaxf(v, __shfl_xor(v, o));
    return v;
}
__device__ __forceinline__ float clamp448(float v) { return fminf(fmaxf(v, -448.f), 448.f); }
__device__ __forceinline__ void fp8_split4(float v0, float v1, float v2, float v3, unsigned& hi, unsigned& lo) {
    v0 = clamp448(v0); v1 = clamp448(v1); v2 = clamp448(v2); v3 = clamp448(v3);
    int h = __builtin_amdgcn_cvt_pk_fp8_f32(v0, v1, 0, false); h = __builtin_amdgcn_cvt_pk_fp8_f32(v2, v3, h, true);
    const auto d0 = __builtin_amdgcn_cvt_pk_f32_fp8(h, false), d1 = __builtin_amdgcn_cvt_pk_f32_fp8(h, true);
    int l = __builtin_amdgcn_cvt_pk_fp8_f32((v0 - d0[0]) * 16.f, (v1 - d0[1]) * 16.f, 0, false); l = __builtin_amdgcn_cvt_pk_fp8_f32((v2 - d1[0]) * 16.f, (v3 - d1[1]) * 16.f, l, true);
    hi = (unsigned)h; lo = (unsigned)l;
}

#define PEER_EID(E, j) (((E)[(j) >> 3][((j) >> 1) & 3] >> (16 * ((j) & 1))) & 0xffffu)
__device__ __forceinline__ void peer_udots_loop(Frame& F, const Args& args, int x, int t0, int tstep) {
    int lane_ = F.lane; asm volatile("" : "+v"(lane_)); const int lane = lane_;
    const int n = lane & 15, kb = lane >> 4, g = lane >> 3, cc = lane & 7;
    LAS unsigned char* tile = F.lds + RING_OFF + F.wave * 16384;
    LAS unsigned char* xq = F.lds + SMALL_OFF + F.wave * 512;
    const LAS unsigned char* ab = xq + (n & 1) * 256 + 16 * kb;
    const LAS unsigned char* brow = tile + n * 128;
    const int swz0 = (cc ^ ((g >> 1) & 7)) * 16, swz1 = (cc ^ ((4 + (g >> 1)) & 7)) * 16;
    const GAS unsigned char* ub = (const GAS unsigned char*)(F.ws + WS_UT2) + (size_t)x * (16384 * 128);
    if (t0 >= T) return;
    const int tlast = t0 + ((T - 1 - t0) / tstep) * tstep;
#define UD_CL(tt) ((tt) <= tlast ? (tt) : tlast)
#define UD_LOAD_E(E, tt) { const GAS v4u* ep = (const GAS v4u*)((const GAS unsigned char*)(F.ws + WS_EB16) + (size_t)(tt) * 256 + g * 32); E[0] = ep[0]; E[1] = ep[1]; }
#define UD_LOAD_X(XR, SC, tt) { XR = *(const GAS u64*)(F_WS(bf16, WS_XN) + (size_t)(tt) * D + 256 * x + 4 * lane); SC = F_WS(float, WS_RT)[tt]; }
#define UD_DMA(E) { _Pragma("unroll") for (int i = 0; i < 16; ++i) { const int k = 8 * i + g; \
        R[i] = *(const GAS v4u*)(ub + ((PEER_EID(E, i) << 7) + (unsigned)((i & 1) ? swz1 : swz0))); } }
#define UD_PUT() { _Pragma("unroll") for (int i = 0; i < 16; ++i) *(LAS v4u*)(tile + i * 1024 + lane * 16) = R[i]; }
#define UD_STEP(XR, SC, tt, E1, E3, X2, SC2) { \
      UD_PUT() \
      asm volatile("s_waitcnt lgkmcnt(0)" ::: "memory"); \
      UD_DMA(E1) \
      __builtin_amdgcn_sched_barrier(0); \
      UD_LOAD_E(E3, UD_CL((tt) + 3 * tstep)) UD_LOAD_X(X2, SC2, UD_CL((tt) + 2 * tstep)) \
      __builtin_amdgcn_sched_barrier(0); \
      v4u bu[8][2]; \
      _Pragma("unroll") for (int rg = 0; rg < 8; ++rg) { _Pragma("unroll") for (int ks = 0; ks < 2; ++ks) bu[rg][ks] = *(const LAS v4u*)(brow + rg * 2048 + (((4 * ks + kb) ^ (n >> 1)) * 16)); } \
      { const unsigned w0 = (unsigned)XR, w1 = (unsigned)(XR >> 32); unsigned hi, lo; const float sc_ = SC * PEER_XS; \
        fp8_split4(bflo(w0) * sc_, bfhi(w0) * sc_, bflo(w1) * sc_, bfhi(w1) * sc_, hi, lo); \
        ((LAS unsigned*)xq)[lane] = hi; ((LAS unsigned*)(xq + 256))[lane] = lo; } \
      asm volatile("s_waitcnt lgkmcnt(0)" ::: "memory"); \
      v8i_t ax[2]; \
      _Pragma("unroll") for (int ks = 0; ks < 2; ++ks) { const v4u p = *(const LAS v4u*)(ab + ks * 128), q = *(const LAS v4u*)(ab + ks * 128 + 64); \
          ax[ks] = (v8i_t){(int)p.x, (int)p.y, (int)p.z, (int)p.w, (int)q.x, (int)q.y, (int)q.z, (int)q.w}; } \
      asm volatile("s_waitcnt lgkmcnt(0)" ::: "memory"); \
      float res[8]; \
      _Pragma("unroll") for (int rg = 0; rg < 8; ++rg) { f32x4 c = (f32x4){0.f, 0.f, 0.f, 0.f}; \
          _Pragma("unroll") for (int ks = 0; ks < 2; ++ks) { const v8i_t b = (v8i_t){(int)bu[rg][ks].x, (int)bu[rg][ks].y, (int)bu[rg][ks].z, (int)bu[rg][ks].w, 0, 0, 0, 0}; \
              c = __builtin_amdgcn_mfma_scale_f32_16x16x128_f8f6f4(ax[ks], b, c, 0, 4, 0, PEER_SC1, 0, PEER_SC1); } \
          res[rg] = (c[0] + c[1] * 0.0625f) * (1.f / PEER_XS); } \
      { GAS v4u* pd = (GAS v4u*)(F_WS(bf16, WS_PD) + ((size_t)x * T + (tt)) * 128 + n * 8); \
        if (lane < 16) pd[0] = (v4u){pg8::cvt_pk_bf16(res[0], res[1]), pg8::cvt_pk_bf16(res[2], res[3]), pg8::cvt_pk_bf16(res[4], res[5]), pg8::cvt_pk_bf16(res[6], res[7])}; } }
    v4u eA[2], eB[2], eC[2]; u64 xrA, xrB, xrC; float scA, scB, scC; v4u R[16];
    UD_LOAD_E(eA, t0) UD_LOAD_E(eB, UD_CL(t0 + tstep)) UD_LOAD_E(eC, UD_CL(t0 + 2 * tstep))
    UD_LOAD_X(xrA, scA, t0) UD_LOAD_X(xrB, scB, UD_CL(t0 + tstep))
    xrC = xrA; scC = scA;
    UD_DMA(eA)
    __builtin_amdgcn_sched_barrier(0);
#pragma unroll 1
    for (int t = t0; t <= tlast; t += 3 * tstep) {
        UD_STEP(xrA, scA, t, eB, eA, xrC, scC)
        if (t + tstep > tlast) break;
        UD_STEP(xrB, scB, t + tstep, eC, eB, xrA, scA)
        if (t + 2 * tstep > tlast) break;
        UD_STEP(xrC, scC, t + 2 * tstep, eA, eC, xrB, scB)
    }
    asm volatile("" :: "v"(R[0]), "v"(R[15]));
#undef UD_LOAD_E
#undef UD_LOAD_X
#undef UD_DMA
#undef UD_PUT
#undef UD_STEP
}

__device__ __forceinline__ void peer_weights4(Frame& F, const Args& args, int t0, int ts) {
    int lane_ = F.lane; asm volatile("" : "+v"(lane_)); const int lane = lane_;
    float s[4][2]; int ex[4][2]; float gt[4][2];
    const int q0 = ((2 * lane) & 7) * 16 + (lane >> 2), q1 = q0 + 16;
#pragma unroll
    for (int k = 0; k < 4; ++k) { const int t = t0 + k * ts;
        float pv[2][8];
#pragma unroll
        for (int x = 0; x < 8; ++x) { const unsigned pw = ((const GAS unsigned*)(F_WS(bf16, WS_PD) + ((size_t)x * T + t) * 128))[lane]; pv[0][x] = bflo(pw); pv[1][x] = bfhi(pw); }
        { const GAS unsigned short* e16 = (const GAS unsigned short*)(F.ws + WS_EB16) + (size_t)t * 128;
          ex[k][0] = (int)e16[(q0 & 7) * 16 + (q0 >> 3)]; ex[k][1] = (int)e16[(q1 & 7) * 16 + (q1 >> 3)]; }
        gt[k][0] = F_WS(float, WS_GATE)[(size_t)t * 128 + q0]; gt[k][1] = F_WS(float, WS_GATE)[(size_t)t * 128 + q1];
        s[k][0] = ((pv[0][0] + pv[0][1]) + (pv[0][2] + pv[0][3])) + ((pv[0][4] + pv[0][5]) + (pv[0][6] + pv[0][7]));
        s[k][1] = ((pv[1][0] + pv[1][1]) + (pv[1][2] + pv[1][3])) + ((pv[1][4] + pv[1][5]) + (pv[1][6] + pv[1][7])); }
    float usc[4][2], vsc[4][2];
#pragma unroll
    for (int k = 0; k < 4; ++k)
#pragma unroll
        for (int u = 0; u < 2; ++u) { usc[k][u] = F_WS(float, WS_USC)[ex[k][u]]; vsc[k][u] = F_WS(float, WS_VSC)[ex[k][u]]; }
#pragma unroll
    for (int k = 0; k < 4; ++k) { const int t = t0 + k * ts;
        float w[2];
#pragma unroll
        for (int u = 0; u < 2; ++u) w[u] = gt[k][u] * gelu_tanh(s[k][u] * usc[k][u]) * vsc[k][u];
        const float wm = wave_max(fmaxf(fabsf(w[0]), fabsf(w[1])));
        int sb = 260 - (int)((__builtin_bit_cast(unsigned, wm) >> 23) & 0xffu);
        sb = wm > 0.f ? (sb < 1 ? 1 : (sb > 253 ? 253 : sb)) : 127;
        const float S = __builtin_bit_cast(float, (unsigned)sb << 23), Sinv = __builtin_bit_cast(float, (unsigned)(254 - sb) << 23);
#pragma unroll
        for (int u = 0; u < 2; ++u) { const float ws_ = clamp448(w[u] * S);
            const int h = __builtin_amdgcn_cvt_pk_fp8_f32(ws_, 0.f, 0, false); const float dec = __builtin_amdgcn_cvt_pk_f32_fp8(h, false)[0];
            const int l = __builtin_amdgcn_cvt_pk_fp8_f32((ws_ - dec) * 16.f, 0.f, 0, false);
            GAS unsigned char* wq = (GAS unsigned char*)(F.ws + WS_WQ) + (size_t)t * 256 + (u ? q1 : q0);
            wq[0] = (unsigned char)(h & 0xff); wq[128] = (unsigned char)(l & 0xff); }
        if (lane == 0) F_WS(float, WS_WSCL)[t] = Sinv; }
}

__device__ __forceinline__ void peer_vsum_loop(Frame& F, const Args& args, int x, int t0, int tstep) {
    int lane_ = F.lane; asm volatile("" : "+v"(lane_)); const int lane = lane_;
    const int n = lane & 15, kb = lane >> 4, g = lane >> 3, cc = lane & 7;
    LAS unsigned char* tile = F.lds + RING_OFF + F.wave * 16384;
    const LAS unsigned char* r1 = tile + (32 * kb + n) * 128;
    const int swz0 = (cc ^ ((g >> 1) & 7)) * 16, swz1 = (cc ^ ((4 + (g >> 1)) & 7)) * 16;
    const GAS unsigned char* vb = (const GAS unsigned char*)(F.ws + WS_VT2) + (size_t)x * (16384 * 128);
    if (t0 >= T) return;
    const int tlast = t0 + ((T - 1 - t0) / tstep) * tstep;
#define VS_LOAD_E(E, tt) { const GAS v4u* ep = (const GAS v4u*)((const GAS unsigned char*)(F.ws + WS_EB16) + (size_t)(tt) * 256 + g * 32); E[0] = ep[0]; E[1] = ep[1]; }
#define VS_DMA(E) { _Pragma("unroll") for (int i = 0; i < 16; ++i) { const int k = 8 * i + g; \
        R[i] = *(const GAS v4u*)(vb + ((PEER_EID(E, i) << 7) + (unsigned)((i & 1) ? swz1 : swz0))); } }
#define VS_PUT() { _Pragma("unroll") for (int i = 0; i < 16; ++i) *(LAS v4u*)(tile + i * 1024 + lane * 16) = R[i]; }
#define VS_LOAD_M(A0, A1, SI, X0, X1, tt) { const GAS unsigned char* wq = (const GAS unsigned char*)(F.ws + WS_WQ) + (size_t)(tt) * 256 + (n & 1) * 128 + 16 * kb; \
        A0 = *(const GAS v4u*)wq; A1 = *(const GAS v4u*)(wq + 64); SI = F_WS(float, WS_WSCL)[tt]; \
        const GAS v4u* xp = (const GAS v4u*)(F_WS(bf16, WS_XN) + (size_t)(tt) * D + 256 * x + 16 * n); X0 = xp[0]; X1 = xp[1]; }
#define X2PAIR(dst, src, d0) { const float a_ = bflo(src) + y[d0], b_ = bfhi(src) + y[(d0) + 1]; ss += a_ * a_ + b_ * b_; dst = pg8::cvt_pk_bf16(a_, b_); }
#define VS_STEP(A0, A1, SI, X0, X1, tt, E1, E3, NA0, NA1, NSI, NX0, NX1) { \
      VS_PUT() \
      asm volatile("s_waitcnt lgkmcnt(0)" ::: "memory"); \
      VS_DMA(E1) \
      __builtin_amdgcn_sched_barrier(0); \
      VS_LOAD_E(E3, UD_CL((tt) + 3 * tstep)) VS_LOAD_M(NA0, NA1, NSI, NX0, NX1, UD_CL((tt) + 2 * tstep)) \
      __builtin_amdgcn_sched_barrier(0); \
      v2i_t tr[16][2]; \
      _Pragma("unroll") for (int dg = 0; dg < 16; ++dg) { const int off = (((dg >> 1) ^ (n >> 1)) * 16) + (dg & 1) * 8; \
          tr[dg][0] = __builtin_amdgcn_ds_read_tr4_b64_v2i32((LAS v2i_t*)(r1 + off)); tr[dg][1] = __builtin_amdgcn_ds_read_tr4_b64_v2i32((LAS v2i_t*)(r1 + 2048 + off)); } \
      asm volatile("s_waitcnt lgkmcnt(0)" ::: "memory"); \
      const v8i_t aw = (v8i_t){(int)A0.x, (int)A0.y, (int)A0.z, (int)A0.w, (int)A1.x, (int)A1.y, (int)A1.z, (int)A1.w}; \
      float y[16]; \
      _Pragma("unroll") for (int dg = 0; dg < 16; ++dg) { const v8i_t b = (v8i_t){tr[dg][0].x, tr[dg][0].y, tr[dg][1].x, tr[dg][1].y, 0, 0, 0, 0}; \
          f32x4 c = (f32x4){0.f, 0.f, 0.f, 0.f}; \
          c = __builtin_amdgcn_mfma_scale_f32_16x16x128_f8f6f4(aw, b, c, 0, 4, 0, PEER_SC1, 0, PEER_SC1); \
          y[dg] = (c[0] + c[1] * 0.0625f) * SI; } \
      float ss = 0.f; v4u o0, o1; \
      X2PAIR(o0.x, X0.x, 0) X2PAIR(o0.y, X0.y, 2) X2PAIR(o0.z, X0.z, 4) X2PAIR(o0.w, X0.w, 6) \
      X2PAIR(o1.x, X1.x, 8) X2PAIR(o1.y, X1.y, 10) X2PAIR(o1.z, X1.z, 12) X2PAIR(o1.w, X1.w, 14) \
      ss += __shfl_xor(ss, 1); ss += __shfl_xor(ss, 2); ss += __shfl_xor(ss, 4); ss += __shfl_xor(ss, 8); \
      if (lane < 16) { GAS v4u* xo = (GAS v4u*)(F_WS(bf16, WS_XN) + (size_t)(tt) * D + 256 * x + 16 * n); xo[0] = o0; xo[1] = o1; F_WS(float, WS_SSQ2)[(size_t)x * T + (tt)] = ss; } }
    v4u R[16]; v4u eA[2], eB[2], eC[2]; v4u a0A, a1A, x0A, x1A, a0B, a1B, x0B, x1B, a0C, a1C, x0C, x1C; float siA, siB, siC;
    VS_LOAD_E(eA, t0) VS_LOAD_E(eB, UD_CL(t0 + tstep)) VS_LOAD_E(eC, UD_CL(t0 + 2 * tstep))
    VS_LOAD_M(a0A, a1A, siA, x0A, x1A, t0) VS_LOAD_M(a0B, a1B, siB, x0B, x1B, UD_CL(t0 + tstep))
    a0C = a0A; a1C = a1A; x0C = x0A; x1C = x1A; siC = siA;
    VS_DMA(eA)
    __builtin_amdgcn_sched_barrier(0);
#pragma unroll 1
    for (int t = t0; t <= tlast; t += 3 * tstep) {
        VS_STEP(a0A, a1A, siA, x0A, x1A, t, eB, eA, a0C, a1C, siC, x0C, x1C)
        if (t + tstep > tlast) break;
        VS_STEP(a0B, a1B, siB, x0B, x1B, t + tstep, eC, eB, a0A, a1A, siA, x0A, x1A)
        if (t + 2 * tstep > tlast) break;
        VS_STEP(a0C, a1C, siC, x0C, x1C, t + 2 * tstep, eA, eC, a0B, a1B, siB, x0B, x1B)
    }
    asm volatile("" :: "v"(R[0]), "v"(R[15]));
#undef VS_LOAD_E
#undef VS_DMA
#undef VS_PUT
#undef VS_LOAD_M
#undef X2PAIR
#undef VS_STEP
#undef UD_CL
}

__device__ __forceinline__ void peer_final4(Frame& F, const Args& args, int t0, int ts, float* dst) {
    int lane_ = F.lane; asm volatile("" : "+v"(lane_)); const int lane = lane_;
    v4u xr[4][4]; float ssq[4];
#pragma unroll
    for (int k = 0; k < 4; ++k) { const int t = t0 + k * ts; const GAS v4u* xp = (const GAS v4u*)(F_WS(bf16, WS_XN) + (size_t)t * D) + lane;
#pragma unroll
        for (int j = 0; j < 4; ++j) xr[k][j] = xp[64 * j];
        float sv[8];
#pragma unroll
        for (int x = 0; x < 8; ++x) sv[x] = F_WS(float, WS_SSQ2)[(size_t)x * T + t];
        ssq[k] = ((sv[0] + sv[1]) + (sv[2] + sv[3])) + ((sv[4] + sv[5]) + (sv[6] + sv[7])); }
    f32x4 ga[4], gb[4];
#pragma unroll
    for (int j = 0; j < 4; ++j) { ga[j] = *(const GAS f32x4*)(F_IN(18) + 8 * lane + 512 * j); gb[j] = *(const GAS f32x4*)(F_IN(18) + 8 * lane + 512 * j + 4); }
#pragma unroll
    for (int k = 0; k < 4; ++k) { const int t = t0 + k * ts; const float r = 1.f / sqrtf(ssq[k] * (1.f / D) + EPS); float* drow = dst + (size_t)t * D;
#pragma unroll
        for (int j = 0; j < 4; ++j) { const v4u v = xr[k][j];
            *(GAS f32x4*)(drow + 8 * lane + 512 * j) = (f32x4){bflo(v.x) * r * ga[j].x, bfhi(v.x) * r * ga[j].y, bflo(v.y) * r * ga[j].z, bfhi(v.y) * r * ga[j].w};
            *(GAS f32x4*)(drow + 8 * lane + 512 * j + 4) = (f32x4){bflo(v.z) * r * gb[j].x, bfhi(v.z) * r * gb[j].y, bflo(v.w) * r * gb[j].z, bfhi(v.w) * r * gb[j].w}; } }
}

__global__ void __launch_bounds__(NWAVES * 64, 2) mk_fwd(Args args) {
    extern __shared__ __attribute__((aligned(16))) unsigned char lds[];
    Frame F;
    F.lds = (LAS unsigned char*)lds;
    F.MISC = (volatile LAS unsigned*)(F.lds + MISC_OFF);
    F.tid = threadIdx.x; F.lane = F.tid & 63; F.wave = __builtin_amdgcn_readfirstlane(F.tid >> 6);
    F.G = gridDim.x; { const int bx = blockIdx.x; F.vcu = (F.G % 8 == 0) ? (bx % 8) * (F.G / 8) + bx / 8 : bx; }
    unsigned char* ws = args.ws;
    F.ctl = (gu32*)(ws + WS_CTL);
    F.out = args.out; F.ws = ws;
    for (int u = F.tid; u < (LDS_BYTES - LDSCTL_OFF) / 4; u += NWAVES * 64) ((LAS unsigned*)(F.lds + LDSCTL_OFF))[u] = 0u;
    __syncthreads();
    XcdBarrier bar; bar.bar = (unsigned*)(F.ctl + CW_BAR); bar.x = 0; bar.st = nullptr;
    if (N_LAUNCHES == 1) bar = xcd_barrier_post((unsigned*)(F.ctl + CW_BAR), F.MISC + 8);
#define GRID_BAR() do { if (N_LAUNCHES == 1) xcd_barrier(bar); } while (0)
    const int lo = args.ph_lo, hi = args.ph_hi;
#define IN(k) (lo <= (k) && (k) < hi)
#define BOTH(k) (IN(k) && IN((k) + 1))
    const int gw = F.vcu * NWAVES + F.wave, NGW = F.G * NWAVES;

    if (IN(0)) { REPS(0) p0_prologue(F, args); if (BOTH(0)) GRID_BAR(); }

    if (IN(1)) {
        pg8::Gemm g{F_WS(bf16, WS_XN), F_WS(bf16, WS_WIN), T, NIN, D}; pg8::TokenOrder S; S.init(T, NIN, F.G, (int)blockIdx.x, F.vcu, true);
        static_assert(WS_K - WS_Q == 64 * MiB && WS_V - WS_K == 64 * MiB && WS_U - WS_V == 64 * MiB && WS_Z - WS_U == 64 * MiB, "q|k|v|u|z regions equally spaced");
        pg8::EpiInProj E{F_WS(bf16, WS_Q), (size_t)(32 * MiB), F_WS(float, WS_ROPE), attn_body::C2};
        REPS(1) pg8::gemm_phase<pg8::EpiInProj, pg8::TokenOrder, true, true>(F.lds + RING_OFF, g, S, E);
        if (BOTH(1)) GRID_BAR();
    }

    if (IN(2)) {
        static_assert(attn_body::ATTN_LDS_BYTES <= RING_BYTES, "attention scratch fits the ring region");
        const attn_body::AttnTensors AT{(const attn_body::bf16*)F_WS(bf16, WS_Q), (const attn_body::bf16*)F_WS(bf16, WS_K), (const attn_body::bf16*)F_WS(bf16, WS_V), (attn_body::bf16*)F_WS(bf16, WS_O0), (attn_body::bf16*)F_WS(bf16, WS_O1)};
        REPS(2) for (int v = F.vcu; v < 256; v += F.G) attn_body::attn_phase<8>((char*)lds + RING_OFF, AT, v);
        if (BOTH(2)) GRID_BAR();
    }

    if (IN(3)) {
        REPS(3) for (int unit = F.vcu; unit < 256; unit += F.G) gmlp_unit(F, args, unit);
        float d1 = F_IN(3)[F.lane] * F_IN(4)[F.lane], d2 = F_IN(5)[F.lane] * F_IN(6)[F.lane];
        d1 = wave_sum(d1); d2 = wave_sum(d2);
        const float lam = __expf(d1) - __expf(d2) + LAMBDA_INIT;
        for (int t = gw; t < T; t += 2 * NGW) combine_row(F, args, t, t + NGW, lam);
        if (BOTH(3)) GRID_BAR();
    }

    if (IN(4)) {
        pg8::Gemm g{F_WS(bf16, WS_MIX), F_WS(bf16, WS_WOUT), T, D, D}; pg8::TokenOrder S; S.init(T, D, F.G, (int)blockIdx.x, F.vcu, true);
        pg8::EpiResX1 E{F_WS(float, WS_RINV), F_IN(1), F_WS(bf16, WS_XN), F_WS(float, WS_SSQ), T, D};
        REPS(4) pg8::gemm_phase<pg8::EpiResX1, pg8::TokenOrder, true, true>(F.lds + RING_OFF, g, S, E);
        if (BOTH(4)) GRID_BAR();
    }


    if (IN(6)) {
        pg8::Gemm g{F_WS(bf16, WS_WSC), F_WS(bf16, WS_XN), 2048, T, D}; pg8::TokenOrder S; S.init(2048, T, F.G, (int)blockIdx.x, F.vcu, false);
        pg8::EpiF16 E{F_WS(unsigned short, WS_SC), T};
        REPS(6) pg8::gemm_phase<pg8::EpiF16, pg8::TokenOrder, true, true>(F.lds + RING_OFF, g, S, E);
        if (BOTH(6)) GRID_BAR();
    }

    if (IN(7)) {
        if (F.wave < 4) peer_tables_rows(F, args);
        REPS(7) for (int wu = gw; wu < (T / 64) * 8; wu += NGW) topk_unit(F, args, wu);
        if (F.wave >= 4) peer_tables_rows(F, args);
        if (BOTH(7)) GRID_BAR();
    }

    if (IN(8)) {
        { const int bx = (int)blockIdx.x, nsl = (F.G % 8 == 0) ? 8 : 1, jg = bx / nsl, WPG = (F.G / nsl) * NWAVES;
          for (int x = bx % nsl; x < 8; x += nsl) peer_udots_loop(F, args, x, jg * NWAVES + F.wave, WPG);
          GRID_BAR();
          for (int t = gw; t < T; t += 4 * NGW) peer_weights4(F, args, t, NGW);
          GRID_BAR();
          for (int x = bx % nsl; x < 8; x += nsl) peer_vsum_loop(F, args, x, jg * NWAVES + F.wave, WPG);
          GRID_BAR();
          for (int t = gw; t < T; t += 4 * NGW) peer_final4(F, args, t, NGW, F.out);
        }
    }
#undef IN
#undef BOTH
}

extern "C" void kernel_launch(void* const* d_in, const int* in_sizes, int n_in, void* d_out, int out_size, void* d_ws, size_t ws_size, hipStream_t stream) {
    static int grid = 0;
    if (grid == 0) {
        if (n_in != 19 || in_sizes[0] != T * D || out_size != T * D || ws_size < WS_END) { fprintf(stderr, "kernel_launch: unexpected shapes (n_in %d, in0 %d, out %d, ws %zu); nothing launched\n", n_in, n_in > 0 ? in_sizes[0] : -1, out_size, ws_size); grid = -1; return; }
        int dev = 0, cus = 0, per_cu = 0;
        if (hipGetDevice(&dev) != hipSuccess || hipDeviceGetAttribute(&cus, hipDeviceAttributeMultiprocessorCount, dev) != hipSuccess) { fprintf(stderr, "kernel_launch: device query failed\n"); grid = -1; return; }
        if (hipFuncSetAttribute((const void*)mk_fwd, hipFuncAttributeMaxDynamicSharedMemorySize, LDS_BYTES) != hipSuccess) { fprintf(stderr, "kernel_launch: hipFuncSetAttribute failed\n"); grid = -1; return; }
        if (hipOccupancyMaxActiveBlocksPerMultiprocessor(&per_cu, (const void*)mk_fwd, NWAVES * 64, LDS_BYTES) != hipSuccess || per_cu < 1)
            fprintf(stderr, "kernel_launch: note: occupancy query reports %d workgroups per CU\n", per_cu);
        (void)hipGetLastError();
        grid = 1; while (grid * 2 <= cus && grid * 2 <= 256) grid *= 2;
    }
    if (grid < 0) return;
    if (hipMemsetAsync((char*)d_ws + WS_CTL, 0, CTL_ZERO_BYTES, stream) != hipSuccess) { fprintf(stderr, "kernel_launch: memset failed\n"); return; }
    Args a{};
    for (int i = 0; i < 19; ++i) a.in[i] = (const float*)d_in[i];
    a.out = (float*)d_out; a.ws = (unsigned char*)d_ws;
    for (int li = 0; li < N_LAUNCHES; ++li) {
        a.ph_lo = (N_LAUNCHES == 1) ? 0 : li; a.ph_hi = (N_LAUNCHES == 1) ? N_PHASES : li + 1; a.li = li; a.pad = 0;
        hipLaunchKernelGGL(mk_fwd, dim3(grid), dim3(NWAVES * 64), LDS_BYTES, stream, a);
        const hipError_t le = hipPeekAtLastError();
        if (le != hipSuccess) { fprintf(stderr, "kernel_launch: launch %d failed: %s\n", li, hipGetErrorName(le)); break; }
    }
}
```

```cpp
#include <hip/hip_runtime.h>
#include <cstdio>
#include <cstdint>
namespace pg8 {
#define PG8_LAS __attribute__((address_space(3)))
typedef unsigned short bf16_t;
typedef short bf16x8 __attribute__((ext_vector_type(8)));
typedef float f32x4 __attribute__((ext_vector_type(4)));
typedef unsigned u32x4 __attribute__((ext_vector_type(4)));
constexpr int BM = 256, BK = 64, HALF = 128, HTB = HALF * BK * 2  , STAGE_BYTES = 8 * HTB, NXCD = 8, WGM = 8;

__host__ __device__ __forceinline__ int lds_byte(int r, int c) { const int st = (r >> 4) * 2 + (c >> 5), rr = r & 15, cc = c & 31, ob = rr * 64 + cc * 2; return st * 1024 + (ob ^ (((ob >> 9) & 1) << 5)); }
__host__ __device__ __forceinline__ void stage_rc(int b, int& R, int& C) { const int st = b / 1024, sb = b % 1024, swz = sb ^ (((sb >> 9) & 1) << 5); R = (st >> 1) * 16 + swz / 64; C = (st & 1) * 32 + (swz % 64) / 2; }
__host__ __device__ __forceinline__ int perm32(int rho) { const int n = rho >> 4, i = rho & 15; return 8 * (i >> 2) + 4 * n + (i & 3); }

struct Unit { int pm, pn; };
struct Gemm { const bf16_t* A; const bf16_t* Bt; int M, N, K; };

struct StaticOrder {
    int nM, nN, nwg, G, c;
    __host__ __device__ void init(int M, int N, int G_, int c_) { nM = M / BM; nN = N / BM; nwg = nM * nN; G = G_; c = c_; }
    __host__ __device__ bool next(int i, Unit& u) const {
        const long L = (long)i * G + c; if (L >= nwg) return false;
        int wgid = (int)L; { const int q = nwg / NXCD, r = nwg % NXCD, xcd = wgid % NXCD, off = wgid / NXCD; wgid = (xcd < r ? xcd * (q + 1) : r * (q + 1) + (xcd - r) * q) + off; }
        const int nig = WGM * nN, gid = wgid / nig, fm = gid * WGM, gsz = (nM - fm) < WGM ? (nM - fm) : WGM;
        u.pm = fm + ((wgid % nig) % gsz); u.pn = (wgid % nig) / gsz; return true;
    }
    __device__ __forceinline__ void a_ready(const Unit&) const {}
    __device__ __forceinline__ void done(const Unit&) const {}
};

__device__ __forceinline__ unsigned cvt_pk_bf16(float lo, float hi) { unsigned r; asm volatile("v_cvt_pk_bf16_f32 %0, %1, %2" : "=v"(r) : "v"(lo), "v"(hi)); return r; }
typedef float f32x2 __attribute__((ext_vector_type(2)));
__device__ __forceinline__ f32x2 gelu_pk(f32x2 v) {
    const f32x2 av = __builtin_elementwise_abs(v), d = av * 0.2316418882f + 1.0f;
    f32x2 t; t.x = __builtin_amdgcn_rcpf(d.x); t.y = __builtin_amdgcn_rcpf(d.y);
    f32x2 q = t * 0.5307027145f + (-0.7265760135f); q = q * t + 0.7107068705f; q = q * t + (-0.142248368f); q = q * t + 0.127414796f; q = q * t;
    const f32x2 s = (v * v) * (-0.72134752044f);
    f32x2 e; e.x = __builtin_amdgcn_exp2f(s.x); e.y = __builtin_amdgcn_exp2f(s.y);
    const f32x2 m = v * (q * e), r = v - m;
    f32x2 o; o.x = v.x < 0.f ? m.x : r.x; o.y = v.y < 0.f ? m.y : r.y; return o;
}

template <class Epi, class Sched, bool ALIGN_EPI = false, bool SP2 = false>
__device__ __forceinline__ void gemm_phase(PG8_LAS unsigned char* lds, const Gemm g, const Sched& S, const Epi& E) {
    const int tid = threadIdx.x, wid = __builtin_amdgcn_readfirstlane(tid >> 6), lane = tid & 63, wr = wid >> 2, wc = wid & 3, fr = lane & 15, fq = lane >> 4;
    const int K = g.K, nt = K / BK;
    unsigned voffA[2], voffB[2];
#pragma unroll
    for (int i = 0; i < 2; ++i) { int R, C; stage_rc(tid * 16 + i * 8192, R, C); const int Rb = Epi::PERM ? ((R & ~31) + perm32(R & 31)) : R;
        voffA[i] = (unsigned)(R * K + C) * 2u; voffB[i] = (unsigned)(Rb * K + C) * 2u; }
    const size_t kstep = (size_t)(BK * 2);
    const size_t hstep = (size_t)HALF * K * 2;
    const size_t tstep = 2 * hstep;
    const unsigned ldsw = (unsigned)wid * 1024u;
    const int aoff = lds_byte(wr * 64 + fr, fq * 8), boff = lds_byte(wc * 32 + fr, fq * 8);
#define PG8_SA(b, h) (((b) * 2 + (h)) * HTB)
#define PG8_SB(b, h) ((4 + (b) * 2 + (h)) * HTB)
#define PG8_STAGE(bufoff, gbase, voff) do { _Pragma("unroll") for (int _i = 0; _i < 2; ++_i) \
        __builtin_amdgcn_global_load_lds((const unsigned*)((const char*)(gbase) + (voff)[_i]), (PG8_LAS unsigned*)(lds + (bufoff) + ldsw + _i * 8192), 16, 0, 0); } while (0)
#define PG8_LDA(dst, b, h) do { _Pragma("unroll") for (int m = 0; m < 4; ++m) _Pragma("unroll") for (int k = 0; k < 2; ++k) dst[m][k] = *(const PG8_LAS bf16x8*)(lds + PG8_SA(b, h) + aoff + m * 2048 + k * 1024); } while (0)
#define PG8_LDB(dst, b, h) do { _Pragma("unroll") for (int n = 0; n < 2; ++n) _Pragma("unroll") for (int k = 0; k < 2; ++k) dst[n][k] = *(const PG8_LAS bf16x8*)(lds + PG8_SB(b, h) + boff + n * 2048 + k * 1024); } while (0)
#define PG8_MMA(ai, bj, At, Bt) do { __builtin_amdgcn_s_setprio(1); _Pragma("unroll") for (int m = 0; m < 4; ++m) _Pragma("unroll") for (int n = 0; n < 2; ++n) _Pragma("unroll") for (int k = 0; k < 2; ++k) \
        acc[ai][bj][m][n] = __builtin_amdgcn_mfma_f32_16x16x32_bf16(Bt[n][k], At[m][k], acc[ai][bj][m][n], 0, 0, 0); __builtin_amdgcn_s_setprio(0); } while (0)
#define PG8_WAIT_V(n) asm volatile("s_waitcnt vmcnt(" #n ")" ::: "memory")
#define PG8_WAIT_L(n) asm volatile("s_waitcnt lgkmcnt(" #n ")" ::: "memory")
#define PG8_BAR __builtin_amdgcn_s_barrier()
#define PG8_SCHED __builtin_amdgcn_sched_barrier(0)
    Unit cur, nxt; int ui = 0;
    if (!S.next(0, cur)) return;
    f32x4 acc[2][2][4][2];
#pragma unroll
    for (int a = 0; a < 2; ++a)
#pragma unroll
        for (int b = 0; b < 2; ++b)
#pragma unroll
            for (int m = 0; m < 4; ++m)
#pragma unroll
                for (int n = 0; n < 2; ++n) acc[a][b][m][n] = (f32x4){0.f, 0.f, 0.f, 0.f};
    bf16x8 At[4][2], B0[2][2], B1[2][2];
    const char* cA = (const char*)g.A + (size_t)cur.pm * tstep; const char* cB = (const char*)g.Bt + (size_t)cur.pn * tstep;
    S.a_ready(cur);
    if constexpr (SP2) {
        PG8_STAGE(PG8_SB(0, 0), cB, voffB); PG8_STAGE(PG8_SB(0, 1), cB + hstep, voffB); PG8_STAGE(PG8_SA(0, 0), cA, voffA); PG8_STAGE(PG8_SA(0, 1), cA + hstep, voffA);
        if (wr == 1) PG8_BAR;
        PG8_WAIT_V(2); PG8_BAR;
        PG8_STAGE(PG8_SB(1, 0), cB + kstep, voffB); PG8_STAGE(PG8_SA(1, 0), cA + kstep, voffA); PG8_STAGE(PG8_SB(1, 1), cB + hstep + kstep, voffB);
        PG8_WAIT_V(6); PG8_BAR;
    } else {
        PG8_STAGE(PG8_SB(0, 0), cB, voffB); PG8_STAGE(PG8_SA(0, 0), cA, voffA); PG8_STAGE(PG8_SB(0, 1), cB + hstep, voffB); PG8_STAGE(PG8_SA(0, 1), cA + hstep, voffA);
        if (wr == 1) PG8_BAR;
        PG8_WAIT_V(4); PG8_BAR;
        PG8_STAGE(PG8_SB(1, 0), cB + kstep, voffB); PG8_STAGE(PG8_SA(1, 0), cA + kstep, voffA); PG8_STAGE(PG8_SB(1, 1), cB + hstep + kstep, voffB);
        PG8_WAIT_V(6); PG8_BAR;
    }
    for (;;) {
        const bool has_next = S.next(ui + 1, nxt);
        const char* nA = has_next ? (const char*)g.A + (size_t)nxt.pm * tstep : cA; const char* nB = has_next ? (const char*)g.Bt + (size_t)nxt.pn * tstep : cB;
        for (int t = 0; t < nt; t += 2) {
            const bool last = (t == nt - 2);
            const char* a1 = cA + (size_t)(t + 1) * kstep;
            const char* a2 = last ? nA : cA + (size_t)(t + 2) * kstep; const char* b2 = last ? nB : cB + (size_t)(t + 2) * kstep;
            const char* a3 = a2 + kstep; const char* b3 = b2 + kstep;
            if (last && has_next) S.a_ready(nxt);
            if constexpr (SP2) {
            PG8_LDB(B0, 0, 0); PG8_LDB(B1, 0, 1); PG8_SCHED; PG8_LDA(At, 0, 0); PG8_STAGE(PG8_SA(1, 1), a1 + hstep, voffA);
            PG8_WAIT_V(8); PG8_WAIT_L(0); PG8_BAR; PG8_MMA(0, 0, At, B0); PG8_MMA(0, 1, At, B1); PG8_BAR; PG8_SCHED;
            PG8_LDA(At, 0, 1); PG8_STAGE(PG8_SB(0, 0), b2, voffB); PG8_STAGE(PG8_SB(0, 1), b2 + hstep, voffB); PG8_STAGE(PG8_SA(0, 0), a2, voffA);
            PG8_WAIT_V(8); PG8_WAIT_L(0); PG8_BAR; PG8_MMA(1, 0, At, B0); PG8_MMA(1, 1, At, B1); PG8_BAR; PG8_SCHED;
            PG8_LDB(B0, 1, 0); PG8_LDB(B1, 1, 1); PG8_SCHED; PG8_LDA(At, 1, 0); PG8_STAGE(PG8_SA(0, 1), a2 + hstep, voffA);
            PG8_WAIT_V(8); PG8_WAIT_L(0); PG8_BAR; PG8_MMA(0, 0, At, B0); PG8_MMA(0, 1, At, B1); PG8_BAR; PG8_SCHED;
            PG8_LDA(At, 1, 1); PG8_STAGE(PG8_SB(1, 0), b3, voffB); PG8_STAGE(PG8_SB(1, 1), b3 + hstep, voffB); PG8_STAGE(PG8_SA(1, 0), a3, voffA);
            PG8_WAIT_V(8); PG8_WAIT_L(0); PG8_BAR; PG8_MMA(1, 0, At, B0); PG8_MMA(1, 1, At, B1); PG8_BAR; PG8_SCHED;
            } else {
            PG8_LDB(B0, 0, 0); PG8_SCHED; PG8_LDA(At, 0, 0); PG8_STAGE(PG8_SA(1, 1), a1 + hstep, voffA);
            PG8_WAIT_L(8); PG8_BAR; PG8_WAIT_L(0); PG8_MMA(0, 0, At, B0); PG8_BAR; PG8_SCHED;
            PG8_LDB(B1, 0, 1); PG8_STAGE(PG8_SB(0, 0), b2, voffB);
            PG8_BAR; PG8_WAIT_L(0); PG8_MMA(0, 1, At, B1); PG8_BAR;
            PG8_LDA(At, 0, 1); PG8_STAGE(PG8_SA(0, 0), a2, voffA);
            PG8_BAR; PG8_WAIT_L(0); PG8_MMA(1, 0, At, B0); PG8_BAR; PG8_SCHED;
            PG8_STAGE(PG8_SB(0, 1), b2 + hstep, voffB);
            PG8_WAIT_V(6); PG8_BAR; PG8_MMA(1, 1, At, B1); PG8_BAR;
            PG8_LDB(B0, 1, 0); PG8_SCHED; PG8_LDA(At, 1, 0); PG8_STAGE(PG8_SA(0, 1), a2 + hstep, voffA);
            PG8_WAIT_L(8); PG8_BAR; PG8_WAIT_L(0); PG8_MMA(0, 0, At, B0); PG8_BAR; PG8_SCHED;
            PG8_LDB(B1, 1, 1); PG8_STAGE(PG8_SB(1, 0), b3, voffB);
            PG8_BAR; PG8_WAIT_L(0); PG8_MMA(0, 1, At, B1); PG8_BAR;
            PG8_LDA(At, 1, 1); PG8_STAGE(PG8_SA(1, 0), a3, voffA);
            PG8_BAR; PG8_WAIT_L(0); PG8_MMA(1, 0, At, B0); PG8_BAR; PG8_SCHED;
            PG8_STAGE(PG8_SB(1, 1), b3 + hstep, voffB);
            PG8_WAIT_V(6); PG8_BAR; PG8_MMA(1, 1, At, B1); PG8_BAR;
            }
        }
        if constexpr (ALIGN_EPI) { if (wr == 0) PG8_BAR; }
        if constexpr (!Epi::AFTER_DRAIN) { E(acc, cur, wr, wc, fr, fq); S.done(cur); }
        if (!has_next) break;
#pragma unroll
        for (int a = 0; a < 2; ++a)
#pragma unroll
            for (int b = 0; b < 2; ++b)
#pragma unroll
                for (int m = 0; m < 4; ++m)
#pragma unroll
                    for (int n = 0; n < 2; ++n) acc[a][b][m][n] = (f32x4){0.f, 0.f, 0.f, 0.f};
        cur = nxt; cA = nA; cB = nB; ++ui;
        if constexpr (ALIGN_EPI) { if (wr == 1) PG8_BAR; }
    }
    PG8_WAIT_V(0);
    if constexpr (!ALIGN_EPI) { if (wr == 0) PG8_BAR; }
    PG8_BAR;
    if constexpr (Epi::AFTER_DRAIN) { E.fused(acc, cur, wr, wc, fr, fq, lds, wid, lane); S.done(cur); }
#undef PG8_SA
#undef PG8_SB
#undef PG8_STAGE
#undef PG8_LDA
#undef PG8_LDB
#undef PG8_MMA
#undef PG8_WAIT_V
#undef PG8_WAIT_L
#undef PG8_BAR
#undef PG8_SCHED
}
}
namespace pg8 {
__device__ __forceinline__ float gelu_tanh(float x) {
    const float y2 = x * (1.5957691216057308f + 0.07135481627613502f * x * x);
    const float e = __builtin_amdgcn_exp2f(-1.4426950408889634f * y2);
    return x * __builtin_amdgcn_rcpf(1.0f + e);
}
struct EpiInProj {
    static constexpr bool PERM = true, AFTER_DRAIN = false;
    bf16_t* Oq; size_t region_stride; const float* rope; float qscale;
    __device__ __forceinline__ void operator()(const f32x4 (&acc)[2][2][4][2], const Unit& u, int wr, int wc, int fr, int fq) const {
        const int region = u.pn >> 2;
        bf16_t* base = Oq + (size_t)region * region_stride;
        const int row0 = u.pm * BM + wr * 64 + fr, col0 = (u.pn & 3) * 256 + wc * 32 + 8 * fq;
        const bool do_rope = (region < 2) && ((wc & 1) == 0) && (fq < 2);
        const bool do_gelu = (region >= 3);
        const float sc = (region == 0) ? qscale : 1.f;
#pragma unroll
        for (int ai = 0; ai < 2; ++ai)
#pragma unroll
            for (int m = 0; m < 4; ++m) { const int row = row0 + ai * HALF + m * 16; bf16_t* rowp = base + (size_t)row * 1024 + col0;
                f32x4 cs0 = (f32x4){1.f, 0.f, 1.f, 0.f}, cs1 = (f32x4){1.f, 0.f, 1.f, 0.f};
                if (do_rope) { const float* rp = rope + ((size_t)(row & 16383) * 8 + 4 * fq) * 2; cs0 = *(const f32x4*)rp; cs1 = *(const f32x4*)(rp + 4); }
#pragma unroll
                for (int bj = 0; bj < 2; ++bj) { f32x4 v0 = acc[ai][bj][m][0], v1 = acc[ai][bj][m][1];
                    if (do_rope) {
                        f32x4 r0, r1;
                        r0[0] = v0[0] * cs0[0] - v0[1] * cs0[1]; r0[1] = v0[1] * cs0[0] + v0[0] * cs0[1];
                        r0[2] = v0[2] * cs0[2] - v0[3] * cs0[3]; r0[3] = v0[3] * cs0[2] + v0[2] * cs0[3];
                        r1[0] = v1[0] * cs1[0] - v1[1] * cs1[1]; r1[1] = v1[1] * cs1[0] + v1[0] * cs1[1];
                        r1[2] = v1[2] * cs1[2] - v1[3] * cs1[3]; r1[3] = v1[3] * cs1[2] + v1[2] * cs1[3];
                        v0 = r0; v1 = r1; }
                    if (do_gelu) {
#pragma unroll
                        for (int e = 0; e < 4; ++e) { v0[e] = gelu_tanh(v0[e]); v1[e] = gelu_tanh(v1[e]); } }
                    v0 = v0 * sc; v1 = v1 * sc; u32x4 w; w.x = cvt_pk_bf16(v0[0], v0[1]); w.y = cvt_pk_bf16(v0[2], v0[3]); w.z = cvt_pk_bf16(v1[0], v1[1]); w.w = cvt_pk_bf16(v1[2], v1[3]);
                    *(u32x4*)(rowp + bj * HALF) = w; } }
    }
};
struct EpiF16 {
    static constexpr bool PERM = true, AFTER_DRAIN = false;
    unsigned short* C; int ldc;
    __device__ __forceinline__ void operator()(const f32x4 (&acc)[2][2][4][2], const Unit& u, int wr, int wc, int fr, int fq) const {
        typedef _Float16 h2 __attribute__((ext_vector_type(2)));
        const int row0 = u.pm * BM + wr * 64 + fr, col0 = u.pn * BM + wc * 32 + 8 * fq;
#pragma unroll
        for (int ai = 0; ai < 2; ++ai)
#pragma unroll
            for (int m = 0; m < 4; ++m) { unsigned short* rowp = C + (size_t)(row0 + ai * HALF + m * 16) * ldc + col0;
#pragma unroll
                for (int bj = 0; bj < 2; ++bj) { f32x4 v0 = acc[ai][bj][m][0], v1 = acc[ai][bj][m][1]; u32x4 w;
#pragma unroll
                    for (int e = 0; e < 4; ++e) { v0[e] = fminf(fmaxf(v0[e], -65504.f), 65504.f); v1[e] = fminf(fmaxf(v1[e], -65504.f), 65504.f); }
                    w.x = __builtin_bit_cast(unsigned, (h2){(_Float16)v0[0], (_Float16)v0[1]}); w.y = __builtin_bit_cast(unsigned, (h2){(_Float16)v0[2], (_Float16)v0[3]});
                    w.z = __builtin_bit_cast(unsigned, (h2){(_Float16)v1[0], (_Float16)v1[1]}); w.w = __builtin_bit_cast(unsigned, (h2){(_Float16)v1[2], (_Float16)v1[3]});
                    *(u32x4*)(rowp + bj * HALF) = w; } }
    }
};
struct EpiF32Res {
    static constexpr bool PERM = false, AFTER_DRAIN = false;
    float* C; int ldc; const float* R;
    __device__ __forceinline__ void operator()(const f32x4 (&acc)[2][2][4][2], const Unit& u, int wr, int wc, int fr, int fq) const {
        const int row0 = u.pm * BM + wr * 64 + fr, col0 = u.pn * BM + wc * 32 + 4 * fq;
#pragma unroll
        for (int ai = 0; ai < 2; ++ai)
#pragma unroll
            for (int m = 0; m < 4; ++m) { const size_t off = (size_t)(row0 + ai * HALF + m * 16) * ldc + col0;
#pragma unroll
                for (int bj = 0; bj < 2; ++bj)
#pragma unroll
                    for (int n = 0; n < 2; ++n) { f32x4 v = acc[ai][bj][m][n]; if (R) v = v + *(const f32x4*)(R + off + bj * HALF + n * 16); *(f32x4*)(C + off + bj * HALF + n * 16) = v; } }
    }
};
struct EpiResX1 {
    static constexpr bool PERM = true, AFTER_DRAIN = false;
    const float* rinv; const float* gain; bf16_t* XB; float* SSQ; int nrows; int ldc;
    __device__ __forceinline__ void operator()(const f32x4 (&acc)[2][2][4][2], const Unit& u, int wr, int wc, int fr, int fq) const {
        const int row0 = u.pm * BM + wr * 64 + fr, col0 = u.pn * BM + wc * 32 + 8 * fq;
        f32x4 gi[2][2];
#pragma unroll
        for (int bj = 0; bj < 2; ++bj)
#pragma unroll
            for (int n = 0; n < 2; ++n) { const f32x4 gg = *(const f32x4*)(gain + col0 + bj * HALF + 4 * n);
                gi[bj][n] = (f32x4){__builtin_amdgcn_rcpf(gg[0]), __builtin_amdgcn_rcpf(gg[1]), __builtin_amdgcn_rcpf(gg[2]), __builtin_amdgcn_rcpf(gg[3])}; }
#pragma unroll
        for (int ai = 0; ai < 2; ++ai)
#pragma unroll
            for (int m = 0; m < 4; ++m) { const int row = row0 + ai * HALF + m * 16; const size_t off = (size_t)row * ldc + col0; float ss = 0.f; const float ri = rinv[row];
#pragma unroll
                for (int bj = 0; bj < 2; ++bj) { const u32x4 xb = *(const u32x4*)(XB + off + bj * HALF);
                    const f32x4 x0 = (f32x4){__builtin_bit_cast(float, xb.x << 16), __builtin_bit_cast(float, xb.x & 0xffff0000u), __builtin_bit_cast(float, xb.y << 16), __builtin_bit_cast(float, xb.y & 0xffff0000u)};
                    const f32x4 x1 = (f32x4){__builtin_bit_cast(float, xb.z << 16), __builtin_bit_cast(float, xb.z & 0xffff0000u), __builtin_bit_cast(float, xb.w << 16), __builtin_bit_cast(float, xb.w & 0xffff0000u)};
                    const f32x4 v0 = acc[ai][bj][m][0] + x0 * gi[bj][0] * ri, v1 = acc[ai][bj][m][1] + x1 * gi[bj][1] * ri;
                    ss += ((v0[0] * v0[0] + v0[1] * v0[1]) + (v0[2] * v0[2] + v0[3] * v0[3])) + ((v1[0] * v1[0] + v1[1] * v1[1]) + (v1[2] * v1[2] + v1[3] * v1[3]));
                    u32x4 w; w.x = cvt_pk_bf16(v0[0], v0[1]); w.y = cvt_pk_bf16(v0[2], v0[3]); w.z = cvt_pk_bf16(v1[0], v1[1]); w.w = cvt_pk_bf16(v1[2], v1[3]);
                    *(u32x4*)(XB + off + bj * HALF) = w; }
                ss += __shfl_xor(ss, 16); ss += __shfl_xor(ss, 32);
                if (fq == 0) SSQ[(size_t)(u.pn * 4 + wc) * nrows + row] = ss; }
    }
};
struct TokenOrder {
    StaticOrder so; int vcu, nsteps; bool tokM, fixed;
    __device__ void init(int M, int N, int G_, int c_, int vcu_, bool tokM_) { so.init(M, N, G_, c_); vcu = vcu_; tokM = tokM_; const int ntok = (tokM_ ? M : N) / BM, noth = (tokM_ ? N : M) / BM;
        fixed = (G_ == 256 && ntok == 128 && (noth % 2) == 0); nsteps = noth / 2; }
    __device__ bool next(int i, Unit& u) const {
        if (!fixed) return so.next(i, u);
        if (i >= nsteps) return false;
        const int tok = vcu >> 1, oth = (vcu & 1) * nsteps + i; u.pm = tokM ? tok : oth; u.pn = tokM ? oth : tok; return true; }
    __device__ __forceinline__ void a_ready(const Unit&) const {}
    __device__ __forceinline__ void done(const Unit&) const {}
};
}
#include <hip/hip_bf16.h>
#include <cmath>
namespace attn_body {
using bf16=__hip_bfloat16;
using bf16x8=__attribute__((ext_vector_type(8)))short;
using s16x4=__attribute__((ext_vector_type(4)))short;
using f32x16=__attribute__((ext_vector_type(16)))float;
using u32x4=__attribute__((ext_vector_type(4)))unsigned;
constexpr int BATCH=2,NHEAD=16,SEQ=16384,D=64,DM=NHEAD*D;
constexpr int NW=8,QBLK=32,QB=QBLK*NW,KVBLK=64,NQB=SEQ/QB;
constexpr int ATTN_PITCH=DM, ATTN_UNIT_ROWS=QB;
__device__ __forceinline__ int crow(int r,int hi){return (r&3)+8*(r>>2)+4*hi;}
#define SBAR() __builtin_amdgcn_sched_barrier(0)
__device__ __forceinline__ void cmask(f32x16&p0,f32x16&p1,int jb,int qrel,int hi){
  const float NEG=-INFINITY; (void)hi;
  if(jb>(qrel>>6)){
  #pragma unroll
  for(int r=0;r<16;++r){p0[r]=NEG;p1[r]=NEG;} }
}

constexpr int NSLOT=3, SLOTB=8192;
constexpr int VSLOTB=2*SLOTB;
constexpr int LDS_K=0, LDS_V=NSLOT*SLOTB, LDS_WS=LDS_V+NSLOT*VSLOTB, LDS_OST=LDS_WS+NW*64*4, LDS_BYTES=LDS_OST+NW*4096;
constexpr float C2=0.125f*1.4426950408889634f;
__device__ __forceinline__ void glds16(const void*gsrc,unsigned lds_dst){unsigned keep;
  asm volatile("s_mov_b32 %0, m0\n\ts_mov_b32 m0, %2\n\ts_nop 0\n\tglobal_load_lds_dwordx4 %1, off\n\ts_mov_b32 m0, %0":"=&s"(keep):"v"(gsrc),"s"(lds_dst):"memory");}
__device__ __forceinline__ float max3f(float a,float b,float c){float r;asm("v_max3_f32 %0, %1, %2, %3":"=v"(r):"v"(a),"v"(b),"v"(c));return r;}
__device__ __forceinline__ float max2f(float a,float b){float r;asm("v_max_f32_e32 %0, %1, %2":"=v"(r):"v"(a),"v"(b));return r;}
__device__ __forceinline__ float fadd_s(float a,float b){float r;asm("v_add_f32_e32 %0, %1, %2":"=v"(r):"v"(a),"v"(b));return r;}
__device__ __forceinline__ float fsub_s(float a,float b){float r;asm("v_sub_f32_e32 %0, %1, %2":"=v"(r):"v"(a),"v"(b));return r;}
typedef float f32x2_t __attribute__((ext_vector_type(2))); typedef __bf16 bf16x2_t __attribute__((ext_vector_type(2)));
__device__ __forceinline__ unsigned cvtpk_s(float lo,float hi){f32x2_t v={lo,hi};bf16x2_t b=__builtin_convertvector(v,bf16x2_t);return __builtin_bit_cast(unsigned,b);}
#define WAIT_BAR(N) asm volatile("s_waitcnt vmcnt(" #N ") lgkmcnt(0)\n\ts_barrier":::"memory")

__device__ __forceinline__ void qkt(f32x16&p0,f32x16&p1,const char*Kslot,const bf16x8*qr,int r32,int hi){
  const char*kb=Kslot+hi*1024+r32*16;
  #pragma unroll
  for(int d0=0;d0<4;++d0){
    const bf16x8 b0=*reinterpret_cast<const bf16x8*>(kb+d0*2048);
    const bf16x8 b1=*reinterpret_cast<const bf16x8*>(kb+d0*2048+512);
    if(d0==0){p0=__builtin_amdgcn_mfma_f32_32x32x16_bf16(b0,qr[0],f32x16{},0,0,0);p1=__builtin_amdgcn_mfma_f32_32x32x16_bf16(b1,qr[0],f32x16{},0,0,0);}
    else{p0=__builtin_amdgcn_mfma_f32_32x32x16_bf16(b0,qr[d0],p0,0,0,0);p1=__builtin_amdgcn_mfma_f32_32x32x16_bf16(b1,qr[d0],p1,0,0,0);}}
}
typedef __attribute__((address_space(3))) const char* lds_cptr;
typedef short v4i16_t __attribute__((ext_vector_type(4)));
__device__ __forceinline__ void kload8(bf16x8*kf,lds_cptr kp){
  kf[0]=*(const __attribute__((address_space(3))) bf16x8*)(kp);      kf[1]=*(const __attribute__((address_space(3))) bf16x8*)(kp+512);
  kf[2]=*(const __attribute__((address_space(3))) bf16x8*)(kp+2048); kf[3]=*(const __attribute__((address_space(3))) bf16x8*)(kp+2560);
  kf[4]=*(const __attribute__((address_space(3))) bf16x8*)(kp+4096); kf[5]=*(const __attribute__((address_space(3))) bf16x8*)(kp+4608);
  kf[6]=*(const __attribute__((address_space(3))) bf16x8*)(kp+6144); kf[7]=*(const __attribute__((address_space(3))) bf16x8*)(kp+6656);
}
__device__ __forceinline__ void kload2(bf16x8*kf,lds_cptr kp,int j){ kf[2*j]=*(const __attribute__((address_space(3))) bf16x8*)(kp+j*2048); kf[2*j+1]=*(const __attribute__((address_space(3))) bf16x8*)(kp+j*2048+512); }
__device__ __forceinline__ s16x4 vtr(lds_cptr p){ return __builtin_bit_cast(s16x4,__builtin_amdgcn_ds_read_tr16_b64_v4i16((__attribute__((address_space(3))) v4i16_t*)p)); }
__device__ __forceinline__ float rowmax(const f32x16&p0,const f32x16&p1){
  float a=max3f(p0[0],p0[1],p1[0]),b=max3f(p0[2],p0[3],p1[1]);a=max3f(a,p1[2],p1[3]);
  #pragma unroll
  for(int r=4;r<16;r+=4){a=max3f(a,p0[r],p0[r+1]);b=max3f(b,p0[r+2],p0[r+3]);a=max3f(a,p1[r],p1[r+1]);b=max3f(b,p1[r+2],p1[r+3]);}
  const float m=max2f(a,b);
  auto rr=__builtin_amdgcn_permlane32_swap(__float_as_uint(m),__float_as_uint(m),false,false);
  return max2f(__uint_as_float(rr[0]),__uint_as_float(rr[1]));
}
__device__ __forceinline__ void pv(f32x16*o,int vb,bf16x8 pa0,bf16x8 pa1,bf16x8 pa2,bf16x8 pa3){
  #pragma unroll
  for(int d0=0;d0<4;++d0){s16x4 lo[4],hi[4];
    #pragma unroll
    for(int ks=0;ks<4;++ks){
      asm volatile("ds_read_b64_tr_b16 %0,%1 offset:%c2":"=&v"(lo[ks]):"v"(vb),"i"(d0*4096+ks*1024):"memory");
      asm volatile("ds_read_b64_tr_b16 %0,%1 offset:%c2":"=&v"(hi[ks]):"v"(vb),"i"(d0*4096+ks*1024+512):"memory");}
    asm volatile("s_waitcnt lgkmcnt(0)":::"memory");SBAR();
    #define PK(k) (bf16x8){lo[k][0],lo[k][1],lo[k][2],lo[k][3],hi[k][0],hi[k][1],hi[k][2],hi[k][3]}
    o[d0]=__builtin_amdgcn_mfma_f32_32x32x16_bf16(pa0,PK(0),o[d0],0,0,0);
    o[d0]=__builtin_amdgcn_mfma_f32_32x32x16_bf16(pa1,PK(1),o[d0],0,0,0);
    o[d0]=__builtin_amdgcn_mfma_f32_32x32x16_bf16(pa2,PK(2),o[d0],0,0,0);
    o[d0]=__builtin_amdgcn_mfma_f32_32x32x16_bf16(pa3,PK(3),o[d0],0,0,0);
    #undef PK
  }
}

#ifndef ATTN_STORE16
#define ATTN_STORE16(p,v) (*(u32x4*)(p)=(v))
#endif
template<int THRL> __device__ __forceinline__ void attn_unit(int b,int hq,int hv,int qb,const bf16*Q,const bf16*__restrict__ K,const bf16*__restrict__ V,bf16*O,char*shm){
  int tid_=threadIdx.x; asm volatile("":"+v"(tid_));
  const int tid=tid_,lane=tid&63,r32=lane&31,hi=lane>>5; const int wid=__builtin_amdgcn_readfirstlane(tid>>6);
  const long rowbase=(long)b*SEQ; const int q0=qb*QB;
  const bf16*Qw=Q+(rowbase+q0+wid*QBLK)*DM+hq*D;
  const bf16*Kh=K+rowbase*DM+hq*D,*Vh=V+rowbase*DM+hv*2*D;
  const unsigned lds0=(unsigned)(uintptr_t)shm;
  float*wsf=(float*)(shm+LDS_WS)+wid*64;
  const bf16*ksrc=Kh+(long)lane*DM+wid*8;
  const bf16*vsrc=Vh+(long)(16*(wid&3)+(lane>>2))*DM+(wid>>2)*32+(lane&3)*8;
  const unsigned kdst=lds0+LDS_K+wid*1024, vdst=lds0+LDS_V+wid*1024;
  #define DMA_K(t,slot) glds16(ksrc+(long)(t)*KVBLK*DM,(unsigned)__builtin_amdgcn_readfirstlane(kdst+(slot)))
  #define DMA_V(t,slot) do{ glds16(vsrc+(long)(t)*KVBLK*DM,(unsigned)__builtin_amdgcn_readfirstlane(vdst+2*(slot))); glds16(vsrc+(long)(t)*KVBLK*DM+64,(unsigned)__builtin_amdgcn_readfirstlane(vdst+2*(slot)+8192)); }while(0)
  const int vb0=(int)(lds0+LDS_V)+((lane>>4)&1)*32+(lane&3)*8+(4*hi+((lane&15)>>2))*64;
  const char*Kbase=shm+LDS_K; bf16x8 kf[8];
  const lds_cptr shm3=(lds_cptr)shm; const lds_cptr kp0=shm3+LDS_K+hi*1024+r32*16; const lds_cptr vp0=shm3+LDS_V+((lane>>4)&1)*32+(lane&3)*8+(4*hi+((lane&15)>>2))*64;
  const int NT=(q0+QB)/KVBLK;
  DMA_K(0,0);DMA_V(0,0);DMA_K(1,SLOTB);
  bf16x8 qr[4];
  #pragma unroll
  for(int d0=0;d0<4;++d0)qr[d0]=*reinterpret_cast<const bf16x8*>(&Qw[(long)r32*DM+d0*16+hi*8]);
  float mhat=0.f,l_reg=0.f;f32x16 o[4];o[0]=f32x16{};o[1]=f32x16{};o[2]=f32x16{};o[3]=f32x16{};
  const int qrel=wid*QBLK+r32;
  #define CMASK(P0,P1,t) do{int jb_=(t)-(NT-4); if(jb_>=0)cmask(P0,P1,jb_,qrel,hi);}while(0)
  bool resc=false;
  #define START(P0,P1) do{ const float rm=rowmax(P0,P1); resc=false; \
    { const float dl=rm; mhat=fadd_s(mhat,dl); \
      _Pragma("unroll") for(int r=0;r<16;++r){P0[r]=fsub_s(P0[r],dl);P1[r]=fsub_s(P1[r],dl);} } \
    _Pragma("unroll") for(int r=0;r<16;++r)P0[r]=__builtin_amdgcn_exp2f(P0[r]); }while(0)
  #define RESC() do{ if(resc){ asm volatile("s_waitcnt lgkmcnt(0)":::"memory"); \
      _Pragma("unroll") for(int d_=0;d_<4;++d_) _Pragma("unroll") for(int r=0;r<16;++r)o[d_][r]*=wsf[crow(r,hi)]; } }while(0)
  f32x16 pA0,pA1,pB0,pB1;
  int sl_prev=0,sl_cur=0,sl_next=SLOTB;
  #define ROT() do{sl_prev=sl_cur;sl_cur=sl_next;sl_next=(sl_next==(NSLOT-1)*SLOTB)?0:sl_next+SLOTB;}while(0)
  DMA_K(2,2*SLOTB);
  WAIT_BAR(4);
  qkt(pA0,pA1,Kbase,qr,r32,hi);asm volatile("s_nop 15\n\ts_nop 7":"+v"(pA0),"+v"(pA1));CMASK(pA0,pA1,0);
  START(pA0,pA1);
  _Pragma("unroll") for(int r=0;r<16;++r)pA1[r]=__builtin_amdgcn_exp2f(pA1[r]);
  WAIT_BAR(0);
  DMA_K(3,0);DMA_V(1,SLOTB);
  ROT();
  kload8(kf,kp0+sl_cur);
  WAIT_BAR(3);
  s16x4 vlo[8],vhi[8]; u32x4 pw0,pw1,pw2,pw3;
  #define PKW(P,B) cvtpk_s(P[B],P[B+1])
  #define PAF(k) __builtin_bit_cast(bf16x8,pw##k)
  #define VFR(i) (bf16x8){vlo[i][0],vlo[i][1],vlo[i][2],vlo[i][3],vhi[i][0],vhi[i][1],vhi[i][2],vhi[i][3]}
  #define PIN(x) asm volatile("":"+v"(x))
  #define MX3(a,b,c) __builtin_fmaxf(__builtin_fmaxf((a),(b)),(c))
  #define GAPA(MF,A0,A1,A2,A3,W0,W1,PW) do{ MF; sacc+=A0; sacc+=A1; sacc+=A2; sacc+=A3; PIN(sacc); W0; W1; PIN(PW); SBAR(); }while(0)
  #define EX(v) __builtin_amdgcn_exp2f(v)
  #define GAPB(MF,X,B) do{ MF; X[B]=EX(X[B]); X[B+1]=EX(X[B+1]); X[B+2]=EX(X[B+2]); X[B+3]=EX(X[B+3]); PIN(X); SBAR(); }while(0)
  #define VRD(i) do{ vlo[i]=vtr(vp_+(((i)>>2)*4096+((i)&3)*1024)); vhi[i]=vtr(vp_+(((i)>>2)*4096+((i)&3)*1024+512)); }while(0)
  #define VRD2(i) do{ vlo[i]=vtr(vp_+(8192+((i)>>2)*4096+((i)&3)*1024)); vhi[i]=vtr(vp_+(8192+((i)>>2)*4096+((i)&3)*1024+512)); SBAR(); }while(0)
  #define GAPB2(MF,X,B) do{ MF; X[B]=EX(X[B]-mhat); X[B+1]=EX(X[B+1]-mhat); PIN(X); SBAR(); }while(0)
  #define KRD(G,j) do{ if(G){ kload2(kf,kp0+sl_next,j); SBAR(); } }while(0)
  #define STEP(C0,C1,P0,P1,t,GK,GV,GL) do{ SBAR(); \
    const lds_cptr vp_=vp0+2*sl_prev; \
    VRD(0); SBAR(); float sacc=(P0[0]+P0[1]); \
    GAPA(C0=__builtin_amdgcn_mfma_f32_32x32x16_bf16(kf[0],qr[0],f32x16{},0,0,0), P0[2],P0[3],P0[4],P0[5],     pw0[0]=PKW(P0,0), pw0[1]=PKW(P0,2), pw0); \
    VRD(4); SBAR(); GAPA(C1=__builtin_amdgcn_mfma_f32_32x32x16_bf16(kf[1],qr[0],f32x16{},0,0,0), P0[6],P0[7],P0[8],P0[9],     pw0[2]=PKW(P0,4), pw0[3]=PKW(P0,6), pw0); \
    VRD(1); SBAR(); GAPA(C0=__builtin_amdgcn_mfma_f32_32x32x16_bf16(kf[2],qr[1],C0,0,0,0),   P0[10],P0[11],P0[12],P0[13], pw1[0]=PKW(P0,8), pw1[1]=PKW(P0,10), pw1); \
    VRD(5); SBAR(); GAPA(C1=__builtin_amdgcn_mfma_f32_32x32x16_bf16(kf[3],qr[1],C1,0,0,0),   P0[14],P0[15],P1[0],P1[1],   pw1[2]=PKW(P0,12),pw1[3]=PKW(P0,14), pw1); \
    VRD(2); SBAR(); GAPA(C0=__builtin_amdgcn_mfma_f32_32x32x16_bf16(kf[4],qr[2],C0,0,0,0),   P1[2],P1[3],P1[4],P1[5],     pw2[0]=PKW(P1,0), pw2[1]=PKW(P1,2), pw2); \
    VRD(6); SBAR(); GAPA(C1=__builtin_amdgcn_mfma_f32_32x32x16_bf16(kf[5],qr[2],C1,0,0,0),   P1[6],P1[7],P1[8],P1[9],     pw2[2]=PKW(P1,4), pw2[3]=PKW(P1,6), pw2); \
    VRD(3); SBAR(); GAPA(C0=__builtin_amdgcn_mfma_f32_32x32x16_bf16(kf[6],qr[3],C0,0,0,0),   P1[10],P1[11],P1[12],P1[13], pw3[0]=PKW(P1,8), pw3[1]=PKW(P1,10), pw3); \
    VRD(7); SBAR(); GAPA(C1=__builtin_amdgcn_mfma_f32_32x32x16_bf16(kf[7],qr[3],C1,0,0,0),   P1[14],P1[15],0.f,0.f,       pw3[2]=PKW(P1,12),pw3[3]=PKW(P1,14), pw3); \
    l_reg+=sacc; \
    if(GK){DMA_K((t)+3,sl_cur);} if(GV){DMA_V((t)+1,sl_next);} \
    CMASK(C0,C1,t); \
    { float a=MX3(C0[0],C0[1],C1[0]),b=MX3(C0[2],C0[3],C1[1]); a=MX3(a,C1[2],C1[3]); \
      _Pragma("unroll") for(int r=4;r<16;r+=4){a=MX3(a,C0[r],C0[r+1]);b=MX3(b,C0[r+2],C0[r+3]);a=MX3(a,C1[r],C1[r+1]);b=MX3(b,C1[r+2],C1[r+3]);} \
      float rm=__builtin_fmaxf(a,b); { auto rr=__builtin_amdgcn_permlane32_swap(__float_as_uint(rm),__float_as_uint(rm),false,false); rm=__builtin_fmaxf(__uint_as_float(rr[0]),__uint_as_float(rr[1])); } \
      resc=false; \
      rm-=mhat;     \
      if(__builtin_expect(__any(rm>(float)THRL),0)){ const float dl=__builtin_fmaxf(rm,0.f); mhat+=dl; \
        const float f=__builtin_amdgcn_exp2f(-dl); l_reg*=f; if(hi==0)wsf[r32]=f; resc=true; } } \
    SBAR(); \
    GAPB2(o[0]=__builtin_amdgcn_mfma_f32_32x32x16_bf16(PAF(0),VFR(0),o[0],0,0,0), C0,0); VRD2(0); \
    GAPB2(o[1]=__builtin_amdgcn_mfma_f32_32x32x16_bf16(PAF(0),VFR(4),o[1],0,0,0), C0,2); VRD2(4); \
    KRD(GL,0); GAPB2(o[0]=__builtin_amdgcn_mfma_f32_32x32x16_bf16(PAF(1),VFR(1),o[0],0,0,0), C0,4); VRD2(1); \
    KRD(GL,1); GAPB2(o[1]=__builtin_amdgcn_mfma_f32_32x32x16_bf16(PAF(1),VFR(5),o[1],0,0,0), C0,6); VRD2(5); \
    KRD(GL,2); GAPB2(o[0]=__builtin_amdgcn_mfma_f32_32x32x16_bf16(PAF(2),VFR(2),o[0],0,0,0), C0,8); VRD2(2); \
    KRD(GL,3); GAPB2(o[1]=__builtin_amdgcn_mfma_f32_32x32x16_bf16(PAF(2),VFR(6),o[1],0,0,0), C0,10); VRD2(6); \
    GAPB2(o[0]=__builtin_amdgcn_mfma_f32_32x32x16_bf16(PAF(3),VFR(3),o[0],0,0,0), C0,12); VRD2(3); \
    GAPB2(o[1]=__builtin_amdgcn_mfma_f32_32x32x16_bf16(PAF(3),VFR(7),o[1],0,0,0), C0,14); VRD2(7); \
    GAPB2(o[2]=__builtin_amdgcn_mfma_f32_32x32x16_bf16(PAF(0),VFR(0),o[2],0,0,0), C1,0); \
    GAPB2(o[3]=__builtin_amdgcn_mfma_f32_32x32x16_bf16(PAF(0),VFR(4),o[3],0,0,0), C1,2); \
    GAPB2(o[2]=__builtin_amdgcn_mfma_f32_32x32x16_bf16(PAF(1),VFR(1),o[2],0,0,0), C1,4); \
    GAPB2(o[3]=__builtin_amdgcn_mfma_f32_32x32x16_bf16(PAF(1),VFR(5),o[3],0,0,0), C1,6); \
    GAPB2(o[2]=__builtin_amdgcn_mfma_f32_32x32x16_bf16(PAF(2),VFR(2),o[2],0,0,0), C1,8); \
    GAPB2(o[3]=__builtin_amdgcn_mfma_f32_32x32x16_bf16(PAF(2),VFR(6),o[3],0,0,0), C1,10); \
    GAPB2(o[2]=__builtin_amdgcn_mfma_f32_32x32x16_bf16(PAF(3),VFR(3),o[2],0,0,0), C1,12); \
    GAPB2(o[3]=__builtin_amdgcn_mfma_f32_32x32x16_bf16(PAF(3),VFR(7),o[3],0,0,0), C1,14); \
    }while(0)
  int t=1;
  #undef CMASK
  #define CMASK(P0,P1,t) do{}while(0)
  for(;t+5<NT;t+=2){
    STEP(pB0,pB1,pA0,pA1,t,true,true,true);     WAIT_BAR(3); RESC(); ROT();
    STEP(pA0,pA1,pB0,pB1,t+1,true,true,true);   WAIT_BAR(3); RESC(); ROT();
  }
  #undef CMASK
  #define CMASK(P0,P1,t) do{int jb_=(t)-(NT-4); if(jb_>=0)cmask(P0,P1,jb_,qrel,hi);}while(0)
  #define ENDW(tt) do{ if((tt)+3<NT){WAIT_BAR(3);} else if((tt)+2<NT){WAIT_BAR(2);} else {WAIT_BAR(0);} }while(0)
  for(;t+1<NT;t+=2){
    STEP(pB0,pB1,pA0,pA1,t,(t+3<NT),(t+1<NT),(t+1<NT));       ENDW(t);   RESC(); ROT();
    STEP(pA0,pA1,pB0,pB1,t+1,(t+4<NT),(t+2<NT),(t+2<NT));     ENDW(t+1); RESC(); ROT();
  }
  STEP(pB0,pB1,pA0,pA1,NT-1,false,false,false); RESC();
  { float sacc=pB0[0]+pB0[1]; _Pragma("unroll") for(int r=2;r<16;++r)sacc+=pB0[r]; _Pragma("unroll") for(int r=0;r<16;++r)sacc+=pB1[r]; l_reg+=sacc;
    pw0=(u32x4){PKW(pB0,0),PKW(pB0,2),PKW(pB0,4),PKW(pB0,6)};pw1=(u32x4){PKW(pB0,8),PKW(pB0,10),PKW(pB0,12),PKW(pB0,14)};pw2=(u32x4){PKW(pB1,0),PKW(pB1,2),PKW(pB1,4),PKW(pB1,6)};pw3=(u32x4){PKW(pB1,8),PKW(pB1,10),PKW(pB1,12),PKW(pB1,14)};
    SBAR(); pv(o,vb0+2*sl_cur,PAF(0),PAF(1),PAF(2),PAF(3)); }
  #undef PKW
  #undef PAF
  #undef VFR
  #undef PIN
  #undef MX3
  #undef GAPA
  #undef GAPB
  #undef GAPB2
  #undef VRD2
  #undef EX
  #undef VRD
  #undef KRD
  #undef STEP
  #undef ENDW
  {auto rr=__builtin_amdgcn_permlane32_swap(__float_as_uint(l_reg),__float_as_uint(l_reg),false,false);l_reg=__uint_as_float(rr[0])+__uint_as_float(rr[1]);}
  if(hi==0)wsf[32+r32]=l_reg;asm volatile("s_waitcnt lgkmcnt(0)":::"memory");
  float rli[16];
  #pragma unroll
  for(int r=0;r<16;++r)rli[r]=__builtin_amdgcn_rcpf(wsf[32+crow(r,hi)]);
  bf16*Ow=O+(rowbase+q0+wid*QBLK)*DM+hv*2*D;
  { bf16*stg=(bf16*)(shm+LDS_OST)+wid*2048;
    #pragma unroll
    for(int ps=0;ps<2;++ps){
    #pragma unroll
    for(int r=0;r<16;++r){const int orow=crow(r,hi);
      #pragma unroll
      for(int d0=0;d0<2;++d0)stg[orow*64+d0*32+r32]=__float2bfloat16(o[2*ps+d0][r]*rli[r]);}
    asm volatile("s_waitcnt lgkmcnt(0)":::"memory");
    #pragma unroll
    for(int i=0;i<4;++i){const int row=i*8+(lane>>3),ch=lane&7; const u32x4 v=*(const u32x4*)(stg+row*64+ch*8); ATTN_STORE16(Ow+(long)row*DM+ps*64+ch*8,v);}
    asm volatile("s_waitcnt lgkmcnt(0)":::"memory"); } }
  asm volatile("s_waitcnt lgkmcnt(0)\n\ts_barrier":::"memory");
  #undef DMA_K
  #undef DMA_V
  #undef CMASK
  #undef START
  #undef RESC
  #undef ROT
}
constexpr int ATTN_LDS_BYTES=LDS_BYTES;
struct AttnTensors { const bf16* Q; const bf16* K; const bf16* V; bf16* O0; bf16* O1; };
template<int THRL=8> __device__ __forceinline__ void attn_phase(char*lds,const AttnTensors&T,int vcu){
  const int combo=vcu>>3, s=vcu&7, m=combo&1, h=(combo>>1)&7, b=combo>>4;
  bf16* O = m ? T.O1 : T.O0;
  for(int i=0;i<8;++i){ const int j=i>>1, qb=(i&1)?(16*j+15-s):(16*j+s); attn_unit<THRL>(b,2*h+m,h,qb,T.Q,T.K,T.V,O,lds); }
}
#undef SBAR
#undef WAIT_BAR
}
constexpr int NWAVES = 8;
#ifndef MK_N_LAUNCHES
#define MK_N_LAUNCHES 1
#endif
constexpr int N_PHASES = 9;
#ifndef PROBE_DUP
#define PROBE_DUP (-1)
#endif
#define REPS(k) for (int rep_ = 0; rep_ < ((PROBE_DUP == (k)) ? 2 : 1); ++rep_)
constexpr int N_LAUNCHES = MK_N_LAUNCHES;
static_assert(N_LAUNCHES == 1 || N_LAUNCHES == N_PHASES, "MK_N_LAUNCHES is 1 or 9");

constexpr int T = 32768, SEQL = 16384, D = 2048, NIN = 5120;
constexpr float EPS = 1e-6f;
constexpr float LAMBDA_INIT = 0.2f;

constexpr size_t MiB = 1u << 20;
constexpr size_t WS_CTL = 0, CTL_ZERO_BYTES = 32768;
constexpr size_t WS_WIN = 2 * MiB;
constexpr size_t WS_WOUT = 22 * MiB;
constexpr size_t WS_WSC = 30 * MiB;
constexpr size_t WS_ROPE = 38 * MiB;
constexpr size_t WS_USC = 39 * MiB, WS_VSC = 39 * MiB + 65536;
constexpr size_t WS_RT = 39 * MiB + 262144;
constexpr size_t WS_RINV = 39 * MiB + 524288;
constexpr size_t WS_XN = 40 * MiB;
constexpr size_t WS_Q = 168 * MiB, WS_K = 232 * MiB, WS_V = 296 * MiB, WS_U = 360 * MiB, WS_Z = 424 * MiB;
constexpr size_t WS_O0 = 488 * MiB, WS_O1 = 552 * MiB;
constexpr size_t WS_MIX = 616 * MiB;
constexpr size_t WS_SC = 168 * MiB;
constexpr size_t WS_GATE = 888 * MiB;
constexpr size_t WS_SSQ = 904 * MiB;
constexpr size_t WS_UT2 = 776 * MiB, WS_VT2 = 840 * MiB;
constexpr size_t WS_EB16 = 568 * MiB;
constexpr size_t WS_END = 908 * MiB;
static_assert(WS_SC + (size_t)2048 * T * 4 <= WS_Z, "SC overlay stays inside Q|K|V|U");
constexpr int CW_TMO = 0;
constexpr int CW_BAR = 4096;
static_assert((CW_BAR + 3456) * 4 <= (int)CTL_ZERO_BYTES, "barrier words inside the per-call memset");

constexpr int RING_OFF = 0, RING_BYTES = 131072;
constexpr int LDSCTL_OFF = RING_BYTES, MISC_OFF = LDSCTL_OFF + 320;
constexpr int SMALL_OFF = RING_BYTES + 1024;
constexpr int LDS_BYTES = 147456;
static_assert(MISC_OFF + 128 <= SMALL_OFF && SMALL_OFF + 4096 <= LDS_BYTES, "LDS map");

#define GAS __attribute__((address_space(1)))
#define LAS __attribute__((address_space(3)))
typedef unsigned short bf16;
typedef unsigned v4u __attribute__((ext_vector_type(4)));
typedef float f32x4 __attribute__((ext_vector_type(4)));
typedef short bf16x8 __attribute__((ext_vector_type(8)));
typedef GAS unsigned gu32;
typedef GAS unsigned long long gu64;
#define RLX_AGENT __ATOMIC_RELAXED, __HIP_MEMORY_SCOPE_AGENT
#define LDS_WAIT() asm volatile("s_waitcnt lgkmcnt(0)" ::: "memory")
#define VM_WAIT() asm volatile("s_waitcnt vmcnt(0)" ::: "memory")
__device__ __forceinline__ unsigned long long rt() { return __builtin_amdgcn_s_memrealtime(); }
__device__ __forceinline__ unsigned f2bf(float f) { unsigned u = __builtin_bit_cast(unsigned, f); return (u + 0x7fffu + ((u >> 16) & 1u)) >> 16; }
__device__ __forceinline__ unsigned pk2(float lo, float hi) { return f2bf(lo) | (f2bf(hi) << 16); }

#define XB_TMO      128
#define XB_XCNT(j)  (256  + 64 * (j))
#define XB_XSUB(j)  (1280 + 64 * (j))
#define XB_XGEN(j)  (2304 + 64 * (j))
#define XB_TOP      3328
#define XB_TOPGEN   3392
#define XCD_BAR_WORDS 3456
#define XB_SPIN_CAP (1u << 18)

__device__ __forceinline__ unsigned xb_ld(unsigned* p)              { return __hip_atomic_load(p, __ATOMIC_RELAXED, __HIP_MEMORY_SCOPE_AGENT); }
__device__ __forceinline__ unsigned xb_add(unsigned* p, unsigned v) { return __hip_atomic_fetch_add(p, v, __ATOMIC_RELAXED, __HIP_MEMORY_SCOPE_AGENT); }
__device__ __forceinline__ unsigned xb_xcc_id() { return (unsigned)__builtin_amdgcn_s_getreg((3 << 11) | 20) & 0xFu; }
#define XB_SPIN(cond, bar) do { unsigned _sp = 0; while (cond) { __builtin_amdgcn_s_sleep(1); \
    if ((++_sp & 255u) == 0u) { if (xb_ld(&(bar)[XB_TMO])) break; if (_sp > XB_SPIN_CAP) { atomicAdd(&(bar)[XB_TMO], 1u); break; } } } } while (0)

struct XcdBarrier {
    unsigned* bar; unsigned x;
    volatile LAS unsigned* st;
};

__device__ __forceinline__ XcdBarrier xcd_barrier_post(unsigned* bar, volatile LAS unsigned* st) {
    XcdBarrier b; b.bar = bar; b.x = xb_xcc_id(); b.st = st;
    if (threadIdx.x == 0) (void)xb_add(&bar[XB_XCNT(b.x)], 1u);
    return b;
}
__device__ __forceinline__ void xcd_barrier_complete(unsigned* bar, unsigned x, unsigned& nloc, unsigned& nx) {
    const unsigned G = gridDim.x * gridDim.y * gridDim.z;
    unsigned sum, cnt, mine, sp = 0u;
    for (;;) {
        sum = 0u; cnt = 0u; mine = 0u;
#pragma unroll
        for (unsigned j = 0; j < 16; ++j) { const unsigned c = xb_ld(&bar[XB_XCNT(j)]); sum += c; cnt += (c > 0u) ? 1u : 0u; mine = (j == x) ? c : mine; }
        if (sum == G) break;
        __builtin_amdgcn_s_sleep(1);
        if ((++sp & 255u) == 0u) { if (xb_ld(&bar[XB_TMO])) break; if (sp > XB_SPIN_CAP) { atomicAdd(&bar[XB_TMO], 1u); break; } }
    }
    nloc = mine > 0u ? mine : 1u; nx = cnt > 0u ? cnt : 1u;
}

__device__ __forceinline__ void xcd_barrier(const XcdBarrier& b) {
    asm volatile("s_waitcnt vmcnt(0)" ::: "memory");
    __syncthreads();
    if (threadIdx.x == 0) {
        unsigned* bar = b.bar;
        __builtin_amdgcn_s_waitcnt(0);
        unsigned nloc = b.st[0], nx = b.st[1];
        if (nloc == 0u) { xcd_barrier_complete(bar, b.x, nloc, nx); b.st[0] = nloc; b.st[1] = nx; }
        const unsigned old = xb_add(&bar[XB_XSUB(b.x)], 1u);
        const unsigned gen = old / nloc;
        if (old + 1u == (gen + 1u) * nloc) {
            __builtin_amdgcn_fence(__ATOMIC_RELEASE, "agent");
            asm volatile("s_waitcnt vmcnt(0)" ::: "memory");
            const unsigned og = xb_add(&bar[XB_TOP], 1u);
            const unsigned tg = og / nx;
            if (og + 1u == (tg + 1u) * nx) xb_add(&bar[XB_TOPGEN], 1u);
            else XB_SPIN(xb_ld(&bar[XB_TOPGEN]) == tg, bar);
            __builtin_amdgcn_fence(__ATOMIC_ACQUIRE, "agent");
            xb_add(&bar[XB_XGEN(b.x)], 1u);
            asm volatile("s_waitcnt vmcnt(0)" ::: "memory");
        } else {
            XB_SPIN(xb_ld(&bar[XB_XGEN(b.x)]) == gen, bar);
            __builtin_amdgcn_fence(__ATOMIC_ACQUIRE, "agent");
            asm volatile("s_waitcnt vmcnt(0)" ::: "memory");
        }
    }
    __syncthreads();
}


typedef unsigned long long u64;
typedef float f32x2v __attribute__((ext_vector_type(2)));
typedef __bf16 bf16x2_t __attribute__((ext_vector_type(2)));
__device__ __forceinline__ float bflo(unsigned u) { return __builtin_bit_cast(float, u << 16); }
__device__ __forceinline__ float bfhi(unsigned u) { return __builtin_bit_cast(float, u & 0xffff0000u); }
__device__ __forceinline__ float wave_sum(float v) {
#pragma unroll
    for (int o = 1; o < 64; o <<= 1) v += __shfl_xor(v, o);
    return v;
}
__device__ __forceinline__ float gelu_tanh(float x) { return pg8::gelu_tanh(x); }

__device__ const float c_invf[8] = {1.0f, 0.1939227432012558f, 0.03760603070259094f, 0.007292664609849453f, 0.0014142135623842478f, 0.00027424818836152554f, 5.318296098266728e-05f, 1.0313386155758053e-05f};

struct Args { const float* in[19]; float* out; unsigned char* ws; int ph_lo, ph_hi, li, pad; };
#define F_IN(k) (args.in[k])
#define F_WS(ty, off) ((ty*)(F.ws + (off)))
struct Frame {
    LAS unsigned char* lds;
    volatile LAS unsigned* MISC;
    gu32* ctl;
    int tid, lane, wave;
    int vcu, G;
    float* out; unsigned char* ws;
};

__device__ __forceinline__ void p0_transpose_item(const float* W, int K, int N, bf16* WT, LAS float* scr, int item, int lane, int rope_rows) {
    const int nblk = N / 32, kb = item / nblk, nb = item % nblk, k0 = 64 * kb, n0 = 32 * nb;
#pragma unroll 8
    for (int i = 0; i < 32; ++i) { const int kk = 2 * i + (lane >> 5); scr[kk * 33 + (lane & 31)] = W[(size_t)(k0 + kk) * N + n0 + (lane & 31)]; }
    LDS_WAIT(); asm volatile("" ::: "memory");
    const int c = lane & 7;
    const bool perm = (n0 < rope_rows) && ((n0 & 63) == 0);
#pragma unroll
    for (int j = 0; j < 4; ++j) { const int n = (lane >> 3) + 8 * j; const int src = (perm && n < 16) ? ((n >> 1) + 8 * (n & 1)) : n; const LAS float* s = scr + (8 * c) * 33 + src;
        v4u o; o.x = pk2(s[0 * 33], s[1 * 33]); o.y = pk2(s[2 * 33], s[3 * 33]); o.z = pk2(s[4 * 33], s[5 * 33]); o.w = pk2(s[6 * 33], s[7 * 33]);
        *(GAS v4u*)(WT + (size_t)(n0 + n) * K + k0 + 8 * c) = o; }
    LDS_WAIT(); asm volatile("" ::: "memory");
}
struct RmsRows2 { f32x4 v[8], w[8]; };
__device__ __forceinline__ void rms_rows2_load(RmsRows2& R, const float* xrow0, const float* xrow1, int lane) {
    const GAS f32x4* xr0 = (const GAS f32x4*)xrow0 + lane; const GAS f32x4* xr1 = (const GAS f32x4*)xrow1 + lane;
#pragma unroll
    for (int j = 0; j < 8; ++j) { R.v[j] = xr0[64 * j]; R.w[j] = xr1[64 * j]; }
}
__device__ __forceinline__ void rms_rows2_finish(const RmsRows2& R, const float* g, bf16* orow0, bf16* orow1, int lane, float* rinv0, float* rinv1) {
    float s0 = 0.f, s1 = 0.f;
#pragma unroll
    for (int j = 0; j < 8; ++j) { s0 += (R.v[j].x * R.v[j].x + R.v[j].y * R.v[j].y) + (R.v[j].z * R.v[j].z + R.v[j].w * R.v[j].w); s1 += (R.w[j].x * R.w[j].x + R.w[j].y * R.w[j].y) + (R.w[j].z * R.w[j].z + R.w[j].w * R.w[j].w); }
    const float q0 = sqrtf(wave_sum(s0) * (1.f / D) + EPS), q1 = sqrtf(wave_sum(s1) * (1.f / D) + EPS); const float r0 = 1.f / q0, r1 = 1.f / q1;
    if (lane == 0) { *rinv0 = q0; *rinv1 = q1; }
    const GAS f32x4* gr = (const GAS f32x4*)g + lane;
    GAS u64* o0 = (GAS u64*)orow0 + lane; GAS u64* o1 = (GAS u64*)orow1 + lane;
#pragma unroll
    for (int j = 0; j < 8; ++j) { const f32x4 gg = gr[64 * j];
        o0[64 * j] = (u64)pk2(R.v[j].x * r0 * gg.x, R.v[j].y * r0 * gg.y) | ((u64)pk2(R.v[j].z * r0 * gg.z, R.v[j].w * r0 * gg.w) << 32);
        o1[64 * j] = (u64)pk2(R.w[j].x * r1 * gg.x, R.w[j].y * r1 * gg.y) | ((u64)pk2(R.w[j].z * r1 * gg.z, R.w[j].w * r1 * gg.w) << 32); }
}
__device__ __forceinline__ void p0_wsc_item(Frame& F, const Args& args, int it) {
    const int g = it >> 5, kk0 = (it & 31) * 64;
    LAS float* sk = (LAS float*)(F.lds + RING_OFF);
    LAS float* wq = sk + 128 * 129;
    const float* skg = F_IN(15) + (size_t)g * 128 * 128;
    for (int i = F.tid; i < 128 * 32; i += NWAVES * 64) { const int k = i >> 5, d4 = (i & 31) * 4; const f32x4 v = *(const GAS f32x4*)(skg + k * 128 + d4);
        sk[k * 129 + d4] = v.x; sk[k * 129 + d4 + 1] = v.y; sk[k * 129 + d4 + 2] = v.z; sk[k * 129 + d4 + 3] = v.w; }
    for (int i = F.tid; i < 64 * 32; i += NWAVES * 64) { const int r = i >> 5, d4 = (i & 31) * 4; const f32x4 v = *(const GAS f32x4*)(F_IN(14) + (size_t)(kk0 + r) * 2048 + g * 128 + d4);
        wq[r * 129 + d4] = v.x; wq[r * 129 + d4 + 1] = v.y; wq[r * 129 + d4 + 2] = v.z; wq[r * 129 + d4 + 3] = v.w; }
    __syncthreads();
    const int kkl = F.tid & 63, kb = (F.tid >> 6) * 16;
    float acc[16];
#pragma unroll
    for (int j = 0; j < 16; ++j) acc[j] = 0.f;
    for (int d = 0; d < 128; ++d) { const float a = wq[kkl * 129 + d];
#pragma unroll
        for (int j = 0; j < 16; ++j) acc[j] += a * sk[(kb + j) * 129 + d]; }
    const float fg = F_IN(13)[kk0 + kkl];
#pragma unroll
    for (int j = 0; j < 16; ++j) F_WS(bf16, WS_WSC)[(size_t)(g * 128 + kb + j) * 2048 + kk0 + kkl] = (bf16)f2bf(acc[j] * fg);
    __syncthreads();
}
__device__ __forceinline__ void p0_prologue(Frame& F, const Args& args) {
    LAS float* scr = (LAS float*)(F.lds + RING_OFF + F.wave * 16384);
    const int gw = F.vcu * NWAVES + F.wave, NGW = F.G * NWAVES;
    constexpr int I_IN = (D / 64) * (NIN / 32), I_OUT = (D / 64) * (D / 32);
    for (int it = gw; it < I_IN + I_OUT; it += NGW) {
        if (it < I_IN) p0_transpose_item(F_IN(2), D, NIN, F_WS(bf16, WS_WIN), scr, it, F.lane, 2048);
        else p0_transpose_item(F_IN(12), D, D, F_WS(bf16, WS_WOUT), scr, it - I_IN, F.lane, 0);
    }
    __syncthreads();
    for (int it = F.vcu; it < 512; it += F.G) p0_wsc_item(F, args, it);
    { const int gt = F.vcu * (NWAVES * 64) + F.tid, NGT = F.G * NWAVES * 64;
      for (int i = gt; i < SEQL * 8; i += NGT) { const int pos = i >> 3, f = i & 7;
          const float angf = (float)pos * c_invf[f];
          const double a = (double)angf, n = __builtin_rint(a * 0.15915494309189535);
          double r = __builtin_fma(-n, 6.283185307179586, a); r = __builtin_fma(-n, 2.4492935982947064e-16, r);
          const double r2 = r * r; double sn = 1.0, cs = 1.0;
#pragma unroll
          for (int k = 12; k >= 1; --k) { sn = 1.0 - r2 * (1.0 / (double)((2 * k) * (2 * k + 1))) * sn; cs = 1.0 - r2 * (1.0 / (double)((2 * k - 1) * (2 * k))) * cs; }
          sn *= r;
          *(GAS f32x2v*)(F_WS(float, WS_ROPE) + (size_t)i * 2) = (f32x2v){(float)cs, (float)sn}; } }
    for (int r0 = gw; r0 < T; r0 += 2 * NGW) { RmsRows2 XR;
        rms_rows2_load(XR, F_IN(0) + (size_t)r0 * D, F_IN(0) + (size_t)(r0 + NGW) * D, F.lane);
        rms_rows2_finish(XR, F_IN(1), F_WS(bf16, WS_XN) + (size_t)r0 * D, F_WS(bf16, WS_XN) + (size_t)(r0 + NGW) * D, F.lane, F_WS(float, WS_RINV) + r0, F_WS(float, WS_RINV) + r0 + NGW); }
}

__device__ __forceinline__ void peer_tables_rows(Frame& F, const Args& args) {
    const int gw = F.vcu * NWAVES + F.wave, NGW = F.G * NWAVES;
    {   f32x4 fg[8];
#pragma unroll
        for (int x = 0; x < 8; ++x) fg[x] = ((const GAS f32x4*)F_IN(13))[64 * x + F.lane];
        LAS unsigned char* cb = F.lds + RING_OFF + F.wave * 16384;
        constexpr int NR = 2 * 16384;
#define P0_LOAD_ROW(V, rr_) { const int rq = (rr_) < NR ? (rr_) : gw; const bool sec_ = rq >= 16384; const int row_ = sec_ ? rq - 16384 : rq; \
        const GAS f32x4* src = (const GAS f32x4*)((sec_ ? F_IN(17) : F_IN(16)) + (size_t)row_ * D) + F.lane; \
        _Pragma("unroll") for (int x = 0; x < 8; ++x) V[x] = src[64 * x]; }
        f32x4 v0[8], v1[8], v2[8];
        P0_LOAD_ROW(v0, gw) P0_LOAD_ROW(v1, gw + NGW)
        for (int rr = gw; rr < NR; rr += NGW) {
            P0_LOAD_ROW(v2, rr + 2 * NGW)
            const bool second = rr >= 16384; const int row = second ? rr - 16384 : rr; const int lane = F.lane;
            if (!second) {
#pragma unroll
                for (int x = 0; x < 8; ++x) v0[x] = v0[x] * fg[x]; }
            float am = 0.f;
#pragma unroll
            for (int x = 0; x < 8; ++x)
#pragma unroll
                for (int i = 0; i < 4; ++i) am = fmaxf(am, fabsf(v0[x][i]));
#pragma unroll
            for (int o = 1; o < 64; o <<= 1) am = fmaxf(am, __shfl_xor(am, o));
            const float sc = am > 0.f ? 6.f / am : 1.f, inv = am > 0.f ? am * (1.f / 6.f) : 1.f;
#pragma unroll
            for (int x = 0; x < 8; ++x) { unsigned p = 0u;
                p = __builtin_amdgcn_cvt_scalef32_pk_fp4_f32(p, v0[x][0] * sc, v0[x][1] * sc, 1.0f, 0);
                p = __builtin_amdgcn_cvt_scalef32_pk_fp4_f32(p, v0[x][2] * sc, v0[x][3] * sc, 1.0f, 1);
                const unsigned c0 = p & 15u, c1 = (p >> 4) & 15u, c2 = (p >> 8) & 15u, c3 = (p >> 12) & 15u;
                if (!second) *(LAS unsigned*)(cb + x * 256 + 4 * lane) = c0 | (c1 << 8) | (c2 << 16) | (c3 << 24);
                else { LAS unsigned char* q = cb + x * 256 + 64 * (lane & 3) + (lane >> 2);
                    q[0] = (unsigned char)c0; q[16] = (unsigned char)c1; q[32] = (unsigned char)c2; q[48] = (unsigned char)c3; } }
            asm volatile("s_waitcnt lgkmcnt(0)" ::: "memory");
            const v4u q0 = *(const LAS v4u*)(cb + 32 * lane), q1 = *(const LAS v4u*)(cb + 32 * lane + 16);
            asm volatile("s_waitcnt lgkmcnt(0)" ::: "memory");
            v4u o;
#define PK16(w) ((((w) | ((w) >> 4)) & 0xffu) | ((((w) | ((w) >> 4)) >> 8) & 0xff00u))
            o.x = PK16(q0.x) | (PK16(q0.y) << 16); o.y = PK16(q0.z) | (PK16(q0.w) << 16); o.z = PK16(q1.x) | (PK16(q1.y) << 16); o.w = PK16(q1.z) | (PK16(q1.w) << 16);
#undef PK16
            *(GAS v4u*)((GAS unsigned char*)(F.ws + (second ? WS_VT2 : WS_UT2)) + ((size_t)(lane >> 3) * 16384 + row) * 128 + (lane & 7) * 16) = o;
            if (lane == 0) (second ? F_WS(float, WS_VSC) : F_WS(float, WS_USC))[row] = inv;
#pragma unroll
            for (int x = 0; x < 8; ++x) { v0[x] = v1[x]; v1[x] = v2[x]; } }
#undef P0_LOAD_ROW
    }
}

__device__ __forceinline__ void combine_row(Frame& F, const Args& args, int t0, int t1, float lam) {
    v4u a[2][2], b[2][2];
#pragma unroll
    for (int u = 0; u < 2; ++u)
#pragma unroll
        for (int j = 0; j < 2; ++j) { const size_t off = (size_t)(u ? t1 : t0) * 1024 + 8 * F.lane + 512 * j; a[u][j] = *(const GAS v4u*)(F_WS(bf16, WS_O0) + off); b[u][j] = *(const GAS v4u*)(F_WS(bf16, WS_O1) + off); }
    const int d0 = (8 * F.lane) & 127;
    const f32x4 g0 = *(const GAS f32x4*)(F_IN(7) + d0), g1 = *(const GAS f32x4*)(F_IN(7) + d0 + 4);
#pragma unroll
    for (int u = 0; u < 2; ++u)
#pragma unroll
    for (int j = 0; j < 2; ++j) { const int t = u ? t1 : t0;
        float o[8]; float ss = 0.f;
#pragma unroll
        for (int i = 0; i < 4; ++i) { o[2 * i] = bflo(a[u][j][i]) - lam * bflo(b[u][j][i]); o[2 * i + 1] = bfhi(a[u][j][i]) - lam * bfhi(b[u][j][i]); ss += o[2 * i] * o[2 * i] + o[2 * i + 1] * o[2 * i + 1]; }
        ss += __shfl_xor(ss, 1); ss += __shfl_xor(ss, 2); ss += __shfl_xor(ss, 4); ss += __shfl_xor(ss, 8);
        const float r = (1.f - LAMBDA_INIT) / sqrtf(ss * (1.f / 128.f) + EPS);
        v4u w; w.x = pk2(o[0] * r * g0.x, o[1] * r * g0.y); w.y = pk2(o[2] * r * g0.z, o[3] * r * g0.w); w.z = pk2(o[4] * r * g1.x, o[5] * r * g1.y); w.w = pk2(o[6] * r * g1.z, o[7] * r * g1.w);
        *(GAS v4u*)(F_WS(bf16, WS_MIX) + (size_t)t * 2048 + 8 * F.lane + 512 * j) = w; }
}
typedef float f32x16g __attribute__((ext_vector_type(16)));
__device__ __forceinline__ int gm_crow(int r, int hi) { return (r & 3) + 8 * (r >> 2) + 4 * hi; }
__device__ __forceinline__ void gmlp_unit(Frame& F, const Args& args, int unit) {
    constexpr int ROWB = 272;
    constexpr int SZS = 132;
    LAS unsigned char* aimg = F.lds + RING_OFF;
    LAS unsigned char* bimg = aimg + 128 * ROWB;
    LAS float* szt = (LAS float*)(F.lds + RING_OFF);
    LAS float* rq = (LAS float*)(F.lds + SMALL_OFF);
    static_assert(128 * SZS * 4 <= 2 * 128 * ROWB, "product tile fits over the images");
    const int t0 = unit * 128;
    const int lane = F.lane, r32 = lane & 31, hi = lane >> 5, w = F.wave, pb = 32 * (w & 3), cb = 64 * (w >> 2);
    const int q = F.tid >> 2, cq = F.tid & 3;
    const GAS bf16* zrow = (const GAS bf16*)(F_WS(bf16, WS_Z) + (size_t)(t0 + q) * 1024 + 8 * cq);
    const GAS bf16* urow = (const GAS bf16*)(F_WS(bf16, WS_U) + (size_t)(t0 + q) * 1024 + 8 * cq);
    GAS bf16* mrow = (GAS bf16*)(F_WS(bf16, WS_MIX) + (size_t)(t0 + q) * 2048 + 1024 + 8 * cq);
    v4u rawz[4], ucur[4]; f32x4 wreg[8];
#define GM_LOAD_ZW(g_) do { _Pragma("unroll") for (int j = 0; j < 4; ++j) rawz[j] = *(const GAS v4u*)(zrow + (g_) * 128 + 32 * j); \
        _Pragma("unroll") for (int i = 0; i < 8; ++i) { const int idx = F.tid + NWAVES * 64 * i; wreg[i] = *(const GAS f32x4*)(F_IN(9) + ((size_t)(g_) * 128 + (idx >> 5)) * 128 + (idx & 31) * 4); } } while (0)
    GM_LOAD_ZW(0);
#pragma unroll
    for (int j = 0; j < 4; ++j) ucur[j] = *(const GAS v4u*)(urow + 32 * j);
    float ssrow = 0.f;
    for (int g = 0; g < 8; ++g) {
        __syncthreads();
        { float ss = 0.f;
#pragma unroll
          for (int j = 0; j < 4; ++j)
#pragma unroll
              for (int i = 0; i < 4; ++i) { const float a = bflo(rawz[j][i]), b = bfhi(rawz[j][i]); ss += a * a + b * b;
                  const int c = 8 * cq + 32 * j + 2 * i;
                  *(LAS unsigned short*)(bimg + c * ROWB + q * 2) = (unsigned short)(rawz[j][i] & 0xffffu);
                  *(LAS unsigned short*)(bimg + (c + 1) * ROWB + q * 2) = (unsigned short)(rawz[j][i] >> 16); }
          ss += __shfl_xor(ss, 1); ss += __shfl_xor(ss, 2);
          if (cq == 0) rq[q] = 1.f / sqrtf(ss * (1.f / 128.f) + EPS); }
        __syncthreads();
#pragma unroll
        for (int i = 0; i < 8; ++i) { const int idx = F.tid + NWAVES * 64 * i, p = idx >> 5, q4 = (idx & 31) * 4;
            f32x4 wv = wreg[i];
            if (p < 64 && q4 >= 64) wv = (f32x4){0.f, 0.f, 0.f, 0.f};
            const f32x4 rr = *(const LAS f32x4*)(rq + q4);
            *(LAS u64*)(aimg + p * ROWB + q4 * 2) = (u64)pk2(wv.x * rr.x, wv.y * rr.y) | ((u64)pk2(wv.z * rr.z, wv.w * rr.w) << 32); }
        v4u unext[4];
        if (g < 7) { GM_LOAD_ZW(g + 1);
#pragma unroll
            for (int j = 0; j < 4; ++j) unext[j] = *(const GAS v4u*)(urow + (g + 1) * 128 + 32 * j); }
        __syncthreads();
        f32x16g acc[2];
#pragma unroll
        for (int nb = 0; nb < 2; ++nb)
#pragma unroll
            for (int r = 0; r < 16; ++r) acc[nb][r] = 0.f;
        const int nks = (pb < 64) ? 4 : 8;
        for (int sI = 0; sI < nks; ++sI) {
            const bf16x8 af = *(const LAS bf16x8*)(aimg + (pb + r32) * ROWB + 32 * sI + 16 * hi);
#pragma unroll
            for (int nb = 0; nb < 2; ++nb) { const bf16x8 bfr = *(const LAS bf16x8*)(bimg + (cb + 32 * nb + r32) * ROWB + 32 * sI + 16 * hi);
                acc[nb] = __builtin_amdgcn_mfma_f32_32x32x16_bf16(af, bfr, acc[nb], 0, 0, 0); } }
        __syncthreads();
#pragma unroll
        for (int nb = 0; nb < 2; ++nb)
#pragma unroll
            for (int r = 0; r < 16; ++r) szt[(pb + gm_crow(r, hi)) * SZS + cb + 32 * nb + r32] = acc[nb][r];
        __syncthreads();
        { const float bias = F_IN(10)[g * 128 + q];
#pragma unroll
          for (int j = 0; j < 4; ++j) { const int c0 = 8 * cq + 32 * j;
              const f32x4 s0 = *(const LAS f32x4*)(szt + q * SZS + c0), s1 = *(const LAS f32x4*)(szt + q * SZS + c0 + 4);
              const f32x4 g0 = *(const GAS f32x4*)(F_IN(8) + g * 128 + c0), g1 = *(const GAS f32x4*)(F_IN(8) + g * 128 + c0 + 4);
              const v4u uu = ucur[j];
              const float o0 = (s0.x * g0.x + bias) * bflo(uu[0]), o1 = (s0.y * g0.y + bias) * bfhi(uu[0]), o2 = (s0.z * g0.z + bias) * bflo(uu[1]), o3 = (s0.w * g0.w + bias) * bfhi(uu[1]);
              const float o4 = (s1.x * g1.x + bias) * bflo(uu[2]), o5 = (s1.y * g1.y + bias) * bfhi(uu[2]), o6 = (s1.z * g1.z + bias) * bflo(uu[3]), o7 = (s1.w * g1.w + bias) * bfhi(uu[3]);
              ssrow += (o0 * o0 + o1 * o1) + (o2 * o2 + o3 * o3) + (o4 * o4 + o5 * o5) + (o6 * o6 + o7 * o7);
              *(GAS v4u*)(mrow + g * 128 + 32 * j) = (v4u){pk2(o0, o1), pk2(o2, o3), pk2(o4, o5), pk2(o6, o7)}; } }
        if (g < 7) {
#pragma unroll
            for (int j = 0; j < 4; ++j) ucur[j] = unext[j]; }
    }
#undef GM_LOAD_ZW
    ssrow += __shfl_xor(ssrow, 1); ssrow += __shfl_xor(ssrow, 2);
    const float rr = 1.f / sqrtf(ssrow * (1.f / 1024.f) + EPS);
    VM_WAIT();
    for (int g = 0; g < 8; ++g) { u64 raw[4][2];
#pragma unroll
        for (int j = 0; j < 4; ++j) { GAS u64* ptr = (GAS u64*)(mrow + g * 128 + 32 * j); raw[j][0] = __hip_atomic_load(ptr, __ATOMIC_RELAXED, __HIP_MEMORY_SCOPE_AGENT); raw[j][1] = __hip_atomic_load(ptr + 1, __ATOMIC_RELAXED, __HIP_MEMORY_SCOPE_AGENT); }
#pragma unroll
        for (int j = 0; j < 4; ++j) { const int c0 = 8 * cq + 32 * j;
            const f32x4 g0 = *(const GAS f32x4*)(F_IN(11) + g * 128 + c0), g1 = *(const GAS f32x4*)(F_IN(11) + g * 128 + c0 + 4);
            const unsigned a0 = (unsigned)raw[j][0], a1 = (unsigned)(raw[j][0] >> 32), a2 = (unsigned)raw[j][1], a3 = (unsigned)(raw[j][1] >> 32);
            *(GAS v4u*)(mrow + g * 128 + 32 * j) = (v4u){pk2(bflo(a0) * rr * g0.x, bfhi(a0) * rr * g0.y), pk2(bflo(a1) * rr * g0.z, bfhi(a1) * rr * g0.w),
                                                         pk2(bflo(a2) * rr * g1.x, bfhi(a2) * rr * g1.y), pk2(bflo(a3) * rr * g1.z, bfhi(a3) * rr * g1.w)}; } }
    __syncthreads();
}

__device__ __forceinline__ void topk_unit(Frame& F, const Args& args, int wu) {
    const int t = (wu >> 3) * 64 + F.lane, h = wu & 7;
    int LA[16], LB[16];
#pragma unroll
    for (int j = 0; j < 16; ++j) { LA[j] = (int)0x80000000; LB[j] = (int)0x80000000; }
    const GAS unsigned short* scA = (const GAS unsigned short*)F_WS(unsigned short, WS_SC) + (size_t)(2 * h) * 128 * T + t;
    const GAS unsigned short* scB = scA + (size_t)128 * T;
#define TK_CE(a, b) { const int hi_ = (a) > (b) ? (a) : (b); const int lo_ = (a) > (b) ? (b) : (a); (a) = hi_; (b) = lo_; }
#define TK_SORT16_ASC(c) { _Pragma("unroll") for (int k_ = 2; k_ <= 16; k_ <<= 1) { _Pragma("unroll") for (int j_ = k_ >> 1; j_ > 0; j_ >>= 1) { _Pragma("unroll") for (int i_ = 0; i_ < 16; ++i_) { const int l_ = i_ ^ j_; \
        if (l_ > i_) { if ((i_ & k_) == 0) { TK_CE(c[l_], c[i_]) } else { TK_CE(c[i_], c[l_]) } } } } } }
#define TK_MERGE16(L, c) { _Pragma("unroll") for (int i_ = 0; i_ < 16; ++i_) L[i_] = L[i_] > c[i_] ? L[i_] : c[i_]; \
        _Pragma("unroll") for (int j_ = 8; j_ > 0; j_ >>= 1) { _Pragma("unroll") for (int i_ = 0; i_ < 16; ++i_) { const int l_ = i_ ^ j_; if (l_ > i_) { TK_CE(L[i_], L[l_]) } } } }
    int ca[16], cbv[16];
#pragma unroll
    for (int i = 0; i < 16; ++i) { ca[i] = (int)scA[(size_t)i * T]; cbv[i] = (int)scB[(size_t)i * T]; }
#pragma unroll 1
    for (int k0 = 0; k0 < 128; k0 += 16) {
        int na[16], nb[16];
        const int kn = (k0 + 16 < 128) ? k0 + 16 : k0;
#pragma unroll
        for (int i = 0; i < 16; ++i) { na[i] = (int)scA[(size_t)(kn + i) * T]; nb[i] = (int)scB[(size_t)(kn + i) * T]; }
#pragma unroll
        for (int i = 0; i < 16; ++i) { const int k = k0 + i;
            int ka = __builtin_bit_cast(int, (float)__builtin_bit_cast(_Float16, (unsigned short)ca[i])), kb = __builtin_bit_cast(int, (float)__builtin_bit_cast(_Float16, (unsigned short)cbv[i]));
            ka ^= (ka >> 31) & 0x7fffffff; kb ^= (kb >> 31) & 0x7fffffff;
            ca[i] = (ka & ~127) | (127 - k); cbv[i] = (kb & ~127) | (127 - k); }
        TK_SORT16_ASC(ca) TK_SORT16_ASC(cbv)
        TK_MERGE16(LA, ca) TK_MERGE16(LB, cbv)
#pragma unroll
        for (int i = 0; i < 16; ++i) { ca[i] = na[i]; cbv[i] = nb[i]; }
    }
#undef TK_CE
#undef TK_SORT16_ASC
#undef TK_MERGE16
    float ssq = 0.f;
    { float sv[32];
#pragma unroll
      for (int i = 0; i < 32; ++i) sv[i] = F_WS(float, WS_SSQ)[(size_t)i * T + t];
#pragma unroll
      for (int i = 0; i < 32; ++i) ssq += sv[i]; }
    const float rt = 1.f / sqrtf(ssq * (1.f / D) + EPS);
    if (h == 0) F_WS(float, WS_RT)[t] = rt;
    float va[16], vb[16]; int ia[16], ib[16];
#pragma unroll
    for (int j = 0; j < 16; ++j) { int a = LA[j] & ~127; ia[j] = 127 - (LA[j] & 127); a ^= (a >> 31) & 0x7fffffff; va[j] = __builtin_bit_cast(float, a) * rt;
                                   int b = LB[j] & ~127; ib[j] = 127 - (LB[j] & 127); b ^= (b >> 31) & 0x7fffffff; vb[j] = __builtin_bit_cast(float, b) * rt; }
    float S[16]; int P[16];
#pragma unroll
    for (int q = 0; q < 16; ++q) { S[q] = -INFINITY; P[q] = 0; }
#pragma unroll
    for (int i = 0; i < 16; ++i)
#pragma unroll
        for (int j = 0; j < 16; ++j) if ((i + 1) * (j + 1) <= 16) {
            float s = va[i] + vb[j]; int p = ia[i] * 128 + ib[j];
#pragma unroll
            for (int q = 0; q < 16; ++q) { const bool gt = s > S[q]; const float s2 = gt ? S[q] : s; const int p2 = gt ? P[q] : p; S[q] = gt ? s : S[q]; P[q] = gt ? p : P[q]; s = s2; p = p2; }
        }
    float e[16]; float sum = 0.f;
#pragma unroll
    for (int q = 0; q < 16; ++q) { e[q] = __expf(S[q] - S[0]); sum += e[q]; }
    const float inv = 1.f / sum;
    { GAS unsigned* e16 = (GAS unsigned*)((GAS unsigned char*)(F.ws + WS_EB16) + (size_t)t * 256) + h;
#pragma unroll
      for (int g8 = 0; g8 < 8; ++g8) e16[g8 * 8] = (unsigned)P[g8] | ((unsigned)P[g8 + 8] << 16); }
    GAS f32x4* gp = (GAS f32x4*)(F_WS(float, WS_GATE) + (size_t)t * 128 + h * 16);
#pragma unroll
    for (int q = 0; q < 4; ++q) gp[q] = (f32x4){e[4 * q] * inv, e[4 * q + 1] * inv, e[4 * q + 2] * inv, e[4 * q + 3] * inv};
}

typedef int v8i_t __attribute__((ext_vector_type(8)));
typedef int v2i_t __attribute__((ext_vector_type(2)));
constexpr float PEER_XS = 8.f;
constexpr size_t WS_PD = 424 * MiB;
constexpr size_t WS_WQ = 552 * MiB;
constexpr size_t WS_WSCL = 600 * MiB;
constexpr size_t WS_SSQ2 = 601 * MiB;
constexpr int PEER_SC1 = 0x7f7f7f7f;

__device__ __forceinline__ float wave_max(float v) {
#pragma unroll
    for (int o = 1; o < 64; o <<= 1) v = fmaxf(v, __shfl_xor(v, o));
    return v;
}
__device__ __forceinline__ float clamp448(float v) { return fminf(fmaxf(v, -448.f), 448.f); }
__device__ __forceinline__ void fp8_split4(float v0, float v1, float v2, float v3, unsigned& hi, unsigned& lo) {
    v0 = clamp448(v0); v1 = clamp448(v1); v2 = clamp448(v2); v3 = clamp448(v3);
    int h = __builtin_amdgcn_cvt_pk_fp8_f32(v0, v1, 0, false); h = __builtin_amdgcn_cvt_pk_fp8_f32(v2, v3, h, true);
    const auto d0 = __builtin_amdgcn_cvt_pk_f32_fp8(h, false), d1 = __builtin_amdgcn_cvt_pk_f32_fp8(h, true);
    int l = __builtin_amdgcn_cvt_pk_fp8_f32((v0 - d0[0]) * 16.f, (v1 - d0[1]) * 16.f, 0, false); l = __builtin_amdgcn_cvt_pk_fp8_f32((v2 - d1[0]) * 16.f, (v3 - d1[1]) * 16.f, l, true);
    hi = (unsigned)h; lo = (unsigned)l;
}

#define PEER_EID(E, j) (((E)[(j) >> 3][((j) >> 1) & 3] >> (16 * ((j) & 1))) & 0xffffu)
__device__ __forceinline__ void peer_udots_loop(Frame& F, const Args& args, int x, int t0, int tstep) {
    int lane_ = F.lane; asm volatile("" : "+v"(lane_)); const int lane = lane_;
    const int n = lane & 15, kb = lane >> 4, g = lane >> 3, cc = lane & 7;
    LAS unsigned char* tile = F.lds + RING_OFF + F.wave * 16384;
    LAS unsigned char* xq = F.lds + SMALL_OFF + F.wave * 512;
    const LAS unsigned char* ab = xq + (n & 1) * 256 + 16 * kb;
    const LAS unsigned char* brow = tile + n * 128;
    const int swz0 = (cc ^ ((g >> 1) & 7)) * 16, swz1 = (cc ^ ((4 + (g >> 1)) & 7)) * 16;
    const GAS unsigned char* ub = (const GAS unsigned char*)(F.ws + WS_UT2) + (size_t)x * (16384 * 128);
    if (t0 >= T) return;
    const int tlast = t0 + ((T - 1 - t0) / tstep) * tstep;
#define UD_CL(tt) ((tt) <= tlast ? (tt) : tlast)
#define UD_LOAD_E(E, tt) { const GAS v4u* ep = (const GAS v4u*)((const GAS unsigned char*)(F.ws + WS_EB16) + (size_t)(tt) * 256 + g * 32); E[0] = ep[0]; E[1] = ep[1]; }
#define UD_LOAD_X(XR, SC, tt) { XR = *(const GAS u64*)(F_WS(bf16, WS_XN) + (size_t)(tt) * D + 256 * x + 4 * lane); SC = F_WS(float, WS_RT)[tt]; }
#define UD_DMA(E) { _Pragma("unroll") for (int i = 0; i < 16; ++i) { const int k = 8 * i + g; \
        R[i] = *(const GAS v4u*)(ub + ((PEER_EID(E, i) << 7) + (unsigned)((i & 1) ? swz1 : swz0))); } }
#define UD_PUT() { _Pragma("unroll") for (int i = 0; i < 16; ++i) *(LAS v4u*)(tile + i * 1024 + lane * 16) = R[i]; }
#define UD_STEP(XR, SC, tt, E1, E3, X2, SC2) { \
      UD_PUT() \
      asm volatile("s_waitcnt lgkmcnt(0)" ::: "memory"); \
      UD_DMA(E1) \
      __builtin_amdgcn_sched_barrier(0); \
      UD_LOAD_E(E3, UD_CL((tt) + 3 * tstep)) UD_LOAD_X(X2, SC2, UD_CL((tt) + 2 * tstep)) \
      __builtin_amdgcn_sched_barrier(0); \
      v4u bu[8][2]; \
      _Pragma("unroll") for (int rg = 0; rg < 8; ++rg) { _Pragma("unroll") for (int ks = 0; ks < 2; ++ks) bu[rg][ks] = *(const LAS v4u*)(brow + rg * 2048 + (((4 * ks + kb) ^ (n >> 1)) * 16)); } \
      { const unsigned w0 = (unsigned)XR, w1 = (unsigned)(XR >> 32); unsigned hi, lo; const float sc_ = SC * PEER_XS; \
        fp8_split4(bflo(w0) * sc_, bfhi(w0) * sc_, bflo(w1) * sc_, bfhi(w1) * sc_, hi, lo); \
        ((LAS unsigned*)xq)[lane] = hi; ((LAS unsigned*)(xq + 256))[lane] = lo; } \
      asm volatile("s_waitcnt lgkmcnt(0)" ::: "memory"); \
      v8i_t ax[2]; \
      _Pragma("unroll") for (int ks = 0; ks < 2; ++ks) { const v4u p = *(const LAS v4u*)(ab + ks * 128), q = *(const LAS v4u*)(ab + ks * 128 + 64); \
          ax[ks] = (v8i_t){(int)p.x, (int)p.y, (int)p.z, (int)p.w, (int)q.x, (int)q.y, (int)q.z, (int)q.w}; } \
      asm volatile("s_waitcnt lgkmcnt(0)" ::: "memory"); \
      float res[8]; \
      _Pragma("unroll") for (int rg = 0; rg < 8; ++rg) { f32x4 c = (f32x4){0.f, 0.f, 0.f, 0.f}; \
          _Pragma("unroll") for (int ks = 0; ks < 2; ++ks) { const v8i_t b = (v8i_t){(int)bu[rg][ks].x, (int)bu[rg][ks].y, (int)bu[rg][ks].z, (int)bu[rg][ks].w, 0, 0, 0, 0}; \
              c = __builtin_amdgcn_mfma_scale_f32_16x16x128_f8f6f4(ax[ks], b, c, 0, 4, 0, PEER_SC1, 0, PEER_SC1); } \
          res[rg] = (c[0] + c[1] * 0.0625f) * (1.f / PEER_XS); } \
      { GAS v4u* pd = (GAS v4u*)(F_WS(bf16, WS_PD) + ((size_t)x * T + (tt)) * 128 + n * 8); \
        if (lane < 16) pd[0] = (v4u){pg8::cvt_pk_bf16(res[0], res[1]), pg8::cvt_pk_bf16(res[2], res[3]), pg8::cvt_pk_bf16(res[4], res[5]), pg8::cvt_pk_bf16(res[6], res[7])}; } }
    v4u eA[2], eB[2], eC[2]; u64 xrA, xrB, xrC; float scA, scB, scC; v4u R[16];
    UD_LOAD_E(eA, t0) UD_LOAD_E(eB, UD_CL(t0 + tstep)) UD_LOAD_E(eC, UD_CL(t0 + 2 * tstep))
    UD_LOAD_X(xrA, scA, t0) UD_LOAD_X(xrB, scB, UD_CL(t0 + tstep))
    xrC = xrA; scC = scA;
    UD_DMA(eA)
    __builtin_amdgcn_sched_barrier(0);
#pragma unroll 1
    for (int t = t0; t <= tlast; t += 3 * tstep) {
        UD_STEP(xrA, scA, t, eB, eA, xrC, scC)
        if (t + tstep > tlast) break;
        UD_STEP(xrB, scB, t + tstep, eC, eB, xrA, scA)
        if (t + 2 * tstep > tlast) break;
        UD_STEP(xrC, scC, t + 2 * tstep, eA, eC, xrB, scB)
    }
    asm volatile("" :: "v"(R[0]), "v"(R[15]));
#undef UD_LOAD_E
#undef UD_LOAD_X
#undef UD_DMA
#undef UD_PUT
#undef UD_STEP
}

__device__ __forceinline__ void peer_weights4(Frame& F, const Args& args, int t0, int ts) {
    int lane_ = F.lane; asm volatile("" : "+v"(lane_)); const int lane = lane_;
    float s[4][2]; int ex[4][2]; float gt[4][2];
    const int q0 = ((2 * lane) & 7) * 16 + (lane >> 2), q1 = q0 + 16;
#pragma unroll
    for (int k = 0; k < 4; ++k) { const int t = t0 + k * ts;
        float pv[2][8];
#pragma unroll
        for (int x = 0; x < 8; ++x) { const unsigned pw = ((const GAS unsigned*)(F_WS(bf16, WS_PD) + ((size_t)x * T + t) * 128))[lane]; pv[0][x] = bflo(pw); pv[1][x] = bfhi(pw); }
        { const GAS unsigned short* e16 = (const GAS unsigned short*)(F.ws + WS_EB16) + (size_t)t * 128;
          ex[k][0] = (int)e16[(q0 & 7) * 16 + (q0 >> 3)]; ex[k][1] = (int)e16[(q1 & 7) * 16 + (q1 >> 3)]; }
        gt[k][0] = F_WS(float, WS_GATE)[(size_t)t * 128 + q0]; gt[k][1] = F_WS(float, WS_GATE)[(size_t)t * 128 + q1];
        s[k][0] = ((pv[0][0] + pv[0][1]) + (pv[0][2] + pv[0][3])) + ((pv[0][4] + pv[0][5]) + (pv[0][6] + pv[0][7]));
        s[k][1] = ((pv[1][0] + pv[1][1]) + (pv[1][2] + pv[1][3])) + ((pv[1][4] + pv[1][5]) + (pv[1][6] + pv[1][7])); }
    float usc[4][2], vsc[4][2];
#pragma unroll
    for (int k = 0; k < 4; ++k)
#pragma unroll
        for (int u = 0; u < 2; ++u) { usc[k][u] = F_WS(float, WS_USC)[ex[k][u]]; vsc[k][u] = F_WS(float, WS_VSC)[ex[k][u]]; }
#pragma unroll
    for (int k = 0; k < 4; ++k) { const int t = t0 + k * ts;
        float w[2];
#pragma unroll
        for (int u = 0; u < 2; ++u) w[u] = gt[k][u] * gelu_tanh(s[k][u] * usc[k][u]) * vsc[k][u];
        const float wm = wave_max(fmaxf(fabsf(w[0]), fabsf(w[1])));
        int sb = 260 - (int)((__builtin_bit_cast(unsigned, wm) >> 23) & 0xffu);
        sb = wm > 0.f ? (sb < 1 ? 1 : (sb > 253 ? 253 : sb)) : 127;
        const float S = __builtin_bit_cast(float, (unsigned)sb << 23), Sinv = __builtin_bit_cast(float, (unsigned)(254 - sb) << 23);
#pragma unroll
        for (int u = 0; u < 2; ++u) { const float ws_ = clamp448(w[u] * S);
            const int h = __builtin_amdgcn_cvt_pk_fp8_f32(ws_, 0.f, 0, false); const float dec = __builtin_amdgcn_cvt_pk_f32_fp8(h, false)[0];
            const int l = __builtin_amdgcn_cvt_pk_fp8_f32((ws_ - dec) * 16.f, 0.f, 0, false);
            GAS unsigned char* wq = (GAS unsigned char*)(F.ws + WS_WQ) + (size_t)t * 256 + (u ? q1 : q0);
            wq[0] = (unsigned char)(h & 0xff); wq[128] = (unsigned char)(l & 0xff); }
        if (lane == 0) F_WS(float, WS_WSCL)[t] = Sinv; }
}

__device__ __forceinline__ void peer_vsum_loop(Frame& F, const Args& args, int x, int t0, int tstep) {
    int lane_ = F.lane; asm volatile("" : "+v"(lane_)); const int lane = lane_;
    const int n = lane & 15, kb = lane >> 4, g = lane >> 3, cc = lane & 7;
    LAS unsigned char* tile = F.lds + RING_OFF + F.wave * 16384;
    const LAS unsigned char* r1 = tile + (32 * kb + n) * 128;
    const int swz0 = (cc ^ ((g >> 1) & 7)) * 16, swz1 = (cc ^ ((4 + (g >> 1)) & 7)) * 16;
    const GAS unsigned char* vb = (const GAS unsigned char*)(F.ws + WS_VT2) + (size_t)x * (16384 * 128);
    if (t0 >= T) return;
    const int tlast = t0 + ((T - 1 - t0) / tstep) * tstep;
#define VS_LOAD_E(E, tt) { const GAS v4u* ep = (const GAS v4u*)((const GAS unsigned char*)(F.ws + WS_EB16) + (size_t)(tt) * 256 + g * 32); E[0] = ep[0]; E[1] = ep[1]; }
#define VS_DMA(E) { _Pragma("unroll") for (int i = 0; i < 16; ++i) { const int k = 8 * i + g; \
        R[i] = *(const GAS v4u*)(vb + ((PEER_EID(E, i) << 7) + (unsigned)((i & 1) ? swz1 : swz0))); } }
#define VS_PUT() { _Pragma("unroll") for (int i = 0; i < 16; ++i) *(LAS v4u*)(tile + i * 1024 + lane * 16) = R[i]; }
#define VS_LOAD_M(A0, A1, SI, X0, X1, tt) { const GAS unsigned char* wq = (const GAS unsigned char*)(F.ws + WS_WQ) + (size_t)(tt) * 256 + (n & 1) * 128 + 16 * kb; \
        A0 = *(const GAS v4u*)wq; A1 = *(const GAS v4u*)(wq + 64); SI = F_WS(float, WS_WSCL)[tt]; \
        const GAS v4u* xp = (const GAS v4u*)(F_WS(bf16, WS_XN) + (size_t)(tt) * D + 256 * x + 16 * n); X0 = xp[0]; X1 = xp[1]; }
#define X2PAIR(dst, src, d0) { const float a_ = bflo(src) + y[d0], b_ = bfhi(src) + y[(d0) + 1]; ss += a_ * a_ + b_ * b_; dst = pg8::cvt_pk_bf16(a_, b_); }
#define VS_STEP(A0, A1, SI, X0, X1, tt, E1, E3, NA0, NA1, NSI, NX0, NX1) { \
      VS_PUT() \
      asm volatile("s_waitcnt lgkmcnt(0)" ::: "memory"); \
      VS_DMA(E1) \
      __builtin_amdgcn_sched_barrier(0); \
      VS_LOAD_E(E3, UD_CL((tt) + 3 * tstep)) VS_LOAD_M(NA0, NA1, NSI, NX0, NX1, UD_CL((tt) + 2 * tstep)) \
      __builtin_amdgcn_sched_barrier(0); \
      v2i_t tr[16][2]; \
      _Pragma("unroll") for (int dg = 0; dg < 16; ++dg) { const int off = (((dg >> 1) ^ (n >> 1)) * 16) + (dg & 1) * 8; \
          tr[dg][0] = __builtin_amdgcn_ds_read_tr4_b64_v2i32((LAS v2i_t*)(r1 + off)); tr[dg][1] = __builtin_amdgcn_ds_read_tr4_b64_v2i32((LAS v2i_t*)(r1 + 2048 + off)); } \
      asm volatile("s_waitcnt lgkmcnt(0)" ::: "memory"); \
      const v8i_t aw = (v8i_t){(int)A0.x, (int)A0.y, (int)A0.z, (int)A0.w, (int)A1.x, (int)A1.y, (int)A1.z, (int)A1.w}; \
      float y[16]; \
      _Pragma("unroll") for (int dg = 0; dg < 16; ++dg) { const v8i_t b = (v8i_t){tr[dg][0].x, tr[dg][0].y, tr[dg][1].x, tr[dg][1].y, 0, 0, 0, 0}; \
          f32x4 c = (f32x4){0.f, 0.f, 0.f, 0.f}; \
          c = __builtin_amdgcn_mfma_scale_f32_16x16x128_f8f6f4(aw, b, c, 0, 4, 0, PEER_SC1, 0, PEER_SC1); \
          y[dg] = (c[0] + c[1] * 0.0625f) * SI; } \
      float ss = 0.f; v4u o0, o1; \
      X2PAIR(o0.x, X0.x, 0) X2PAIR(o0.y, X0.y, 2) X2PAIR(o0.z, X0.z, 4) X2PAIR(o0.w, X0.w, 6) \
      X2PAIR(o1.x, X1.x, 8) X2PAIR(o1.y, X1.y, 10) X2PAIR(o1.z, X1.z, 12) X2PAIR(o1.w, X1.w, 14) \
      ss += __shfl_xor(ss, 1); ss += __shfl_xor(ss, 2); ss += __shfl_xor(ss, 4); ss += __shfl_xor(ss, 8); \
      if (lane < 16) { GAS v4u* xo = (GAS v4u*)(F_WS(bf16, WS_XN) + (size_t)(tt) * D + 256 * x + 16 * n); xo[0] = o0; xo[1] = o1; F_WS(float, WS_SSQ2)[(size_t)x * T + (tt)] = ss; } }
    v4u R[16]; v4u eA[2], eB[2], eC[2]; v4u a0A, a1A, x0A, x1A, a0B, a1B, x0B, x1B, a0C, a1C, x0C, x1C; float siA, siB, siC;
    VS_LOAD_E(eA, t0) VS_LOAD_E(eB, UD_CL(t0 + tstep)) VS_LOAD_E(eC, UD_CL(t0 + 2 * tstep))
    VS_LOAD_M(a0A, a1A, siA, x0A, x1A, t0) VS_LOAD_M(a0B, a1B, siB, x0B, x1B, UD_CL(t0 + tstep))
    a0C = a0A; a1C = a1A; x0C = x0A; x1C = x1A; siC = siA;
    VS_DMA(eA)
    __builtin_amdgcn_sched_barrier(0);
#pragma unroll 1
    for (int t = t0; t <= tlast; t += 3 * tstep) {
        VS_STEP(a0A, a1A, siA, x0A, x1A, t, eB, eA, a0C, a1C, siC, x0C, x1C)
        if (t + tstep > tlast) break;
        VS_STEP(a0B, a1B, siB, x0B, x1B, t + tstep, eC, eB, a0A, a1A, siA, x0A, x1A)
        if (t + 2 * tstep > tlast) break;
        VS_STEP(a0C, a1C, siC, x0C, x1C, t + 2 * tstep, eA, eC, a0B, a1B, siB, x0B, x1B)
    }
    asm volatile("" :: "v"(R[0]), "v"(R[15]));
#undef VS_LOAD_E
#undef VS_DMA
#undef VS_PUT
#undef VS_LOAD_M
#undef X2PAIR
#undef VS_STEP
#undef UD_CL
}

__device__ __forceinline__ void peer_final4(Frame& F, const Args& args, int t0, int ts, float* dst) {
    int lane_ = F.lane; asm volatile("" : "+v"(lane_)); const int lane = lane_;
    u64 xr[4][8]; float ssq[4];
#pragma unroll
    for (int k = 0; k < 4; ++k) { const int t = t0 + k * ts; const GAS u64* xp = (const GAS u64*)(F_WS(bf16, WS_XN) + (size_t)t * D) + lane;
#pragma unroll
        for (int j = 0; j < 8; ++j) xr[k][j] = xp[64 * j];
        float sv[8];
#pragma unroll
        for (int x = 0; x < 8; ++x) sv[x] = F_WS(float, WS_SSQ2)[(size_t)x * T + t];
        ssq[k] = ((sv[0] + sv[1]) + (sv[2] + sv[3])) + ((sv[4] + sv[5]) + (sv[6] + sv[7])); }
    f32x4 ga[8];
#pragma unroll
    for (int j = 0; j < 8; ++j) ga[j] = *(const GAS f32x4*)(F_IN(18) + 4 * lane + 256 * j);
#pragma unroll
    for (int k = 0; k < 4; ++k) { const int t = t0 + k * ts; const float r = 1.f / sqrtf(ssq[k] * (1.f / D) + EPS); float* drow = dst + (size_t)t * D;
#pragma unroll
        for (int j = 0; j < 8; ++j) { const unsigned w0 = (unsigned)xr[k][j], w1 = (unsigned)(xr[k][j] >> 32);
            const f32x4 o = (f32x4){bflo(w0) * r * ga[j].x, bfhi(w0) * r * ga[j].y, bflo(w1) * r * ga[j].z, bfhi(w1) * r * ga[j].w};
            __builtin_nontemporal_store(o, (GAS f32x4*)(drow + 4 * lane + 256 * j)); } }
}

__global__ void __launch_bounds__(NWAVES * 64, 2) mk_fwd(Args args) {
    extern __shared__ __attribute__((aligned(16))) unsigned char lds[];
    Frame F;
    F.lds = (LAS unsigned char*)lds;
    F.MISC = (volatile LAS unsigned*)(F.lds + MISC_OFF);
    F.tid = threadIdx.x; F.lane = F.tid & 63; F.wave = __builtin_amdgcn_readfirstlane(F.tid >> 6);
    F.G = gridDim.x; { const int bx = blockIdx.x; F.vcu = (F.G % 8 == 0) ? (bx % 8) * (F.G / 8) + bx / 8 : bx; }
    unsigned char* ws = args.ws;
    F.ctl = (gu32*)(ws + WS_CTL);
    F.out = args.out; F.ws = ws;
    for (int u = F.tid; u < (LDS_BYTES - LDSCTL_OFF) / 4; u += NWAVES * 64) ((LAS unsigned*)(F.lds + LDSCTL_OFF))[u] = 0u;
    __syncthreads();
    XcdBarrier bar; bar.bar = (unsigned*)(F.ctl + CW_BAR); bar.x = 0; bar.st = nullptr;
    if (N_LAUNCHES == 1) bar = xcd_barrier_post((unsigned*)(F.ctl + CW_BAR), F.MISC + 8);
#define GRID_BAR() do { if (N_LAUNCHES == 1) xcd_barrier(bar); } while (0)
    const int lo = args.ph_lo, hi = args.ph_hi;
#define IN(k) (lo <= (k) && (k) < hi)
#define BOTH(k) (IN(k) && IN((k) + 1))
    const int gw = F.vcu * NWAVES + F.wave, NGW = F.G * NWAVES;

    if (IN(0)) { REPS(0) p0_prologue(F, args); if (BOTH(0)) GRID_BAR(); }

    if (IN(1)) {
        pg8::Gemm g{F_WS(bf16, WS_XN), F_WS(bf16, WS_WIN), T, NIN, D}; pg8::TokenOrder S; S.init(T, NIN, F.G, (int)blockIdx.x, F.vcu, true);
        static_assert(WS_K - WS_Q == 64 * MiB && WS_V - WS_K == 64 * MiB && WS_U - WS_V == 64 * MiB && WS_Z - WS_U == 64 * MiB, "q|k|v|u|z regions equally spaced");
        pg8::EpiInProj E{F_WS(bf16, WS_Q), (size_t)(32 * MiB), F_WS(float, WS_ROPE), attn_body::C2};
        REPS(1) pg8::gemm_phase<pg8::EpiInProj, pg8::TokenOrder, true, true>(F.lds + RING_OFF, g, S, E);
        if (BOTH(1)) GRID_BAR();
    }

    if (IN(2)) {
        static_assert(attn_body::ATTN_LDS_BYTES <= RING_BYTES, "attention scratch fits the ring region");
        const attn_body::AttnTensors AT{(const attn_body::bf16*)F_WS(bf16, WS_Q), (const attn_body::bf16*)F_WS(bf16, WS_K), (const attn_body::bf16*)F_WS(bf16, WS_V), (attn_body::bf16*)F_WS(bf16, WS_O0), (attn_body::bf16*)F_WS(bf16, WS_O1)};
        REPS(2) for (int v = F.vcu; v < 256; v += F.G) attn_body::attn_phase<8>((char*)lds + RING_OFF, AT, v);
        if (BOTH(2)) GRID_BAR();
    }

    if (IN(3)) {
        REPS(3) for (int unit = F.vcu; unit < 256; unit += F.G) gmlp_unit(F, args, unit);
        float d1 = F_IN(3)[F.lane] * F_IN(4)[F.lane], d2 = F_IN(5)[F.lane] * F_IN(6)[F.lane];
        d1 = wave_sum(d1); d2 = wave_sum(d2);
        const float lam = __expf(d1) - __expf(d2) + LAMBDA_INIT;
        for (int t = gw; t < T; t += 2 * NGW) combine_row(F, args, t, t + NGW, lam);
        if (BOTH(3)) GRID_BAR();
    }

    if (IN(4)) {
        pg8::Gemm g{F_WS(bf16, WS_MIX), F_WS(bf16, WS_WOUT), T, D, D}; pg8::TokenOrder S; S.init(T, D, F.G, (int)blockIdx.x, F.vcu, true);
        pg8::EpiResX1 E{F_WS(float, WS_RINV), F_IN(1), F_WS(bf16, WS_XN), F_WS(float, WS_SSQ), T, D};
        REPS(4) pg8::gemm_phase<pg8::EpiResX1, pg8::TokenOrder, true, true>(F.lds + RING_OFF, g, S, E);
        if (BOTH(4)) GRID_BAR();
    }


    if (IN(6)) {
        pg8::Gemm g{F_WS(bf16, WS_WSC), F_WS(bf16, WS_XN), 2048, T, D}; pg8::TokenOrder S; S.init(2048, T, F.G, (int)blockIdx.x, F.vcu, false);
        pg8::EpiF16 E{F_WS(unsigned short, WS_SC), T};
        REPS(6) pg8::gemm_phase<pg8::EpiF16, pg8::TokenOrder, true, true>(F.lds + RING_OFF, g, S, E);
        if (BOTH(6)) GRID_BAR();
    }

    if (IN(7)) {
        if (F.wave < 4) peer_tables_rows(F, args);
        REPS(7) for (int wu = gw; wu < (T / 64) * 8; wu += NGW) topk_unit(F, args, wu);
        if (F.wave >= 4) peer_tables_rows(F, args);
        if (BOTH(7)) GRID_BAR();
    }

    if (IN(8)) {
        { const int bx = (int)blockIdx.x, nsl = (F.G % 8 == 0) ? 8 : 1, jg = bx / nsl, WPG = (F.G / nsl) * NWAVES;
          for (int x = bx % nsl; x < 8; x += nsl) peer_udots_loop(F, args, x, jg * NWAVES + F.wave, WPG);
          GRID_BAR();
          for (int t = gw; t < T; t += 4 * NGW) peer_weights4(F, args, t, NGW);
          GRID_BAR();
          for (int x = bx % nsl; x < 8; x += nsl) peer_vsum_loop(F, args, x, jg * NWAVES + F.wave, WPG);
          GRID_BAR();
          for (int t = gw; t < T; t += 4 * NGW) peer_final4(F, args, t, NGW, F.out);
        }
    }
#undef IN
#undef BOTH
}

extern "C" void kernel_launch(void* const* d_in, const int* in_sizes, int n_in, void* d_out, int out_size, void* d_ws, size_t ws_size, hipStream_t stream) {
    static int grid = 0;
    if (grid == 0) {
        if (n_in != 19 || in_sizes[0] != T * D || out_size != T * D || ws_size < WS_END) { fprintf(stderr, "kernel_launch: unexpected shapes (n_in %d, in0 %d, out %d, ws %zu); nothing launched\n", n_in, n_in > 0 ? in_sizes[0] : -1, out_size, ws_size); grid = -1; return; }
        int dev = 0, cus = 0, per_cu = 0;
        if (hipGetDevice(&dev) != hipSuccess || hipDeviceGetAttribute(&cus, hipDeviceAttributeMultiprocessorCount, dev) != hipSuccess) { fprintf(stderr, "kernel_launch: device query failed\n"); grid = -1; return; }
        if (hipFuncSetAttribute((const void*)mk_fwd, hipFuncAttributeMaxDynamicSharedMemorySize, LDS_BYTES) != hipSuccess) { fprintf(stderr, "kernel_launch: hipFuncSetAttribute failed\n"); grid = -1; return; }
        if (hipOccupancyMaxActiveBlocksPerMultiprocessor(&per_cu, (const void*)mk_fwd, NWAVES * 64, LDS_BYTES) != hipSuccess || per_cu < 1)
            fprintf(stderr, "kernel_launch: note: occupancy query reports %d workgroups per CU\n", per_cu);
        (void)hipGetLastError();
        grid = 1; while (grid * 2 <= cus && grid * 2 <= 256) grid *= 2;
    }
    if (grid < 0) return;
    if (hipMemsetAsync((char*)d_ws + WS_CTL, 0, CTL_ZERO_BYTES, stream) != hipSuccess) { fprintf(stderr, "kernel_launch: memset failed\n"); return; }
    Args a{};
    for (int i = 0; i < 19; ++i) a.in[i] = (const float*)d_in[i];
    a.out = (float*)d_out; a.ws = (unsigned char*)d_ws;
    for (int li = 0; li < N_LAUNCHES; ++li) {
        a.ph_lo = (N_LAUNCHES == 1) ? 0 : li; a.ph_hi = (N_LAUNCHES == 1) ? N_PHASES : li + 1; a.li = li; a.pad = 0;
        hipLaunchKernelGGL(mk_fwd, dim3(grid), dim3(NWAVES * 64), LDS_BYTES, stream, a);
        const hipError_t le = hipPeekAtLastError();
        if (le != hipSuccess) { fprintf(stderr, "kernel_launch: launch %d failed: %s\n", li, hipGetErrorName(le)); break; }
    }
}
```
